# Optimizing an MI355X kernel written in HIP

```python
import jax, jax.numpy as jnp
from jax import lax
import numpy as np

D_MODEL = 4096
BATCH = 4
SEQ = 2048
DEPTH = 2

HEAD_DIM = 128
N_HEADS = D_MODEL // 256
N_KV_HEADS = N_HEADS // 4
GROUP = N_HEADS // N_KV_HEADS
ATTN_WIDTH = N_HEADS * HEAD_DIM
KV_WIDTH = N_KV_HEADS * HEAD_DIM
WINDOW = 128
BLOCK = 128
ROPE_THETA = 500000.0
ROT_DIM = HEAD_DIM // 4
POOL_WIDTH = D_MODEL // 2
POOL_WINDOWS = (2, 4, 8, 16)
N_POOL_GROUPS = len(POOL_WINDOWS)
POOL_GROUP_DIM = POOL_WIDTH // N_POOL_GROUPS
IN_SPLITS = (ATTN_WIDTH, ATTN_WIDTH + KV_WIDTH, ATTN_WIDTH + 2 * KV_WIDTH,
             ATTN_WIDTH + 2 * KV_WIDTH + POOL_WIDTH,
             ATTN_WIDTH + 2 * KV_WIDTH + POOL_WIDTH + D_MODEL)
IN_WIDTH = ATTN_WIDTH + 2 * KV_WIDTH + POOL_WIDTH + 2 * D_MODEL
D_FF = ((-((-8 * D_MODEL) // 3)) + 255) // 256 * 256
RMS_EPS = 1e-6

kernel_name = 'hybrid_window_gqa_multiscale_pool_gated_encoder'


def rms_norm(x, g):
    x32 = x.astype(jnp.float32)
    y = x32 * lax.rsqrt(jnp.mean(x32 * x32, axis=-1, keepdims=True) + RMS_EPS)
    return (y * g.astype(jnp.float32)).astype(x.dtype)


def rotary_tables(seq):
    pos = jnp.arange(seq, dtype=jnp.float32)
    inv_freq = 1.0 / jnp.power(jnp.float32(ROPE_THETA),
                               jnp.arange(0, ROT_DIM, 2, dtype=jnp.float32) / ROT_DIM)
    ang = pos[:, None] * inv_freq[None, :]
    return jnp.cos(ang), jnp.sin(ang)


def partial_rotary(t, cos, sin):
    half = ROT_DIM // 2
    c = cos[None, :, None, :].astype(t.dtype)
    s = sin[None, :, None, :].astype(t.dtype)
    t1 = t[..., :half]
    t2 = t[..., half:ROT_DIM]
    return jnp.concatenate([t1 * c - t2 * s, t2 * c + t1 * s, t[..., ROT_DIM:]], axis=-1)


def windowed_gqa_with_sink(q, k, v, sink):
    B, S = q.shape[0], q.shape[1]
    nb = S // BLOCK
    qb = q.reshape(B, nb, BLOCK, N_KV_HEADS, GROUP, HEAD_DIM)
    pad = ((0, 0), (BLOCK, BLOCK), (0, 0), (0, 0))
    kp = jnp.pad(k, pad).reshape(B, nb + 2, BLOCK, N_KV_HEADS, HEAD_DIM)
    vp = jnp.pad(v, pad).reshape(B, nb + 2, BLOCK, N_KV_HEADS, HEAD_DIM)
    kw = jnp.concatenate([kp[:, :-2], kp[:, 1:-1], kp[:, 2:]], axis=2)
    vw = jnp.concatenate([vp[:, :-2], vp[:, 1:-1], vp[:, 2:]], axis=2)
    s = jnp.einsum('bnqhgd,bnjhd->bnhgqj', qb, kw).astype(jnp.float32) * (HEAD_DIM ** -0.5)
    blk = jnp.arange(nb)[:, None] * BLOCK
    qpos = blk + jnp.arange(BLOCK)[None, :]
    kpos = blk - BLOCK + jnp.arange(3 * BLOCK)[None, :]
    valid = ((kpos[:, None, :] >= 0) & (kpos[:, None, :] < S)
             & (jnp.abs(qpos[:, :, None] - kpos[:, None, :]) <= WINDOW))
    s = jnp.where(valid[None, :, None, None], s, -jnp.inf)
    sk = sink.astype(jnp.float32).reshape(1, 1, N_KV_HEADS, GROUP, 1, 1)
    m = jnp.maximum(jnp.max(s, axis=-1, keepdims=True), sk)
    p = jnp.exp(s - m)
    denom = jnp.sum(p, axis=-1, keepdims=True) + jnp.exp(sk - m)
    p = (p / denom).astype(v.dtype)
    o = jnp.einsum('bnhgqj,bnjhd->bnqhgd', p, vw)
    return o.reshape(B, S, ATTN_WIDTH)


def multiscale_pool(u, pool_w, pool_scale):
    B, S = u.shape[0], u.shape[1]
    ug = u.astype(jnp.float32).reshape(B, S, N_POOL_GROUPS, POOL_GROUP_DIM)
    t = jnp.arange(S)
    outs = []
    for gi, w in enumerate(POOL_WINDOWS):
        x_g = ug[:, :, gi]
        csum = jnp.concatenate([jnp.zeros((B, 1, POOL_GROUP_DIM), jnp.float32),
                                lax.cumsum(x_g, axis=1)], axis=1)
        lo = jnp.clip(t - w // 2, 0, S - 1)
        hi = jnp.clip(t + w // 2 - 1, 0, S - 1)
        cnt = (hi - lo + 1).astype(jnp.float32)[None, :, None]
        mean = (csum[:, hi + 1] - csum[:, lo]) / cnt
        outs.append(mean - x_g)
    pooled = jnp.stack(outs, axis=2)
    mixed = jnp.einsum('bsgc,gcd->bsgd', pooled, pool_w.astype(jnp.float32))
    mixed = mixed.reshape(B, S, POOL_WIDTH) * pool_scale.astype(jnp.float32)
    return mixed.astype(u.dtype)


def setup_inputs(seed: int = 0) -> dict:
    key = jax.random.key(seed)
    ks = jax.random.split(key, 14)
    f32 = jnp.float32

    def w(k, shape, fan_in):
        return jax.random.normal(k, shape, f32) * (fan_in ** -0.5)

    def gain(k, shape):
        return 1.0 + 0.02 * jax.random.normal(k, shape, f32)

    return {
        'x': jax.random.normal(ks[0], (BATCH, SEQ, D_MODEL), f32),
        'norm1_g': gain(ks[1], (DEPTH, D_MODEL)),
        'w_in': w(ks[2], (DEPTH, D_MODEL, IN_WIDTH), D_MODEL),
        'attn_sink': 0.5 * jax.random.normal(ks[3], (DEPTH, N_HEADS), f32),
        'pool_w': w(ks[4], (DEPTH, N_POOL_GROUPS, POOL_GROUP_DIM, POOL_GROUP_DIM), POOL_GROUP_DIM),
        'pool_scale': gain(ks[5], (DEPTH, POOL_WIDTH)),
        'w_branch_attn': w(ks[6], (DEPTH, ATTN_WIDTH, D_MODEL), ATTN_WIDTH),
        'w_branch_pool': w(ks[7], (DEPTH, POOL_WIDTH, D_MODEL), POOL_WIDTH),
        'w_out': w(ks[8], (DEPTH, D_MODEL, D_MODEL), D_MODEL),
        'norm2_g': gain(ks[9], (DEPTH, D_MODEL)),
        'w_gate_up': w(ks[10], (DEPTH, D_MODEL, 2 * D_FF), D_MODEL),
        'w_down': w(ks[11], (DEPTH, D_FF, D_MODEL), D_FF),
        'final_norm_g': gain(ks[12], (D_MODEL,)),
    }


def reference(x, norm1_g, w_in, attn_sink, pool_w, pool_scale, w_branch_attn,
              w_branch_pool, w_out, norm2_g, w_gate_up, w_down, final_norm_g):
    B, S = x.shape[0], x.shape[1]
    cos, sin = rotary_tables(S)
    for l in range(DEPTH):
        h = rms_norm(x, norm1_g[l])
        proj = h @ w_in[l]
        q, k, v, u, ga, gb = jnp.split(proj, IN_SPLITS, axis=-1)
        q = partial_rotary(q.reshape(B, S, N_HEADS, HEAD_DIM), cos, sin)
        k = partial_rotary(k.reshape(B, S, N_KV_HEADS, HEAD_DIM), cos, sin)
        v = v.reshape(B, S, N_KV_HEADS, HEAD_DIM)
        y_attn = windowed_gqa_with_sink(q, k, v, attn_sink[l]) @ w_branch_attn[l]
        y_pool = multiscale_pool(u, pool_w[l], pool_scale[l]) @ w_branch_pool[l]
        merged = jax.nn.sigmoid(ga) * y_attn + jax.nn.sigmoid(gb) * y_pool
        x = x + merged @ w_out[l]
        h2 = rms_norm(x, norm2_g[l])
        gate, up = jnp.split(h2 @ w_gate_up[l], 2, axis=-1)
        x = x + (jax.nn.silu(gate) * up) @ w_down[l]
    return rms_norm(x, final_norm_g)
```

```cpp
#include <hip/hip_runtime.h>
#include <hip/hip_bf16.h>
#include <cstdio>
#include <cstdint>
#ifndef PHMASK
#define PHMASK 0xFFFF
#endif

#define GAS __attribute__((address_space(1)))
#define LAS __attribute__((address_space(3)))
typedef unsigned short bf16_t;
typedef short bf16x8 __attribute__((ext_vector_type(8)));
typedef short s16x4 __attribute__((ext_vector_type(4)));
typedef float f32x4 __attribute__((ext_vector_type(4)));
typedef float f32x16 __attribute__((ext_vector_type(16)));
typedef unsigned u32x4 __attribute__((ext_vector_type(4)));
typedef GAS unsigned gu32;

constexpr int BATCH = 4, SEQ = 2048, M = BATCH * SEQ, DM = 4096, NHEAD = 16, NKVH = 4, HD = 128, DEPTH = 2;
constexpr int AW = 2048, KVW = 512, PW = 2048, NIN = 13312, FF = 11008, NGU = 2 * FF;
constexpr int C_Q = 0, C_K = 2048, C_V = 2560, C_U = 3072, C_GA = 5120, C_GB = 9216;
constexpr float RMS_EPS = 1e-6f;

constexpr size_t MiB = 1u << 20;
constexpr size_t WS_CTL = 0, CTL_ZERO_BYTES = 1 * MiB;
constexpr size_t WS_ROT = 1 * MiB;
constexpr size_t WS_W = 2 * MiB;
constexpr size_t WO_IN = 0, WO_POOL = 104 * MiB, WO_BA = 106 * MiB, WO_BP = 122 * MiB, WO_OUT = 138 * MiB, WO_GU = 170 * MiB, WO_DN = 342 * MiB, W_LAYER = 428 * MiB;
static_assert((size_t)NIN * DM * 2 <= WO_POOL - WO_IN && (size_t)NGU * DM * 2 <= WO_DN - WO_GU && (size_t)DM * FF * 2 <= W_LAYER - WO_DN, "weight map");
constexpr size_t WS_ACTS = WS_W + DEPTH * W_LAYER;
constexpr size_t WS_H = WS_ACTS, WS_PROJ = WS_H + 64 * MiB, WS_ATTO = WS_PROJ + 208 * MiB, WS_POOLED = WS_ATTO + 32 * MiB, WS_MIXED = WS_POOLED + 32 * MiB,
                 WS_MERGED = WS_MIXED + 32 * MiB, WS_X = WS_MERGED + 64 * MiB, WS_ACT = WS_X + 128 * MiB, WS_END = WS_ACT + 172 * MiB;
static_assert((size_t)M * NIN * 2 <= 208 * MiB && (size_t)M * FF * 2 <= 172 * MiB, "activation map");
constexpr int CW_BAR = 4096;

constexpr int RING_BYTES = 131072, LDSCTL_OFF = 139264, MISC_OFF = LDSCTL_OFF + 320, LDS_BYTES = 147456;
constexpr int NWAVES = 8;

#define LDS_WAIT() asm volatile("s_waitcnt lgkmcnt(0)" ::: "memory")
#define VM_WAIT() asm volatile("s_waitcnt vmcnt(0)" ::: "memory")
__device__ __forceinline__ unsigned cvt_pk_bf16(float lo, float hi) { unsigned r; asm volatile("v_cvt_pk_bf16_f32 %0, %1, %2" : "=v"(r) : "v"(lo), "v"(hi)); return r; }
__device__ __forceinline__ float bf_lo(unsigned w) { return __uint_as_float(w << 16); }
__device__ __forceinline__ float bf_hi(unsigned w) { return __uint_as_float(w & 0xffff0000u); }
__device__ __forceinline__ float fast_sigmoid(float x) { return __builtin_amdgcn_rcpf(1.0f + __builtin_amdgcn_exp2f(-1.4426950408889634f * x)); }

namespace pg8 {
constexpr int BM = 256, BK = 64, HALF = 128, HTB = HALF * BK * 2, STAGE_BYTES = 8 * HTB, NXCD = 8, WGM = 8;
__host__ __device__ __forceinline__ int lds_byte(int r, int c) { const int st = (r >> 4) * 2 + (c >> 5), rr = r & 15, cc = c & 31, ob = rr * 64 + cc * 2; return st * 1024 + (ob ^ (((ob >> 9) & 1) << 5)); }
__host__ __device__ __forceinline__ void stage_rc(int b, int& R, int& C) { const int st = b / 1024, sb = b % 1024, swz = sb ^ (((sb >> 9) & 1) << 5); R = (st >> 1) * 16 + swz / 64; C = (st & 1) * 32 + (swz % 64) / 2; }
__host__ __device__ __forceinline__ int perm32(int rho) { const int n = rho >> 4, i = rho & 15; return 8 * (i >> 2) + 4 * n + (i & 3); }

struct UnitD { const char* A; const char* B; int pm, pn, nt, kind; };

struct TileOrder {
    int nM, nN, nwg, G, c;
    __device__ __forceinline__ void init(int nM_, int nN_, int G_, int c_) { nM = nM_; nN = nN_; nwg = nM * nN; G = G_; c = c_; }
    __device__ __forceinline__ bool tile(int i, int& pm, int& pn) const {
        const long L = (long)i * G + c; if (L >= nwg) return false;
        int wgid = (int)L; { const int q = nwg / NXCD, r = nwg % NXCD, xcd = wgid % NXCD, off = wgid / NXCD; wgid = (xcd < r ? xcd * (q + 1) : r * (q + 1) + (xcd - r) * q) + off; }
        const int nig = WGM * nN, gid = wgid / nig, fm = gid * WGM, gsz = (nM - fm) < WGM ? (nM - fm) : WGM;
        pm = fm + ((wgid % nig) % gsz); pn = (wgid % nig) / gsz; return true;
    }
};
struct SchedPlain {
    TileOrder T; const char* A; const char* B; size_t tA, tB; int nt;
    __device__ __forceinline__ bool next(int i, UnitD& u) const { int pm, pn; if (!T.tile(i, pm, pn)) return false; u.pm = pm; u.pn = pn; u.A = A + (size_t)pm * tA; u.B = B + (size_t)pn * tB; u.nt = nt; u.kind = 0; return true; }
};
struct SchedPool {
    TileOrder T; const char* A; const char* B; size_t tA, tB; int nt;
    __device__ __forceinline__ bool next(int i, UnitD& u) const { int pm, pn; if (!T.tile(i, pm, pn)) return false; u.pm = pm; u.pn = pn; u.A = A + (size_t)pm * tA + (size_t)(pn >> 1) * 1024; u.B = B + (size_t)pn * tB; u.nt = nt; u.kind = 0; return true; }
};
struct SchedBranch {
    TileOrder T; const char* A1; const char* B1; const char* A2; const char* B2; size_t tA, tB; int nt;
    __device__ __forceinline__ bool next(int i, UnitD& u) const { int pm, pn; if (!T.tile(i >> 1, pm, pn)) return false; const int s = i & 1; u.pm = pm; u.pn = pn;
        u.A = (s ? A2 : A1) + (size_t)pm * tA; u.B = (s ? B2 : B1) + (size_t)pn * tB; u.nt = nt; u.kind = s; return true; }
};

template <class Epi, class Sched>
__device__ __forceinline__ void gemm_phase(LAS unsigned char* lds, const int lda, const int ldb, const Sched& S, const Epi& E) {
    int tid = threadIdx.x; asm volatile("" : "+v"(tid));
    const int wid = __builtin_amdgcn_readfirstlane(tid >> 6), lane = tid & 63, wr = wid >> 2, wc = wid & 3, fr = lane & 15, fq = lane >> 4;
    unsigned voffA[2], voffB[2];
#pragma unroll
    for (int i = 0; i < 2; ++i) { int R, C; stage_rc(tid * 16 + i * 8192, R, C); const int Rb = Epi::PERM ? ((R & ~31) + perm32(R & 31)) : R;
        voffA[i] = (unsigned)(R * lda + C) * 2u; voffB[i] = (unsigned)(Rb * ldb + C) * 2u; }
    const size_t kstep = (size_t)(BK * 2);
    const size_t hstepA = (size_t)HALF * lda * 2, hstepB = (size_t)HALF * ldb * 2;
    const unsigned ldsw = (unsigned)wid * 1024u;
    const int aoff = lds_byte(wr * 64 + fr, fq * 8), boff = lds_byte(wc * 32 + fr, fq * 8);
#define PG8_SA(b, h) (((b) * 2 + (h)) * HTB)
#define PG8_SB(b, h) ((4 + (b) * 2 + (h)) * HTB)
#define PG8_STAGE(bufoff, gbase, voff) do { _Pragma("unroll") for (int _i = 0; _i < 2; ++_i) \
        __builtin_amdgcn_global_load_lds((const unsigned*)((const char*)(gbase) + (voff)[_i]), (LAS unsigned*)(lds + (bufoff) + ldsw + _i * 8192), 16, 0, 0); } while (0)
#define PG8_LDA(dst, b, h) do { _Pragma("unroll") for (int m = 0; m < 4; ++m) _Pragma("unroll") for (int k = 0; k < 2; ++k) dst[m][k] = *(const LAS bf16x8*)(lds + PG8_SA(b, h) + aoff + m * 2048 + k * 1024); } while (0)
#define PG8_LDB(dst, b, h) do { _Pragma("unroll") for (int n = 0; n < 2; ++n) _Pragma("unroll") for (int k = 0; k < 2; ++k) dst[n][k] = *(const LAS bf16x8*)(lds + PG8_SB(b, h) + boff + n * 2048 + k * 1024); } while (0)
#define PG8_MMA(ai, bj, At, Bt) do { __builtin_amdgcn_s_setprio(1); _Pragma("unroll") for (int m = 0; m < 4; ++m) _Pragma("unroll") for (int n = 0; n < 2; ++n) _Pragma("unroll") for (int k = 0; k < 2; ++k) \
        acc[ai][bj][m][n] = __builtin_amdgcn_mfma_f32_16x16x32_bf16(Bt[n][k], At[m][k], acc[ai][bj][m][n], 0, 0, 0); __builtin_amdgcn_s_setprio(0); } while (0)
#define PG8_WAIT_V(n) asm volatile("s_waitcnt vmcnt(" #n ")" ::: "memory")
#define PG8_WAIT_L(n) asm volatile("s_waitcnt lgkmcnt(" #n ")" ::: "memory")
#define PG8_BAR __builtin_amdgcn_s_barrier()
#define PG8_SCHED __builtin_amdgcn_sched_barrier(0)
#define PG8_ZERO() do { _Pragma("unroll") for (int a = 0; a < 2; ++a) _Pragma("unroll") for (int b = 0; b < 2; ++b) _Pragma("unroll") for (int m = 0; m < 4; ++m) _Pragma("unroll") for (int n = 0; n < 2; ++n) acc[a][b][m][n] = (f32x4){0.f, 0.f, 0.f, 0.f}; } while (0)
    UnitD cur, nxt; int ui = 0;
    if (!S.next(0, cur)) return;
    f32x4 acc[2][2][4][2];
    PG8_ZERO();
    bf16x8 At[4][2], B0[2][2], B1[2][2];
    const char* cA = cur.A; const char* cB = cur.B;
    PG8_STAGE(PG8_SB(0, 0), cB, voffB); PG8_STAGE(PG8_SB(0, 1), cB + hstepB, voffB); PG8_STAGE(PG8_SA(0, 0), cA, voffA); PG8_STAGE(PG8_SA(0, 1), cA + hstepA, voffA);
    if (wr == 1) PG8_BAR;
    PG8_WAIT_V(2); PG8_BAR;
    PG8_STAGE(PG8_SB(1, 0), cB + kstep, voffB); PG8_STAGE(PG8_SA(1, 0), cA + kstep, voffA); PG8_STAGE(PG8_SB(1, 1), cB + hstepB + kstep, voffB);
    PG8_WAIT_V(6); PG8_BAR;
    for (;;) {
        const bool has_next = S.next(ui + 1, nxt);
        const char* nA = has_next ? nxt.A : cA; const char* nB = has_next ? nxt.B : cB;
        const int nt = cur.nt;
        for (int t = 0; t < nt; t += 2) {
            const bool last = (t == nt - 2);
            const char* a1 = cA + (size_t)(t + 1) * kstep;
            const char* a2 = last ? nA : cA + (size_t)(t + 2) * kstep; const char* b2 = last ? nB : cB + (size_t)(t + 2) * kstep;
            const char* a3 = a2 + kstep; const char* b3 = b2 + kstep;
            PG8_LDB(B0, 0, 0); PG8_LDB(B1, 0, 1); PG8_SCHED; PG8_LDA(At, 0, 0); PG8_STAGE(PG8_SA(1, 1), a1 + hstepA, voffA);
            PG8_WAIT_V(8); PG8_WAIT_L(0); PG8_BAR; PG8_MMA(0, 0, At, B0); PG8_MMA(0, 1, At, B1); PG8_BAR; PG8_SCHED;
            PG8_LDA(At, 0, 1); PG8_STAGE(PG8_SB(0, 0), b2, voffB); PG8_STAGE(PG8_SB(0, 1), b2 + hstepB, voffB); PG8_STAGE(PG8_SA(0, 0), a2, voffA);
            PG8_WAIT_V(8); PG8_WAIT_L(0); PG8_BAR; PG8_MMA(1, 0, At, B0); PG8_MMA(1, 1, At, B1); PG8_BAR; PG8_SCHED;
            PG8_LDB(B0, 1, 0); PG8_LDB(B1, 1, 1); PG8_SCHED; PG8_LDA(At, 1, 0); PG8_STAGE(PG8_SA(0, 1), a2 + hstepA, voffA);
            PG8_WAIT_V(8); PG8_WAIT_L(0); PG8_BAR; PG8_MMA(0, 0, At, B0); PG8_MMA(0, 1, At, B1); PG8_BAR; PG8_SCHED;
            PG8_LDA(At, 1, 1); PG8_STAGE(PG8_SB(1, 0), b3, voffB); PG8_STAGE(PG8_SB(1, 1), b3 + hstepB, voffB); PG8_STAGE(PG8_SA(1, 0), a3, voffA);
            PG8_WAIT_V(8); PG8_WAIT_L(0); PG8_BAR; PG8_MMA(1, 0, At, B0); PG8_MMA(1, 1, At, B1); PG8_BAR; PG8_SCHED;
        }
        if (wr == 0) PG8_BAR;
        const bool keep = E(acc, cur, wr, wc, fr, fq);
        if (!has_next) break;
        if (!keep) PG8_ZERO();
        cur = nxt; cA = nA; cB = nB; ++ui;
        if (wr == 1) PG8_BAR;
    }
    PG8_WAIT_V(0);
    PG8_BAR;
#undef PG8_SA
#undef PG8_SB
#undef PG8_STAGE
#undef PG8_LDA
#undef PG8_LDB
#undef PG8_MMA
#undef PG8_WAIT_V
#undef PG8_WAIT_L
#undef PG8_BAR
#undef PG8_SCHED
#undef PG8_ZERO
}

struct EpiIn {
    static constexpr bool PERM = true;
    bf16_t* P; const float* cosT; const float* sinT;
    __device__ __forceinline__ bool operator()(f32x4 (&acc)[2][2][4][2], const UnitD& u, int wr, int wc, int fr, int fq) const {
        const int row0 = u.pm * 256 + wr * 64 + fr, col0 = u.pn * 256 + wc * 32 + 8 * fq;
        const int mode = (u.pn < 10) ? ((wc == 0) ? 1 : 0) : ((u.pn >= 20) ? 2 : 0);
#pragma unroll
        for (int ai = 0; ai < 2; ++ai)
#pragma unroll
            for (int m = 0; m < 4; ++m) {
                const int row = row0 + ai * 128 + m * 16;
                f32x4 v[2][2];
#pragma unroll
                for (int bj = 0; bj < 2; ++bj) { v[bj][0] = acc[ai][bj][m][0]; v[bj][1] = acc[ai][bj][m][1]; }
                if (mode == 1) {
                    const int pos = row & (SEQ - 1);
                    const f32x4 c = *(const f32x4*)(cosT + pos * 16 + 4 * fq), s = *(const f32x4*)(sinT + pos * 16 + 4 * fq);
#pragma unroll
                    for (int bj = 0; bj < 2; ++bj) { const f32x4 a = v[bj][0], b = v[bj][1]; v[bj][0] = a * c - b * s; v[bj][1] = b * c + a * s; }
                } else if (mode == 2) {
#pragma unroll
                    for (int bj = 0; bj < 2; ++bj)
#pragma unroll
                        for (int n = 0; n < 2; ++n)
#pragma unroll
                            for (int j = 0; j < 4; ++j) v[bj][n][j] = fast_sigmoid(v[bj][n][j]);
                }
                bf16_t* rowp = P + (size_t)row * NIN + col0;
#pragma unroll
                for (int bj = 0; bj < 2; ++bj) { u32x4 w; w.x = cvt_pk_bf16(v[bj][0][0], v[bj][0][1]); w.y = cvt_pk_bf16(v[bj][0][2], v[bj][0][3]); w.z = cvt_pk_bf16(v[bj][1][0], v[bj][1][1]); w.w = cvt_pk_bf16(v[bj][1][2], v[bj][1][3]);
                    *(u32x4*)(rowp + bj * 128) = w; }
            }
        return false;
    }
};
struct EpiPool {
    static constexpr bool PERM = true;
    bf16_t* O; const float* scale;
    __device__ __forceinline__ bool operator()(f32x4 (&acc)[2][2][4][2], const UnitD& u, int wr, int wc, int fr, int fq) const {
        const int row0 = u.pm * 256 + wr * 64 + fr, col0 = u.pn * 256 + wc * 32 + 8 * fq;
        f32x4 sc[2][2];
#pragma unroll
        for (int bj = 0; bj < 2; ++bj)
#pragma unroll
            for (int n = 0; n < 2; ++n) sc[bj][n] = *(const f32x4*)(scale + col0 + bj * 128 + 4 * n);
#pragma unroll
        for (int ai = 0; ai < 2; ++ai)
#pragma unroll
            for (int m = 0; m < 4; ++m) { bf16_t* rowp = O + (size_t)(row0 + ai * 128 + m * 16) * PW + col0;
#pragma unroll
                for (int bj = 0; bj < 2; ++bj) { const f32x4 v0 = acc[ai][bj][m][0] * sc[bj][0], v1 = acc[ai][bj][m][1] * sc[bj][1];
                    u32x4 w; w.x = cvt_pk_bf16(v0[0], v0[1]); w.y = cvt_pk_bf16(v0[2], v0[3]); w.z = cvt_pk_bf16(v1[0], v1[1]); w.w = cvt_pk_bf16(v1[2], v1[3]);
                    *(u32x4*)(rowp + bj * 128) = w; } }
        return false;
    }
};
struct EpiBranch {
    static constexpr bool PERM = true;
    const bf16_t* P; bf16_t* O;
    __device__ __forceinline__ bool operator()(f32x4 (&acc)[2][2][4][2], const UnitD& u, int wr, int wc, int fr, int fq) const {
        const int row0 = u.pm * 256 + wr * 64 + fr, col0 = u.pn * 256 + wc * 32 + 8 * fq;
        if (u.kind == 0) {
#pragma unroll
            for (int ai = 0; ai < 2; ++ai)
#pragma unroll
                for (int m = 0; m < 4; ++m) { const bf16_t* rowp = P + (size_t)(row0 + ai * 128 + m * 16) * NIN + col0;
#pragma unroll
                    for (int bj = 0; bj < 2; ++bj) { const u32x4 a = *(const u32x4*)(rowp + C_GA + bj * 128), b = *(const u32x4*)(rowp + C_GB + bj * 128);
                        f32x4 r0, r1;
                        r0[0] = bf_lo(a.x) * __builtin_amdgcn_rcpf(fmaxf(bf_lo(b.x), 1e-20f)); r0[1] = bf_hi(a.x) * __builtin_amdgcn_rcpf(fmaxf(bf_hi(b.x), 1e-20f));
                        r0[2] = bf_lo(a.y) * __builtin_amdgcn_rcpf(fmaxf(bf_lo(b.y), 1e-20f)); r0[3] = bf_hi(a.y) * __builtin_amdgcn_rcpf(fmaxf(bf_hi(b.y), 1e-20f));
                        r1[0] = bf_lo(a.z) * __builtin_amdgcn_rcpf(fmaxf(bf_lo(b.z), 1e-20f)); r1[1] = bf_hi(a.z) * __builtin_amdgcn_rcpf(fmaxf(bf_hi(b.z), 1e-20f));
                        r1[2] = bf_lo(a.w) * __builtin_amdgcn_rcpf(fmaxf(bf_lo(b.w), 1e-20f)); r1[3] = bf_hi(a.w) * __builtin_amdgcn_rcpf(fmaxf(bf_hi(b.w), 1e-20f));
                        acc[ai][bj][m][0] = acc[ai][bj][m][0] * r0; acc[ai][bj][m][1] = acc[ai][bj][m][1] * r1; }
                    asm volatile("" ::: "memory"); }
            return true;
        }
#pragma unroll
        for (int ai = 0; ai < 2; ++ai)
#pragma unroll
            for (int m = 0; m < 4; ++m) { const bf16_t* rowp = P + (size_t)(row0 + ai * 128 + m * 16) * NIN + col0; bf16_t* outp = O + (size_t)(row0 + ai * 128 + m * 16) * DM + col0;
#pragma unroll
                for (int bj = 0; bj < 2; ++bj) { const u32x4 b = *(const u32x4*)(rowp + C_GB + bj * 128);
                    f32x4 s0, s1;
                    s0[0] = fmaxf(bf_lo(b.x), 1e-20f); s0[1] = fmaxf(bf_hi(b.x), 1e-20f); s0[2] = fmaxf(bf_lo(b.y), 1e-20f); s0[3] = fmaxf(bf_hi(b.y), 1e-20f);
                    s1[0] = fmaxf(bf_lo(b.z), 1e-20f); s1[1] = fmaxf(bf_hi(b.z), 1e-20f); s1[2] = fmaxf(bf_lo(b.w), 1e-20f); s1[3] = fmaxf(bf_hi(b.w), 1e-20f);
                    const f32x4 v0 = acc[ai][bj][m][0] * s0, v1 = acc[ai][bj][m][1] * s1;
                    u32x4 w; w.x = cvt_pk_bf16(v0[0], v0[1]); w.y = cvt_pk_bf16(v0[2], v0[3]); w.z = cvt_pk_bf16(v1[0], v1[1]); w.w = cvt_pk_bf16(v1[2], v1[3]);
                    *(u32x4*)(outp + bj * 128) = w; }
                asm volatile("" ::: "memory"); }
        return false;
    }
};
struct EpiRes {
    static constexpr bool PERM = false;
    const float* xin; float* xout;
    __device__ __forceinline__ bool operator()(f32x4 (&acc)[2][2][4][2], const UnitD& u, int wr, int wc, int fr, int fq) const {
        const int row0 = u.pm * 256 + wr * 64 + fr, col0 = u.pn * 256 + wc * 32 + 4 * fq;
#pragma unroll
        for (int ai = 0; ai < 2; ++ai)
#pragma unroll
            for (int m = 0; m < 4; ++m) { const size_t off = (size_t)(row0 + ai * 128 + m * 16) * DM + col0;
#pragma unroll
                for (int bj = 0; bj < 2; ++bj)
#pragma unroll
                    for (int n = 0; n < 2; ++n) { const f32x4 r = *(const f32x4*)(xin + off + bj * 128 + n * 16); *(f32x4*)(xout + off + bj * 128 + n * 16) = r + acc[ai][bj][m][n]; }
                asm volatile("" ::: "memory"); }
        return false;
    }
};
struct EpiGU {
    static constexpr bool PERM = true;
    bf16_t* O;
    __device__ __forceinline__ bool operator()(f32x4 (&acc)[2][2][4][2], const UnitD& u, int wr, int wc, int fr, int fq) const {
        const int row0 = u.pm * 256 + wr * 64 + fr, col0 = u.pn * 128 + wc * 32 + 8 * fq;
#pragma unroll
        for (int ai = 0; ai < 2; ++ai)
#pragma unroll
            for (int m = 0; m < 4; ++m) { f32x4 v[2];
#pragma unroll
                for (int n = 0; n < 2; ++n)
#pragma unroll
                    for (int j = 0; j < 4; ++j) { const float g = acc[ai][0][m][n][j]; v[n][j] = g * fast_sigmoid(g) * acc[ai][1][m][n][j]; }
                u32x4 w; w.x = cvt_pk_bf16(v[0][0], v[0][1]); w.y = cvt_pk_bf16(v[0][2], v[0][3]); w.z = cvt_pk_bf16(v[1][0], v[1][1]); w.w = cvt_pk_bf16(v[1][2], v[1][3]);
                *(u32x4*)(O + (size_t)(row0 + ai * 128 + m * 16) * FF + col0) = w; }
        return false;
    }
};
}

namespace attn {
constexpr int D = 128, NW = 8, QBLK = 32, KVBLK = 64, QB = NW * QBLK, WIN = 128;
constexpr int SHM_V = KVBLK * D * 2, SHM_K = KVBLK * D * 2;
constexpr int LDS_BYTES = 2 * SHM_V + 2 * SHM_K + NW * 64 * 4;
constexpr int LDQ = NIN, LDKV = NIN, LDO = AW;
constexpr float SCALE = 0.08838834764831845f;
constexpr float THR = 8.f;
#define KSWZ(row, colB) ((row) * 256 + ((colB) ^ (((row) & 7) << 4)))
#define SBAR() __builtin_amdgcn_sched_barrier(0)
__device__ __forceinline__ int v_st(int k, int c) { const int kk = (k & ~0xC) | ((k & 4) << 1) | ((k & 8) >> 1); return ((kk >> 3) * 4 + (c >> 5)) * 512 + ((kk & 7) * 32 + (c & 31)) * 2; }
__device__ __forceinline__ int v_rd_base(int lane) { return ((lane & 3) << 3) | (((lane >> 2) & 3) << 6) | (((lane >> 4) & 1) << 5) | (((lane >> 5) & 1) << 8); }
constexpr int v_rd_off(int d0, int ks, int half) { return d0 * 512 + ks * 4096 + half * 2048; }
__device__ __forceinline__ int crow(int r, int hi) { return (r & 3) + 8 * (r >> 2) + 4 * hi; }
__device__ __forceinline__ unsigned cvtpk(float lo, float hi) { unsigned r; asm volatile("v_cvt_pk_bf16_f32 %0, %1, %2" : "=v"(r) : "v"(lo), "v"(hi)); return r; }
__device__ __forceinline__ bf16x8 load8(const bf16_t* p) { return *reinterpret_cast<const bf16x8*>(p); }
__device__ __forceinline__ void mask_tile(f32x16& p0, f32x16& p1, int dq) {
    const float NEG = -__builtin_inff();
#pragma unroll
    for (int r = 0; r < 16; ++r) {
        const int c = (r & 3) + 8 * (r >> 2);
        if ((unsigned)(dq - c) >= (unsigned)(2 * WIN + 1)) p0[r] = NEG;
        if ((unsigned)(dq - c - 32) >= (unsigned)(2 * WIN + 1)) p1[r] = NEG;
    }
}
__device__ __forceinline__ void partialSM(f32x16& p0, f32x16& p1, float& m_reg, float& mn, float& alpha) {
    float pmax = p0[0]; for (int r = 1; r < 16; ++r) pmax = fmaxf(pmax, p0[r]); for (int r = 0; r < 16; ++r) pmax = fmaxf(pmax, p1[r]);
    { auto rr = __builtin_amdgcn_permlane32_swap(__float_as_uint(pmax), __float_as_uint(pmax), false, false);
      pmax = fmaxf(__uint_as_float(rr[0]), __uint_as_float(rr[1])); }
    constexpr float C2 = 1.4426950408889634f * SCALE;
    if (__builtin_expect(__all((pmax - m_reg) * SCALE <= THR), 1)) { mn = m_reg; alpha = 1.f; }
    else { mn = fmaxf(m_reg, pmax); alpha = __builtin_amdgcn_exp2f((m_reg - mn) * C2); m_reg = mn; }
    const float mnL = -mn * C2;
    for (int r = 0; r < 16; ++r) p0[r] = fmaf(p0[r], C2, mnL); for (int r = 0; r < 16; ++r) p1[r] = fmaf(p1[r], C2, mnL);
    for (int r = 0; r < 16; ++r) p0[r] = __builtin_amdgcn_exp2f(p0[r]);
}
__device__ __forceinline__ void finishSM(f32x16& p0, f32x16& p1, float alpha, float& l_reg, bf16x8& pa0, bf16x8& pa1, bf16x8& pa2, bf16x8& pa3) {
    for (int r = 0; r < 16; ++r) p1[r] = __builtin_amdgcn_exp2f(p1[r]);
    float ps = 0; for (int r = 0; r < 16; ++r) ps += p0[r]; for (int r = 0; r < 16; ++r) ps += p1[r];
    { auto rr = __builtin_amdgcn_permlane32_swap(__float_as_uint(ps), __float_as_uint(ps), false, false);
      ps = __uint_as_float(rr[0]) + __uint_as_float(rr[1]); }
    l_reg = l_reg * alpha + ps;
#define PK4(P, B_, OUT) do { unsigned a0 = cvtpk(P[B_+0], P[B_+1]), a1 = cvtpk(P[B_+2], P[B_+3]);                          \
        unsigned b0 = cvtpk(P[B_+4], P[B_+5]), b1 = cvtpk(P[B_+6], P[B_+7]);                                             \
        auto r0 = __builtin_amdgcn_permlane32_swap(a0, b0, false, false); auto r1 = __builtin_amdgcn_permlane32_swap(a1, b1, false, false); \
        u32x4 w = {r0[0], r1[0], r0[1], r1[1]}; OUT = *reinterpret_cast<bf16x8*>(&w); } while (0)
    PK4(p0, 0, pa0); PK4(p0, 8, pa1); PK4(p1, 0, pa2); PK4(p1, 8, pa3);
#undef PK4
}
template <int KB>
__device__ __forceinline__ void qkt(f32x16& p0, f32x16& p1, const char* K_lds, int r32, int hi, const char* q_lds, bool act) {
    if (!act) { const float NEG = -__builtin_inff();
#pragma unroll
        for (int r = 0; r < 16; ++r) { p0[r] = NEG; p1[r] = NEG; } return; }
    p0 = f32x16{}; p1 = f32x16{};
    const char* kb[4];
#pragma unroll
    for (int dd = 0; dd < 4; ++dd) kb[dd] = K_lds + KB * SHM_K + KSWZ(r32, (dd * 16 + hi * 8) * 2);
#pragma unroll
    for (int d0 = 0; d0 < 8; ++d0) { const char* a = kb[d0 & 3] + (d0 >> 2) * 128;
        bf16x8 b0 = *reinterpret_cast<const bf16x8*>(a);
        bf16x8 b1 = *reinterpret_cast<const bf16x8*>(a + 32 * 256);
        bf16x8 q = *reinterpret_cast<const bf16x8*>(q_lds + d0 * 1024);
        p0 = __builtin_amdgcn_mfma_f32_32x32x16_bf16(b0, q, p0, 0, 0, 0);
        p1 = __builtin_amdgcn_mfma_f32_32x32x16_bf16(b1, q, p1, 0, 0, 0); }
}
template <int VB>
__device__ __forceinline__ void pv_tile(f32x16* o, int vb0, bf16x8 pa0, bf16x8 pa1, bf16x8 pa2, bf16x8 pa3, bool act) {
    if (!act) return;
#define TRRD(dst, off) asm volatile("ds_read_b64_tr_b16 %0, %1 offset:%2" : "=&v"(dst) : "v"(vb0), "i"(off) : "memory")
#define PV_D0(d0) do { s16x4 l0, l1, l2, l3, h0, h1, h2, h3; constexpr int b_ = VB * SHM_V + v_rd_off(d0, 0, 0);   \
        TRRD(l0, b_); TRRD(h0, b_ + 2048); TRRD(l1, b_ + 4096); TRRD(h1, b_ + 6144); TRRD(l2, b_ + 8192); TRRD(h2, b_ + 10240); TRRD(l3, b_ + 12288); TRRD(h3, b_ + 14336); \
        asm volatile("s_waitcnt lgkmcnt(0)" ::: "memory"); SBAR();   \
        o[d0] = __builtin_amdgcn_mfma_f32_32x32x16_bf16(pa0, (bf16x8){l0[0], l0[1], l0[2], l0[3], h0[0], h0[1], h0[2], h0[3]}, o[d0], 0, 0, 0);   \
        o[d0] = __builtin_amdgcn_mfma_f32_32x32x16_bf16(pa1, (bf16x8){l1[0], l1[1], l1[2], l1[3], h1[0], h1[1], h1[2], h1[3]}, o[d0], 0, 0, 0);   \
        o[d0] = __builtin_amdgcn_mfma_f32_32x32x16_bf16(pa2, (bf16x8){l2[0], l2[1], l2[2], l2[3], h2[0], h2[1], h2[2], h2[3]}, o[d0], 0, 0, 0);   \
        o[d0] = __builtin_amdgcn_mfma_f32_32x32x16_bf16(pa3, (bf16x8){l3[0], l3[1], l3[2], l3[3], h3[0], h3[1], h3[2], h3[3]}, o[d0], 0, 0, 0); } while (0)
    PV_D0(0); PV_D0(1); PV_D0(2); PV_D0(3);
#undef PV_D0
#undef TRRD
}
struct BlockRef { const bf16_t* Q; const bf16_t* K; const bf16_t* V; bf16_t* O; int P0; float msink; };
struct Seam { bf16x8 st_v0, st_v1, st_k0, st_k1; };
constexpr int LDS_Q = LDS_BYTES;
constexpr int LDS_TOTAL = LDS_Q + NW * 8192;
__device__ __forceinline__ int jlo_of(int P0) { const int lowk = P0 - WIN; return lowk > 0 ? lowk / KVBLK : 0; }
#define ROW(p, k0, rr) ((p) + (size_t)((k0) + (rr)) * LDKV + sc)
#define VMW() asm volatile("s_waitcnt vmcnt(0)" ::: "memory")
#define SLOAD_H(Kp, Vp, k0) do { S.st_v0 = load8(ROW(Vp, k0, sr)); S.st_v1 = load8(ROW(Vp, k0, 32 + sr));              \
                         S.st_k0 = load8(ROW(Kp, k0, sr)); S.st_k1 = load8(ROW(Kp, k0, 32 + sr)); } while (0)
#define SWRITE_HK(bf) do { *(bf16x8*)(K_lds + (bf) * SHM_K + kws) = S.st_k0; *(bf16x8*)(K_lds + (bf) * SHM_K + kws + 32 * 256) = S.st_k1; } while (0)
#define SWRITE_HV(bf) do { *(bf16x8*)(V_lds + (bf) * SHM_V + vst0) = S.st_v0; *(bf16x8*)(V_lds + (bf) * SHM_V + vst1) = S.st_v1; } while (0)
#define SWRITE_H(bf) do { SWRITE_HV(bf); SWRITE_HK(bf); } while (0)
__device__ __forceinline__ void attn_block(const BlockRef& cur, char* lds) {
    int tid = threadIdx.x; asm volatile("" : "+v"(tid));
    const int wid = __builtin_amdgcn_readfirstlane(tid >> 6), lane = tid & 63, r32 = lane & 31, hi = lane >> 5;
    const int j_lo = jlo_of(cur.P0);
    int j_hi = (cur.P0 + QB - 1 + WIN) / KVBLK + 1; if (j_hi > SEQ / KVBLK) j_hi = SEQ / KVBLK;
    const int NT = j_hi - j_lo;
    const int qlo = cur.P0 + wid * QBLK, qm = qlo + r32 - 4 * hi + WIN;
    char* V_lds = lds; char* K_lds = lds + 2 * SHM_V;
    float* ws = (float*)(lds + 2 * SHM_V + 2 * SHM_K) + wid * 64; float* li_l = ws, * al_l = ws + 32;
    char* q_lds = lds + LDS_Q + wid * 8192 + lane * 16;
    float m_reg = cur.msink, l_reg = 1.f; f32x16 o[4] = {};
    const int sr = tid >> 4, sc = (tid & 15) * 8, vst0 = v_st(sr, sc), vst1 = v_st(32 + sr, sc), kws = KSWZ(sr, sc * 2);
    const int vb0 = (int)(uintptr_t)V_lds + v_rd_base(lane);
    const bf16_t* Kh = cur.K; const bf16_t* Vh = cur.V;
    Seam S;
#define KBASE(t) ((j_lo + (t)) * KVBLK)
    {
        SLOAD_H(Kh, Vh, KBASE(0));
#pragma unroll
        for (int d0 = 0; d0 < 8; ++d0) { const bf16x8 q = load8(cur.Q + (size_t)(wid * QBLK + r32) * LDQ + d0 * 16 + hi * 8); *reinterpret_cast<bf16x8*>(q_lds + d0 * 1024) = q; }
        VMW(); SWRITE_HK(0);
        __syncthreads();
    }
#define RESC(a) do { if (__any((a) < 1.f)) { if (hi == 0) al_l[r32] = (a); asm volatile("s_waitcnt lgkmcnt(0)" ::: "memory");              \
                     for (int d_ = 0; d_ < 4; ++d_) for (int r = 0; r < 16; ++r) o[d_][r] *= al_l[crow(r, hi)]; } } while (0)
#define ACT(t) (KBASE(t) <= qlo + QBLK - 1 + WIN && KBASE(t) + KVBLK - 1 >= qlo - WIN)
#define MASKT(P0_, P1_, t) do { const int kb_ = KBASE(t); if (ACT(t) && (kb_ + KVBLK - 1 > qlo + WIN || kb_ < qlo + QBLK - 1 - WIN)) mask_tile(P0_, P1_, qm - kb_); } while (0)
    f32x16 pA0, pA1, pB0, pB1; float mnA, mnB, alA, alB; bf16x8 pa0, pa1, pa2, pa3;
    SWRITE_HV(0); SBAR();
    if (NT > 1) { SLOAD_H(Kh, Vh, KBASE(1)); }
    SBAR(); qkt<0>(pA0, pA1, K_lds, r32, hi, q_lds, ACT(0));
    MASKT(pA0, pA1, 0); partialSM(pA0, pA1, m_reg, mnA, alA);
    if (NT > 1) { VMW(); SWRITE_H(1); }
    __syncthreads();
#define HALF_STEP(PX0, PX1, mnX, alX, PY0, PY1, alY, t, KB, VB, SB) do {                                                      \
        SBAR(); qkt<KB>(PX0, PX1, K_lds, r32, hi, q_lds, ACT(t));                                                \
        finishSM(PY0, PY1, alY, l_reg, pa0, pa1, pa2, pa3); SBAR();                                                           \
        if ((t) + 1 < NT) { SLOAD_H(Kh, Vh, KBASE((t) + 1)); SBAR(); }                                                         \
        pv_tile<VB>(o, vb0, pa0, pa1, pa2, pa3, ACT((t) - 1)); MASKT(PX0, PX1, (t)); partialSM(PX0, PX1, m_reg, mnX, alX);    \
        __syncthreads();                                                                                                      \
        if ((t) + 1 < NT) { VMW(); SWRITE_H(SB); }                                                                            \
        RESC(alX); __syncthreads(); } while (0)
    for (int t = 1; t + 1 < NT; t += 2) {
        HALF_STEP(pB0, pB1, mnB, alB, pA0, pA1, alA, t, 1, 0, 0);
        HALF_STEP(pA0, pA1, mnA, alA, pB0, pB1, alB, t + 1, 0, 1, 1);
    }
    const bool even = (NT & 1) == 0;
    if (even) { SBAR(); qkt<1>(pB0, pB1, K_lds, r32, hi, q_lds, ACT(NT - 1)); SBAR(); }
    finishSM(pA0, pA1, alA, l_reg, pa0, pa1, pa2, pa3); SBAR();
    pv_tile<0>(o, vb0, pa0, pa1, pa2, pa3, ACT(even ? NT - 2 : NT - 1));
    if (even) { MASKT(pB0, pB1, NT - 1); partialSM(pB0, pB1, m_reg, mnB, alB); __syncthreads(); RESC(alB);
        finishSM(pB0, pB1, alB, l_reg, pa0, pa1, pa2, pa3); SBAR(); pv_tile<1>(o, vb0, pa0, pa1, pa2, pa3, ACT(NT - 1)); }
    SBAR();
    if (hi == 0) li_l[r32] = l_reg; asm volatile("s_waitcnt lgkmcnt(0)" ::: "memory");
    float rli[16];
#pragma unroll
    for (int r = 0; r < 16; ++r) rli[r] = __builtin_amdgcn_rcpf(li_l[crow(r, hi)]);
    bf16_t* Ow = cur.O + (size_t)(wid * QBLK) * LDO;
#pragma unroll
    for (int r = 0; r < 16; ++r) { const int orow = crow(r, hi);
#pragma unroll
        for (int d0 = 0; d0 < 4; ++d0) { const float v = o[d0][r] * rli[r];
            const float vn = __shfl_xor(v, 1);
            if ((r32 & 1) == 0) *(unsigned*)(Ow + (size_t)orow * LDO + d0 * 32 + r32) = cvtpk(v, vn); } }
    __syncthreads();
#undef RESC
#undef KBASE
#undef ACT
#undef MASKT
#undef HALF_STEP
}
#undef ROW
#undef VMW
#undef SLOAD_H
#undef SWRITE_HK
#undef SWRITE_HV
#undef SWRITE_H
#undef KSWZ
#undef SBAR
}
static_assert(attn::LDS_TOTAL <= LDSCTL_OFF && pg8::STAGE_BYTES <= LDSCTL_OFF && MISC_OFF + 128 <= LDS_BYTES, "LDS map");

#define XB_TMO      128
#define XB_XCNT(j)  (256  + 64 * (j))
#define XB_XSUB(j)  (1280 + 64 * (j))
#define XB_XGEN(j)  (2304 + 64 * (j))
#define XB_TOP      3328
#define XB_TOPGEN   3392
#define XCD_BAR_WORDS 3456
#define XB_SPIN_CAP (1u << 18)

__device__ __forceinline__ unsigned xb_ld(unsigned* p)              { return __hip_atomic_load(p, __ATOMIC_RELAXED, __HIP_MEMORY_SCOPE_AGENT); }
__device__ __forceinline__ unsigned xb_add(unsigned* p, unsigned v) { return __hip_atomic_fetch_add(p, v, __ATOMIC_RELAXED, __HIP_MEMORY_SCOPE_AGENT); }
__device__ __forceinline__ unsigned xb_xcc_id() { return (unsigned)__builtin_amdgcn_s_getreg((3 << 11) | 20) & 0xFu; }
#define XB_SPIN(cond, bar) do { unsigned _sp = 0; while (cond) { __builtin_amdgcn_s_sleep(1); \
    if ((++_sp & 255u) == 0u) { if (xb_ld(&(bar)[XB_TMO])) break; if (_sp > XB_SPIN_CAP) { atomicAdd(&(bar)[XB_TMO], 1u); break; } } } } while (0)

struct XcdBarrier {
    unsigned* bar; unsigned x;
    volatile LAS unsigned* st;
};
__device__ __forceinline__ XcdBarrier xcd_barrier_post(unsigned* bar, volatile LAS unsigned* st) {
    XcdBarrier b; b.bar = bar; b.x = xb_xcc_id(); b.st = st;
    if (threadIdx.x == 0) (void)xb_add(&bar[XB_XCNT(b.x)], 1u);
    return b;
}
__device__ __forceinline__ void xcd_barrier_complete(unsigned* bar, unsigned x, unsigned& nloc, unsigned& nx) {
    const unsigned G = gridDim.x * gridDim.y * gridDim.z;
    unsigned sum, cnt, mine, sp = 0u;
    for (;;) {
        sum = 0u; cnt = 0u; mine = 0u;
#pragma unroll
        for (unsigned j = 0; j < 16; ++j) { const unsigned c = xb_ld(&bar[XB_XCNT(j)]); sum += c; cnt += (c > 0u) ? 1u : 0u; mine = (j == x) ? c : mine; }
        if (sum == G) break;
        __builtin_amdgcn_s_sleep(1);
        if ((++sp & 255u) == 0u) { if (xb_ld(&bar[XB_TMO])) break; if (sp > XB_SPIN_CAP) { atomicAdd(&bar[XB_TMO], 1u); break; } }
    }
    nloc = mine > 0u ? mine : 1u; nx = cnt > 0u ? cnt : 1u;
}
__device__ __forceinline__ void xcd_barrier(const XcdBarrier& b) {
    asm volatile("s_waitcnt vmcnt(0)" ::: "memory");
    __syncthreads();
    if (threadIdx.x == 0) {
        unsigned* bar = b.bar;
        __builtin_amdgcn_s_waitcnt(0);
        unsigned nloc = b.st[0], nx = b.st[1];
        if (nloc == 0u) { xcd_barrier_complete(bar, b.x, nloc, nx); b.st[0] = nloc; b.st[1] = nx; }
        const unsigned old = xb_add(&bar[XB_XSUB(b.x)], 1u);
        const unsigned gen = old / nloc;
        if (old + 1u == (gen + 1u) * nloc) {
            __builtin_amdgcn_fence(__ATOMIC_RELEASE, "agent");
            asm volatile("s_waitcnt vmcnt(0)" ::: "memory");
            const unsigned og = xb_add(&bar[XB_TOP], 1u);
            const unsigned tg = og / nx;
            if (og + 1u == (tg + 1u) * nx) xb_add(&bar[XB_TOPGEN], 1u);
            else XB_SPIN(xb_ld(&bar[XB_TOPGEN]) == tg, bar);
            __builtin_amdgcn_fence(__ATOMIC_ACQUIRE, "agent");
            xb_add(&bar[XB_XGEN(b.x)], 1u);
            asm volatile("s_waitcnt vmcnt(0)" ::: "memory");
        } else {
            XB_SPIN(xb_ld(&bar[XB_XGEN(b.x)]) == gen, bar);
            __builtin_amdgcn_fence(__ATOMIC_ACQUIRE, "agent");
            asm volatile("s_waitcnt vmcnt(0)" ::: "memory");
        }
    }
    __syncthreads();
}

struct Args { const float* in[13]; float* out; unsigned char* ws; };

__device__ __forceinline__ float wave_sum(float v) {
#pragma unroll
    for (int o = 1; o < 64; o <<= 1) v += __shfl_xor(v, o);
    return v;
}
template <int MAP> __device__ __forceinline__ int rowmap(int n) {
    if (MAP == 1) {
        if (n < C_V) { const int d = n & 127; if (d < 32) { const int e = d & 15, p = ((e >> 2) << 3) + ((d >> 4) << 2) + (e & 3); return n - d + p; } }
        return n;
    }
    if (MAP == 2) {
        if (n < FF) return ((n >> 7) << 8) + (n & 127);
        const int h = n - FF; return ((h >> 7) << 8) + 128 + (h & 127);
    }
    return n;
}
template <int MAP>
__device__ __forceinline__ void transpose_item(const float* W, int K, int N, bf16_t* WT, int row_off, LAS float* scr, int item, int lane) {
    asm volatile("" : "+v"(lane));
    const int nblk = N / 32, kb = item / nblk, nb = item - kb * nblk, k0 = 64 * kb, n0 = 32 * nb;
#pragma unroll 8
    for (int i = 0; i < 32; ++i) { const int kk = 2 * i + (lane >> 5); scr[kk * 33 + (lane & 31)] = W[(size_t)(k0 + kk) * N + n0 + (lane & 31)]; }
    LDS_WAIT(); asm volatile("" ::: "memory");
    const int c = lane & 7;
#pragma unroll
    for (int j = 0; j < 4; ++j) { const int n = (lane >> 3) + 8 * j; const LAS float* s = scr + (8 * c) * 33 + n;
        u32x4 o; o.x = cvt_pk_bf16(s[0 * 33], s[1 * 33]); o.y = cvt_pk_bf16(s[2 * 33], s[3 * 33]); o.z = cvt_pk_bf16(s[4 * 33], s[5 * 33]); o.w = cvt_pk_bf16(s[6 * 33], s[7 * 33]);
        *(GAS u32x4*)(WT + (size_t)(row_off + rowmap<MAP>(n0 + n)) * K + k0 + 8 * c) = o; }
    LDS_WAIT(); asm volatile("" ::: "memory");
}
__device__ __forceinline__ void rms_row_to_bf16(const float* xrow, const float* g, bf16_t* orow, int lane) {
    asm volatile("" : "+v"(lane));
    const GAS f32x4* xr = (const GAS f32x4*)xrow + lane; const GAS f32x4* gr = (const GAS f32x4*)g + lane;
    f32x4 v[16]; float s = 0.f;
#pragma unroll
    for (int j = 0; j < 16; ++j) { v[j] = xr[64 * j]; s += (v[j].x * v[j].x + v[j].y * v[j].y) + (v[j].z * v[j].z + v[j].w * v[j].w); }
    const float rstd = 1.0f / sqrtf(wave_sum(s) * (1.f / DM) + RMS_EPS);
    GAS unsigned long long* o8 = (GAS unsigned long long*)orow + lane;
#pragma unroll
    for (int j = 0; j < 16; ++j) { const f32x4 gv = gr[64 * j];
        o8[64 * j] = (unsigned long long)cvt_pk_bf16(v[j].x * rstd * gv.x, v[j].y * rstd * gv.y) | ((unsigned long long)cvt_pk_bf16(v[j].z * rstd * gv.z, v[j].w * rstd * gv.w) << 32); }
}
__device__ __forceinline__ void rms_row_to_f32(const float* xrow, const float* g, float* orow, int lane, bool poison) {
    asm volatile("" : "+v"(lane));
    const GAS f32x4* xr = (const GAS f32x4*)xrow + lane; const GAS f32x4* gr = (const GAS f32x4*)g + lane;
    f32x4 v[16]; float s = 0.f;
#pragma unroll
    for (int j = 0; j < 16; ++j) { v[j] = xr[64 * j]; s += (v[j].x * v[j].x + v[j].y * v[j].y) + (v[j].z * v[j].z + v[j].w * v[j].w); }
    float rstd = 1.0f / sqrtf(wave_sum(s) * (1.f / DM) + RMS_EPS);
    if (poison) rstd = __builtin_nanf("");
    GAS f32x4* o4 = (GAS f32x4*)orow + lane;
#pragma unroll
    for (int j = 0; j < 16; ++j) { const f32x4 gv = gr[64 * j]; o4[64 * j] = v[j] * rstd * gv; }
}
__device__ __forceinline__ void sincos_tab(float ang, float& c, float& s) {
    const double a = (double)ang;
    const double k = __builtin_rint(a * 0.63661977236758134308);
    const double r = __builtin_fma(-k, 6.12323399573676603587e-17, __builtin_fma(-k, 1.57079632679489655800, a));
    const double r2 = r * r;
    double sp = -1.0 / 1307674368000.0; sp = sp * r2 + 1.0 / 6227020800.0; sp = sp * r2 - 1.0 / 39916800.0; sp = sp * r2 + 1.0 / 362880.0; sp = sp * r2 - 1.0 / 5040.0; sp = sp * r2 + 1.0 / 120.0; sp = sp * r2 - 1.0 / 6.0; sp = sp * r2 + 1.0;
    const double sn = sp * r;
    double cp = 1.0 / 20922789888000.0; cp = cp * r2 - 1.0 / 87178291200.0; cp = cp * r2 + 1.0 / 479001600.0; cp = cp * r2 - 1.0 / 3628800.0; cp = cp * r2 + 1.0 / 40320.0; cp = cp * r2 - 1.0 / 720.0; cp = cp * r2 + 1.0 / 24.0; cp = cp * r2 - 0.5; cp = cp * r2 + 1.0;
    const int q = ((int)k) & 3;
    const double cs = (q == 0) ? cp : (q == 1) ? -sn : (q == 2) ? -cp : sn;
    const double ss = (q == 0) ? sn : (q == 1) ? cp : (q == 2) ? -sn : -cp;
    c = (float)cs; s = (float)ss;
}
__device__ __forceinline__ float inv_freq_of(int i) {
    switch (i) {
        case 0: return 0x1.000000p+0f; case 1: return 0x1.c2ef78p-2f; case 2: return 0x1.8d2760p-3f; case 3: return 0x1.5dc95ap-4f;
        case 4: return 0x1.341190p-5f; case 5: return 0x1.0f5386p-6f; case 6: return 0x1.ddee9ep-8f; case 7: return 0x1.a4ee40p-9f;
        case 8: return 0x1.72ba42p-10f; case 9: return 0x1.46831ap-11f; case 10: return 0x1.1f91f0p-12f; case 11: return 0x1.fa8b86p-14f;
        case 12: return 0x1.be218cp-15f; case 13: return 0x1.88ec20p-16f; case 14: return 0x1.5a0f4ep-17f; default: return 0x1.30c94ep-18f;
    }
}

__global__ void __launch_bounds__(NWAVES * 64, 2) fwd_kernel(Args args) {
    extern __shared__ __attribute__((aligned(16))) unsigned char lds[];
    LAS unsigned char* const L = (LAS unsigned char*)lds;
    volatile LAS unsigned* const MISC = (volatile LAS unsigned*)(L + MISC_OFF);
    const int tid = threadIdx.x, lane = tid & 63, wave = __builtin_amdgcn_readfirstlane(tid >> 6);
    const int G = gridDim.x; const int bx = blockIdx.x; const int vcu = (G % 8 == 0) ? (bx % 8) * (G / 8) + bx / 8 : bx;
    unsigned char* const ws = args.ws;
    gu32* const ctl = (gu32*)(ws + WS_CTL);
    for (int u = tid; u < (LDS_BYTES - LDSCTL_OFF) / 4; u += NWAVES * 64) ((LAS unsigned*)(L + LDSCTL_OFF))[u] = 0u;
    __syncthreads();
    const XcdBarrier bar = xcd_barrier_post((unsigned*)(ctl + CW_BAR), MISC + 8);
#define GRID_BAR() xcd_barrier(bar)
    const int gw = vcu * NWAVES + wave, NGW = G * NWAVES;
    const int gt = vcu * (NWAVES * 64) + tid, NGT = G * NWAVES * 64;

    float* const cosT = (float*)(ws + WS_ROT); float* const sinT = cosT + SEQ * 16;
    bf16_t* const H = (bf16_t*)(ws + WS_H); bf16_t* const PROJ = (bf16_t*)(ws + WS_PROJ); bf16_t* const ATTO = (bf16_t*)(ws + WS_ATTO);
    bf16_t* const POOLED = (bf16_t*)(ws + WS_POOLED); bf16_t* const MIXED = (bf16_t*)(ws + WS_MIXED); bf16_t* const MERGED = (bf16_t*)(ws + WS_MERGED);
    float* const X = (float*)(ws + WS_X); bf16_t* const ACT = (bf16_t*)(ws + WS_ACT);

    {
        LAS float* scr = (LAS float*)(L + wave * 16384);
        constexpr int I_IN = (DM / 64) * (NIN / 32), I_PW = (512 / 64) * (512 / 32), I_BR = (AW / 64) * (DM / 32), I_OUT = (DM / 64) * (DM / 32), I_GU = (DM / 64) * (NGU / 32), I_DN = (FF / 64) * (DM / 32);
        constexpr int I_LAYER = I_IN + 4 * I_PW + 2 * I_BR + I_OUT + I_GU + I_DN;
        for (int it = gw; it < DEPTH * I_LAYER; it += NGW) {
            const int l = it / I_LAYER; int r = it - l * I_LAYER;
            unsigned char* wl = ws + WS_W + (size_t)l * W_LAYER;
            if (r < I_IN) { transpose_item<1>(args.in[2] + (size_t)l * DM * NIN, DM, NIN, (bf16_t*)(wl + WO_IN), 0, scr, r, lane); continue; } r -= I_IN;
            if (r < 4 * I_PW) { const int g = r / I_PW; transpose_item<0>(args.in[4] + ((size_t)l * 4 + g) * 512 * 512, 512, 512, (bf16_t*)(wl + WO_POOL), g * 512, scr, r - g * I_PW, lane); continue; } r -= 4 * I_PW;
            if (r < I_BR) { transpose_item<0>(args.in[6] + (size_t)l * AW * DM, AW, DM, (bf16_t*)(wl + WO_BA), 0, scr, r, lane); continue; } r -= I_BR;
            if (r < I_BR) { transpose_item<0>(args.in[7] + (size_t)l * PW * DM, PW, DM, (bf16_t*)(wl + WO_BP), 0, scr, r, lane); continue; } r -= I_BR;
            if (r < I_OUT) { transpose_item<0>(args.in[8] + (size_t)l * DM * DM, DM, DM, (bf16_t*)(wl + WO_OUT), 0, scr, r, lane); continue; } r -= I_OUT;
            if (r < I_GU) { transpose_item<2>(args.in[10] + (size_t)l * DM * NGU, DM, NGU, (bf16_t*)(wl + WO_GU), 0, scr, r, lane); continue; } r -= I_GU;
            transpose_item<0>(args.in[11] + (size_t)l * FF * DM, FF, DM, (bf16_t*)(wl + WO_DN), 0, scr, r, lane);
        }
        for (int e = gt; e < SEQ * 16; e += NGT) { const int pos = e >> 4, i = e & 15; float c, s; sincos_tab((float)pos * inv_freq_of(i), c, s); cosT[e] = c; sinT[e] = s; }
        for (int m = gw; m < M; m += NGW) rms_row_to_bf16(args.in[0] + (size_t)m * DM, args.in[1], H + (size_t)m * DM, lane);
    }
    GRID_BAR();

    for (int l = 0; l < DEPTH; ++l) {
        unsigned char* const wl = ws + WS_W + (size_t)l * W_LAYER;
#if (PHMASK >> 1) & 1
        {
            pg8::SchedPlain S; S.T.init(M / 256, NIN / 256, G, bx); S.A = (const char*)H; S.B = (const char*)(wl + WO_IN); S.tA = (size_t)256 * DM * 2; S.tB = (size_t)256 * DM * 2; S.nt = DM / 64;
            pg8::EpiIn E{PROJ, cosT, sinT};
            pg8::gemm_phase<pg8::EpiIn, pg8::SchedPlain>(L, DM, DM, S, E);
        }
#endif
        GRID_BAR();
#if (PHMASK >> 2) & 1
        {
            const float* sink = args.in[3] + l * NHEAD;
            constexpr int NITEMS = BATCH * NHEAD * (SEQ / 256);
            for (int Li = bx; Li < NITEMS; Li += G) {
                const int qb_ = Li & 7, h_ = (Li >> 3) & 15, b_ = Li >> 7; const size_t r0_ = (size_t)b_ * SEQ;
                attn::BlockRef cur;
                cur.Q = PROJ + (r0_ + qb_ * 256) * NIN + C_Q + h_ * HD; cur.K = PROJ + r0_ * NIN + C_K + (h_ >> 2) * HD; cur.V = PROJ + r0_ * NIN + C_V + (h_ >> 2) * HD;
                cur.O = ATTO + (r0_ + qb_ * 256) * AW + h_ * HD; cur.P0 = qb_ * 256; cur.msink = sink[h_] * 11.313708498984761f;
                attn::attn_block(cur, (char*)lds);
            }
            int gtp = gt; asm volatile("" : "+v"(gtp));
            for (int idx = gtp; idx < M * (PW / 8); idx += NGT) {
                const int row = idx >> 8, ch8 = idx & 255, half = 1 << (ch8 >> 6), t = row & (SEQ - 1);
                const int lo = (t - half) > 0 ? (t - half) : 0, hi = (t + half - 1) < (SEQ - 1) ? (t + half - 1) : (SEQ - 1);
                const bf16_t* base = PROJ + (size_t)(row - t) * NIN + C_U + ch8 * 8;
                float a[8] = {0.f, 0.f, 0.f, 0.f, 0.f, 0.f, 0.f, 0.f};
                for (int j = lo; j <= hi; ++j) { const u32x4 w = *(const u32x4*)(base + (size_t)j * NIN);
                    a[0] += bf_lo(w.x); a[1] += bf_hi(w.x); a[2] += bf_lo(w.y); a[3] += bf_hi(w.y); a[4] += bf_lo(w.z); a[5] += bf_hi(w.z); a[6] += bf_lo(w.w); a[7] += bf_hi(w.w); }
                const u32x4 own = *(const u32x4*)(base + (size_t)t * NIN);
                const float inv = 1.0f / (float)(hi - lo + 1);
                u32x4 o; o.x = cvt_pk_bf16(a[0] * inv - bf_lo(own.x), a[1] * inv - bf_hi(own.x)); o.y = cvt_pk_bf16(a[2] * inv - bf_lo(own.y), a[3] * inv - bf_hi(own.y));
                o.z = cvt_pk_bf16(a[4] * inv - bf_lo(own.z), a[5] * inv - bf_hi(own.z)); o.w = cvt_pk_bf16(a[6] * inv - bf_lo(own.w), a[7] * inv - bf_hi(own.w));
                *(u32x4*)(POOLED + (size_t)row * PW + ch8 * 8) = o;
            }
        }
#endif
        GRID_BAR();
#if (PHMASK >> 3) & 1
        {
            pg8::SchedPool S; S.T.init(M / 256, PW / 256, G, bx); S.A = (const char*)POOLED; S.B = (const char*)(wl + WO_POOL); S.tA = (size_t)256 * PW * 2; S.tB = (size_t)256 * 512 * 2; S.nt = 512 / 64;
            pg8::EpiPool E{MIXED, args.in[5] + (size_t)l * PW};
            pg8::gemm_phase<pg8::EpiPool, pg8::SchedPool>(L, PW, 512, S, E);
        }
#endif
        GRID_BAR();
#if (PHMASK >> 4) & 1
        {
            pg8::SchedBranch S; S.T.init(M / 256, DM / 256, G, bx); S.A1 = (const char*)ATTO; S.B1 = (const char*)(wl + WO_BA); S.A2 = (const char*)MIXED; S.B2 = (const char*)(wl + WO_BP);
            S.tA = (size_t)256 * AW * 2; S.tB = (size_t)256 * AW * 2; S.nt = AW / 64;
            pg8::EpiBranch E{PROJ, MERGED};
            pg8::gemm_phase<pg8::EpiBranch, pg8::SchedBranch>(L, AW, AW, S, E);
        }
#endif
        GRID_BAR();
#if (PHMASK >> 5) & 1
        {
            pg8::SchedPlain S; S.T.init(M / 256, DM / 256, G, bx); S.A = (const char*)MERGED; S.B = (const char*)(wl + WO_OUT); S.tA = (size_t)256 * DM * 2; S.tB = (size_t)256 * DM * 2; S.nt = DM / 64;
            pg8::EpiRes E{l == 0 ? args.in[0] : (const float*)X, X};
            pg8::gemm_phase<pg8::EpiRes, pg8::SchedPlain>(L, DM, DM, S, E);
        }
#endif
        GRID_BAR();
#if (PHMASK >> 6) & 1
        for (int m = gw; m < M; m += NGW) rms_row_to_bf16(X + (size_t)m * DM, args.in[9] + (size_t)l * DM, H + (size_t)m * DM, lane);
#endif
        GRID_BAR();
#if (PHMASK >> 7) & 1
        {
            pg8::SchedPlain S; S.T.init(M / 256, NGU / 256, G, bx); S.A = (const char*)H; S.B = (const char*)(wl + WO_GU); S.tA = (size_t)256 * DM * 2; S.tB = (size_t)256 * DM * 2; S.nt = DM / 64;
            pg8::EpiGU E{ACT};
            pg8::gemm_phase<pg8::EpiGU, pg8::SchedPlain>(L, DM, DM, S, E);
        }
#endif
        GRID_BAR();
#if (PHMASK >> 8) & 1
        {
            pg8::SchedPlain S; S.T.init(M / 256, DM / 256, G, bx); S.A = (const char*)ACT; S.B = (const char*)(wl + WO_DN); S.tA = (size_t)256 * FF * 2; S.tB = (size_t)256 * FF * 2; S.nt = FF / 64;
            pg8::EpiRes E{X, X};
            pg8::gemm_phase<pg8::EpiRes, pg8::SchedPlain>(L, FF, FF, S, E);
        }
#endif
        GRID_BAR();
#if (PHMASK >> 9) & 1
        if (l + 1 < DEPTH) {
            for (int m = gw; m < M; m += NGW) rms_row_to_bf16(X + (size_t)m * DM, args.in[1] + (size_t)(l + 1) * DM, H + (size_t)m * DM, lane);
            GRID_BAR();
        } else {
            const bool poison = xb_ld((unsigned*)(ctl + CW_BAR) + XB_TMO) != 0u;
            for (int m = gw; m < M; m += NGW) rms_row_to_f32(X + (size_t)m * DM, args.in[12], args.out + (size_t)m * DM, lane, poison);
        }
#endif
    }
#undef GRID_BAR
}

extern "C" void kernel_launch(void* const* d_in, const int* in_sizes, int n_in, void* d_out, int out_size, void* d_ws, size_t ws_size, hipStream_t stream) {
    static int grid = 0;
    if (grid == 0) {
        if (n_in != 13 || in_sizes[0] != M * DM || out_size != M * DM || ws_size < WS_END) {
            fprintf(stderr, "kernel_launch: unexpected shapes (n_in %d, in0 %d, out %d, ws %zu, need %zu); nothing launched\n", n_in, n_in > 0 ? in_sizes[0] : -1, out_size, ws_size, (size_t)WS_END); grid = -1; return; }
        int dev = 0, cus = 0, per_cu = 0;
        if (hipGetDevice(&dev) != hipSuccess || hipDeviceGetAttribute(&cus, hipDeviceAttributeMultiprocessorCount, dev) != hipSuccess) { fprintf(stderr, "kernel_launch: device query failed\n"); grid = -1; return; }
        if (hipFuncSetAttribute((const void*)fwd_kernel, hipFuncAttributeMaxDynamicSharedMemorySize, LDS_BYTES) != hipSuccess) { fprintf(stderr, "kernel_launch: hipFuncSetAttribute failed\n"); grid = -1; return; }
        if (hipOccupancyMaxActiveBlocksPerMultiprocessor(&per_cu, (const void*)fwd_kernel, NWAVES * 64, LDS_BYTES) != hipSuccess || per_cu < 1)
            fprintf(stderr, "kernel_launch: note: occupancy query reports %d workgroups per CU\n", per_cu);
        (void)hipGetLastError();
        grid = cus;
    }
    if (grid < 0) return;
    if (hipMemsetAsync((char*)d_ws + WS_CTL, 0, CTL_ZERO_BYTES, stream) != hipSuccess) { fprintf(stderr, "kernel_launch: memset failed\n"); return; }
    Args a{};
    for (int i = 0; i < 13; ++i) a.in[i] = (const float*)d_in[i];
    a.out = (float*)d_out; a.ws = (unsigned char*)d_ws;
    hipLaunchKernelGGL(fwd_kernel, dim3(grid), dim3(NWAVES * 64), LDS_BYTES, stream, a);
    const hipError_t le = hipPeekAtLastError();
    if (le != hipSuccess) fprintf(stderr, "kernel_launch: launch failed: %s\n", hipGetErrorName(le));
}
```

```cpp
#include <hip/hip_runtime.h>
#include <hip/hip_bf16.h>
#include <cstdio>
#include <cstdint>
#ifndef REPMASK
#define REPMASK 0
#endif
#define REPEAT(k) _Pragma("unroll") for (int rep_ = 0; rep_ < 1 + ((REPMASK >> (k)) & 1); ++rep_)

#define GAS __attribute__((address_space(1)))
#define LAS __attribute__((address_space(3)))
typedef unsigned short bf16_t;
typedef short bf16x8 __attribute__((ext_vector_type(8)));
typedef short s16x4 __attribute__((ext_vector_type(4)));
typedef float f32x4 __attribute__((ext_vector_type(4)));
typedef float f32x16 __attribute__((ext_vector_type(16)));
typedef unsigned u32x4 __attribute__((ext_vector_type(4)));
typedef GAS unsigned gu32;

constexpr int BATCH = 4, SEQ = 2048, M = BATCH * SEQ, DM = 4096, NHEAD = 16, NKVH = 4, HD = 128, DEPTH = 2;
constexpr int AW = 2048, KVW = 512, PW = 2048, NIN = 13312, FF = 11008, NGU = 2 * FF;
constexpr int C_Q = 0, C_K = 2048, C_V = 2560, C_U = 3072, C_GA = 5120, C_GB = 9216;
constexpr float RMS_EPS = 1e-6f;

constexpr size_t MiB = 1u << 20;
constexpr size_t WS_CTL = 0, CTL_ZERO_BYTES = 1 * MiB;
constexpr size_t WS_ROT = 1 * MiB;
constexpr size_t WS_W = 2 * MiB;
constexpr size_t WO_IN = 0, WO_POOL = 104 * MiB, WO_BA = 106 * MiB, WO_BP = 122 * MiB, WO_OUT = 138 * MiB, WO_GU = 170 * MiB, WO_DN = 342 * MiB, W_LAYER = 428 * MiB;
static_assert((size_t)NIN * DM * 2 <= WO_POOL - WO_IN && (size_t)NGU * DM * 2 <= WO_DN - WO_GU && (size_t)DM * FF * 2 <= W_LAYER - WO_DN, "weight map");
constexpr size_t WS_ACTS = WS_W + DEPTH * W_LAYER;
constexpr size_t WS_H = WS_ACTS, WS_PROJ = WS_H + 64 * MiB, WS_ATTO = WS_PROJ + 208 * MiB, WS_POOLED = WS_ATTO + 32 * MiB, WS_MIXED = WS_POOLED + 32 * MiB,
                 WS_MERGED = WS_MIXED + 32 * MiB, WS_X = WS_MERGED + 64 * MiB, WS_ACT = WS_X + 128 * MiB, WS_END = WS_ACT + 172 * MiB;
static_assert((size_t)M * NIN * 2 <= 208 * MiB && (size_t)M * FF * 2 <= 172 * MiB, "activation map");
constexpr int CW_SSQ = 16384;
constexpr int CW_BAR = 4096;

constexpr int RING_BYTES = 131072, LDSCTL_OFF = 139264, MISC_OFF = LDSCTL_OFF + 320, LDS_BYTES = 147456;
constexpr int NWAVES = 8;

#define LDS_WAIT() asm volatile("s_waitcnt lgkmcnt(0)" ::: "memory")
#define VM_WAIT() asm volatile("s_waitcnt vmcnt(0)" ::: "memory")
__device__ __forceinline__ unsigned cvt_pk_bf16(float lo, float hi) { unsigned r; asm volatile("v_cvt_pk_bf16_f32 %0, %1, %2" : "=v"(r) : "v"(lo), "v"(hi)); return r; }
__device__ __forceinline__ float bf_lo(unsigned w) { return __uint_as_float(w << 16); }
__device__ __forceinline__ float bf_hi(unsigned w) { return __uint_as_float(w & 0xffff0000u); }
__device__ __forceinline__ float fast_sigmoid(float x) { return __builtin_amdgcn_rcpf(1.0f + __builtin_amdgcn_exp2f(-1.4426950408889634f * x)); }

namespace pg8 {
constexpr int BM = 256, BK = 64, HALF = 128, HTB = HALF * BK * 2, STAGE_BYTES = 8 * HTB, NXCD = 8, WGM = 8;
__host__ __device__ __forceinline__ int lds_byte(int r, int c) { const int st = (r >> 4) * 2 + (c >> 5), rr = r & 15, cc = c & 31, ob = rr * 64 + cc * 2; return st * 1024 + (ob ^ (((ob >> 9) & 1) << 5)); }
__host__ __device__ __forceinline__ void stage_rc(int b, int& R, int& C) { const int st = b / 1024, sb = b % 1024, swz = sb ^ (((sb >> 9) & 1) << 5); R = (st >> 1) * 16 + swz / 64; C = (st & 1) * 32 + (swz % 64) / 2; }
__host__ __device__ __forceinline__ int perm32(int rho) { const int n = rho >> 4, i = rho & 15; return 8 * (i >> 2) + 4 * n + (i & 3); }

struct UnitD { const char* A; const char* B; int pm, pn, nt, kind; };

struct TileOrder {
    int nM, nN, nwg, G, c;
    __device__ __forceinline__ void init(int nM_, int nN_, int G_, int c_) { nM = nM_; nN = nN_; nwg = nM * nN; G = G_; c = c_; }
    __device__ __forceinline__ bool tile(int i, int& pm, int& pn) const {
        const long L = (long)i * G + c; if (L >= nwg) return false;
        int wgid = (int)L; { const int q = nwg / NXCD, r = nwg % NXCD, xcd = wgid % NXCD, off = wgid / NXCD; wgid = (xcd < r ? xcd * (q + 1) : r * (q + 1) + (xcd - r) * q) + off; }
        const int nig = WGM * nN, gid = wgid / nig, fm = gid * WGM, gsz = (nM - fm) < WGM ? (nM - fm) : WGM;
        pm = fm + ((wgid % nig) % gsz); pn = (wgid % nig) / gsz; return true;
    }
};
struct SchedPlain {
    TileOrder T; const char* A; const char* B; size_t tA, tB; int nt;
    __device__ __forceinline__ bool next(int i, UnitD& u) const { int pm, pn; if (!T.tile(i, pm, pn)) return false; u.pm = pm; u.pn = pn; u.A = A + (size_t)pm * tA; u.B = B + (size_t)pn * tB; u.nt = nt; u.kind = 0; return true; }
};
struct SchedPool {
    TileOrder T; const char* A; const char* B; size_t tA, tB; int nt;
    __device__ __forceinline__ bool next(int i, UnitD& u) const { int pm, pn; if (!T.tile(i, pm, pn)) return false; u.pm = pm; u.pn = pn; u.A = A + (size_t)pm * tA + (size_t)(pn >> 1) * 1024; u.B = B + (size_t)pn * tB; u.nt = nt; u.kind = 0; return true; }
};
struct SchedBranch {
    TileOrder T; const char* A1; const char* B1; const char* A2; const char* B2; size_t tA, tB; int nt;
    __device__ __forceinline__ bool next(int i, UnitD& u) const { int pm, pn; if (!T.tile(i >> 1, pm, pn)) return false; const int s = i & 1; u.pm = pm; u.pn = pn;
        u.A = (s ? A2 : A1) + (size_t)pm * tA; u.B = (s ? B2 : B1) + (size_t)pn * tB; u.nt = nt; u.kind = s; return true; }
};

template <class Epi, class Sched>
__device__ __forceinline__ void gemm_phase(LAS unsigned char* lds, const int lda, const int ldb, const Sched& S, const Epi& E) {
    int tid = threadIdx.x; asm volatile("" : "+v"(tid));
    const int wid = __builtin_amdgcn_readfirstlane(tid >> 6), lane = tid & 63, wr = wid >> 2, wc = wid & 3, fr = lane & 15, fq = lane >> 4;
    unsigned voffA[2], voffB[2];
#pragma unroll
    for (int i = 0; i < 2; ++i) { int R, C; stage_rc(tid * 16 + i * 8192, R, C); const int Rb = Epi::PERM ? ((R & ~31) + perm32(R & 31)) : R;
        voffA[i] = (unsigned)(R * lda + C) * 2u; voffB[i] = (unsigned)(Rb * ldb + C) * 2u; }
    const size_t kstep = (size_t)(BK * 2);
    const size_t hstepA = (size_t)HALF * lda * 2, hstepB = (size_t)HALF * ldb * 2;
    const unsigned ldsw = (unsigned)wid * 1024u;
    const int aoff = lds_byte(wr * 64 + fr, fq * 8), boff = lds_byte(wc * 32 + fr, fq * 8);
#define PG8_SA(b, h) (((b) * 2 + (h)) * HTB)
#define PG8_SB(b, h) ((4 + (b) * 2 + (h)) * HTB)
#define PG8_STAGE(bufoff, gbase, voff) do { _Pragma("unroll") for (int _i = 0; _i < 2; ++_i) \
        __builtin_amdgcn_global_load_lds((const unsigned*)((const char*)(gbase) + (voff)[_i]), (LAS unsigned*)(lds + (bufoff) + ldsw + _i * 8192), 16, 0, 0); } while (0)
#define PG8_LDA(dst, b, h) do { _Pragma("unroll") for (int m = 0; m < 4; ++m) _Pragma("unroll") for (int k = 0; k < 2; ++k) dst[m][k] = *(const LAS bf16x8*)(lds + PG8_SA(b, h) + aoff + m * 2048 + k * 1024); } while (0)
#define PG8_LDB(dst, b, h) do { _Pragma("unroll") for (int n = 0; n < 2; ++n) _Pragma("unroll") for (int k = 0; k < 2; ++k) dst[n][k] = *(const LAS bf16x8*)(lds + PG8_SB(b, h) + boff + n * 2048 + k * 1024); } while (0)
#define PG8_MMA(ai, bj, At, Bt) do { __builtin_amdgcn_s_setprio(1); _Pragma("unroll") for (int m = 0; m < 4; ++m) _Pragma("unroll") for (int n = 0; n < 2; ++n) _Pragma("unroll") for (int k = 0; k < 2; ++k) \
        acc[ai][bj][m][n] = __builtin_amdgcn_mfma_f32_16x16x32_bf16(Bt[n][k], At[m][k], acc[ai][bj][m][n], 0, 0, 0); __builtin_amdgcn_s_setprio(0); } while (0)
#define PG8_WAIT_V(n) asm volatile("s_waitcnt vmcnt(" #n ")" ::: "memory")
#define PG8_WAIT_L(n) asm volatile("s_waitcnt lgkmcnt(" #n ")" ::: "memory")
#define PG8_BAR __builtin_amdgcn_s_barrier()
#define PG8_SCHED __builtin_amdgcn_sched_barrier(0)
#define PG8_ZERO() do { _Pragma("unroll") for (int a = 0; a < 2; ++a) _Pragma("unroll") for (int b = 0; b < 2; ++b) _Pragma("unroll") for (int m = 0; m < 4; ++m) _Pragma("unroll") for (int n = 0; n < 2; ++n) acc[a][b][m][n] = (f32x4){0.f, 0.f, 0.f, 0.f}; } while (0)
    UnitD cur, nxt; int ui = 0;
    if (!S.next(0, cur)) return;
    f32x4 acc[2][2][4][2];
    PG8_ZERO();
    bf16x8 At[4][2], B0[2][2], B1[2][2];
    const char* cA = cur.A; const char* cB = cur.B;
    PG8_STAGE(PG8_SB(0, 0), cB, voffB); PG8_STAGE(PG8_SB(0, 1), cB + hstepB, voffB); PG8_STAGE(PG8_SA(0, 0), cA, voffA); PG8_STAGE(PG8_SA(0, 1), cA + hstepA, voffA);
    if (wr == 1) PG8_BAR;
    PG8_WAIT_V(2); PG8_BAR;
    PG8_STAGE(PG8_SB(1, 0), cB + kstep, voffB); PG8_STAGE(PG8_SA(1, 0), cA + kstep, voffA); PG8_STAGE(PG8_SB(1, 1), cB + hstepB + kstep, voffB);
    PG8_WAIT_V(6); PG8_BAR;
    for (;;) {
        const bool has_next = S.next(ui + 1, nxt);
        const char* nA = has_next ? nxt.A : cA; const char* nB = has_next ? nxt.B : cB;
        const int nt = cur.nt;
        for (int t = 0; t < nt; t += 2) {
            const bool last = (t == nt - 2);
            const char* a1 = cA + (size_t)(t + 1) * kstep;
            const char* a2 = last ? nA : cA + (size_t)(t + 2) * kstep; const char* b2 = last ? nB : cB + (size_t)(t + 2) * kstep;
            const char* a3 = a2 + kstep; const char* b3 = b2 + kstep;
            PG8_LDB(B0, 0, 0); PG8_LDB(B1, 0, 1); PG8_SCHED; PG8_LDA(At, 0, 0); PG8_STAGE(PG8_SA(1, 1), a1 + hstepA, voffA);
            PG8_WAIT_V(8); PG8_WAIT_L(0); PG8_BAR; PG8_MMA(0, 0, At, B0); PG8_MMA(0, 1, At, B1); PG8_BAR; PG8_SCHED;
            PG8_LDA(At, 0, 1); PG8_STAGE(PG8_SB(0, 0), b2, voffB); PG8_STAGE(PG8_SB(0, 1), b2 + hstepB, voffB); PG8_STAGE(PG8_SA(0, 0), a2, voffA);
            PG8_WAIT_V(8); PG8_WAIT_L(0); PG8_BAR; PG8_MMA(1, 0, At, B0); PG8_MMA(1, 1, At, B1); PG8_BAR; PG8_SCHED;
            PG8_LDB(B0, 1, 0); PG8_LDB(B1, 1, 1); PG8_SCHED; PG8_LDA(At, 1, 0); PG8_STAGE(PG8_SA(0, 1), a2 + hstepA, voffA);
            PG8_WAIT_V(8); PG8_WAIT_L(0); PG8_BAR; PG8_MMA(0, 0, At, B0); PG8_MMA(0, 1, At, B1); PG8_BAR; PG8_SCHED;
            PG8_LDA(At, 1, 1); PG8_STAGE(PG8_SB(1, 0), b3, voffB); PG8_STAGE(PG8_SB(1, 1), b3 + hstepB, voffB); PG8_STAGE(PG8_SA(1, 0), a3, voffA);
            PG8_WAIT_V(8); PG8_WAIT_L(0); PG8_BAR; PG8_MMA(1, 0, At, B0); PG8_MMA(1, 1, At, B1); PG8_BAR; PG8_SCHED;
        }
        if (wr == 0) PG8_BAR;
        const bool keep = E(acc, cur, wr, wc, fr, fq);
        if (!has_next) break;
        if (!keep) PG8_ZERO();
        cur = nxt; cA = nA; cB = nB; ++ui;
        if (wr == 1) PG8_BAR;
    }
    PG8_WAIT_V(0);
    PG8_BAR;
#undef PG8_SA
#undef PG8_SB
#undef PG8_STAGE
#undef PG8_LDA
#undef PG8_LDB
#undef PG8_MMA
#undef PG8_WAIT_V
#undef PG8_WAIT_L
#undef PG8_BAR
#undef PG8_SCHED
#undef PG8_ZERO
}

struct EpiIn {
    static constexpr bool PERM = true;
    bf16_t* P; const float* cosT; const float* sinT; const float* ssq;
    __device__ __forceinline__ bool operator()(f32x4 (&acc)[2][2][4][2], const UnitD& u, int wr, int wc, int fr, int fq) const {
        const int row0 = u.pm * 256 + wr * 64 + fr, col0 = u.pn * 256 + wc * 32 + 8 * fq;
        const int mode = (u.pn < 10) ? ((wc == 0) ? 1 : 0) : ((u.pn >= 20) ? 2 : 0);
#pragma unroll
        for (int ai = 0; ai < 2; ++ai)
#pragma unroll
            for (int m = 0; m < 4; ++m) {
                const int row = row0 + ai * 128 + m * 16;
                f32x4 v[2][2];
                const float rs = __builtin_amdgcn_rsqf(ssq[row] * (1.f / DM) + RMS_EPS);
#pragma unroll
                for (int bj = 0; bj < 2; ++bj) { v[bj][0] = acc[ai][bj][m][0] * rs; v[bj][1] = acc[ai][bj][m][1] * rs; }
                if (mode == 1) {
                    const int pos = row & (SEQ - 1);
                    const f32x4 c = *(const f32x4*)(cosT + pos * 16 + 4 * fq), s = *(const f32x4*)(sinT + pos * 16 + 4 * fq);
#pragma unroll
                    for (int bj = 0; bj < 2; ++bj) { const f32x4 a = v[bj][0], b = v[bj][1]; v[bj][0] = a * c - b * s; v[bj][1] = b * c + a * s; }
                } else if (mode == 2) {
#pragma unroll
                    for (int bj = 0; bj < 2; ++bj)
#pragma unroll
                        for (int n = 0; n < 2; ++n)
#pragma unroll
                            for (int j = 0; j < 4; ++j) v[bj][n][j] = fast_sigmoid(v[bj][n][j]);
                }
                bf16_t* rowp = P + (size_t)row * NIN + col0;
#pragma unroll
                for (int bj = 0; bj < 2; ++bj) { u32x4 w; w.x = cvt_pk_bf16(v[bj][0][0], v[bj][0][1]); w.y = cvt_pk_bf16(v[bj][0][2], v[bj][0][3]); w.z = cvt_pk_bf16(v[bj][1][0], v[bj][1][1]); w.w = cvt_pk_bf16(v[bj][1][2], v[bj][1][3]);
                    *(u32x4*)(rowp + bj * 128) = w; }
            }
        return false;
    }
};
struct EpiPool {
    static constexpr bool PERM = true;
    bf16_t* O; const float* scale;
    __device__ __forceinline__ bool operator()(f32x4 (&acc)[2][2][4][2], const UnitD& u, int wr, int wc, int fr, int fq) const {
        const int row0 = u.pm * 256 + wr * 64 + fr, col0 = u.pn * 256 + wc * 32 + 8 * fq;
        f32x4 sc[2][2];
#pragma unroll
        for (int bj = 0; bj < 2; ++bj)
#pragma unroll
            for (int n = 0; n < 2; ++n) sc[bj][n] = *(const f32x4*)(scale + col0 + bj * 128 + 4 * n);
#pragma unroll
        for (int ai = 0; ai < 2; ++ai)
#pragma unroll
            for (int m = 0; m < 4; ++m) { bf16_t* rowp = O + (size_t)(row0 + ai * 128 + m * 16) * PW + col0;
#pragma unroll
                for (int bj = 0; bj < 2; ++bj) { const f32x4 v0 = acc[ai][bj][m][0] * sc[bj][0], v1 = acc[ai][bj][m][1] * sc[bj][1];
                    u32x4 w; w.x = cvt_pk_bf16(v0[0], v0[1]); w.y = cvt_pk_bf16(v0[2], v0[3]); w.z = cvt_pk_bf16(v1[0], v1[1]); w.w = cvt_pk_bf16(v1[2], v1[3]);
                    *(u32x4*)(rowp + bj * 128) = w; } }
        return false;
    }
};
struct EpiBranch {
    static constexpr bool PERM = true;
    const bf16_t* P; bf16_t* O;
    __device__ __forceinline__ bool operator()(f32x4 (&acc)[2][2][4][2], const UnitD& u, int wr, int wc, int fr, int fq) const {
        const int row0 = u.pm * 256 + wr * 64 + fr, col0 = u.pn * 256 + wc * 32 + 8 * fq;
        if (u.kind == 0) {
#pragma unroll
            for (int ai = 0; ai < 2; ++ai)
#pragma unroll
                for (int m = 0; m < 4; ++m) { const bf16_t* rowp = P + (size_t)(row0 + ai * 128 + m * 16) * NIN + col0;
#pragma unroll
                    for (int bj = 0; bj < 2; ++bj) { const u32x4 a = *(const u32x4*)(rowp + C_GA + bj * 128), b = *(const u32x4*)(rowp + C_GB + bj * 128);
                        f32x4 r0, r1;
                        r0[0] = bf_lo(a.x) * __builtin_amdgcn_rcpf(fmaxf(bf_lo(b.x), 1e-20f)); r0[1] = bf_hi(a.x) * __builtin_amdgcn_rcpf(fmaxf(bf_hi(b.x), 1e-20f));
                        r0[2] = bf_lo(a.y) * __builtin_amdgcn_rcpf(fmaxf(bf_lo(b.y), 1e-20f)); r0[3] = bf_hi(a.y) * __builtin_amdgcn_rcpf(fmaxf(bf_hi(b.y), 1e-20f));
                        r1[0] = bf_lo(a.z) * __builtin_amdgcn_rcpf(fmaxf(bf_lo(b.z), 1e-20f)); r1[1] = bf_hi(a.z) * __builtin_amdgcn_rcpf(fmaxf(bf_hi(b.z), 1e-20f));
                        r1[2] = bf_lo(a.w) * __builtin_amdgcn_rcpf(fmaxf(bf_lo(b.w), 1e-20f)); r1[3] = bf_hi(a.w) * __builtin_amdgcn_rcpf(fmaxf(bf_hi(b.w), 1e-20f));
                        acc[ai][bj][m][0] = acc[ai][bj][m][0] * r0; acc[ai][bj][m][1] = acc[ai][bj][m][1] * r1; }
                    asm volatile("" ::: "memory"); }
            return true;
        }
#pragma unroll
        for (int ai = 0; ai < 2; ++ai)
#pragma unroll
            for (int m = 0; m < 4; ++m) { const bf16_t* rowp = P + (size_t)(row0 + ai * 128 + m * 16) * NIN + col0; bf16_t* outp = O + (size_t)(row0 + ai * 128 + m * 16) * DM + col0;
#pragma unroll
                for (int bj = 0; bj < 2; ++bj) { const u32x4 b = *(const u32x4*)(rowp + C_GB + bj * 128);
                    f32x4 s0, s1;
                    s0[0] = fmaxf(bf_lo(b.x), 1e-20f); s0[1] = fmaxf(bf_hi(b.x), 1e-20f); s0[2] = fmaxf(bf_lo(b.y), 1e-20f); s0[3] = fmaxf(bf_hi(b.y), 1e-20f);
                    s1[0] = fmaxf(bf_lo(b.z), 1e-20f); s1[1] = fmaxf(bf_hi(b.z), 1e-20f); s1[2] = fmaxf(bf_lo(b.w), 1e-20f); s1[3] = fmaxf(bf_hi(b.w), 1e-20f);
                    const f32x4 v0 = acc[ai][bj][m][0] * s0, v1 = acc[ai][bj][m][1] * s1;
                    u32x4 w; w.x = cvt_pk_bf16(v0[0], v0[1]); w.y = cvt_pk_bf16(v0[2], v0[3]); w.z = cvt_pk_bf16(v1[0], v1[1]); w.w = cvt_pk_bf16(v1[2], v1[3]);
                    *(u32x4*)(outp + bj * 128) = w; }
                asm volatile("" ::: "memory"); }
        return false;
    }
};
struct EpiRes {
    static constexpr bool PERM = true;
    const float* xin32; bf16_t* xb; float* xout32; float* ssq;
    __device__ __forceinline__ bool operator()(f32x4 (&acc)[2][2][4][2], const UnitD& u, int wr, int wc, int fr, int fq) const {
        const int row0 = u.pm * 256 + wr * 64 + fr, col0 = u.pn * 256 + wc * 32 + 8 * fq;
#pragma unroll
        for (int ai = 0; ai < 2; ++ai)
#pragma unroll
            for (int m = 0; m < 4; ++m) { const int row = row0 + ai * 128 + m * 16; const size_t off = (size_t)row * DM + col0; float ss = 0.f;
#pragma unroll
                for (int bj = 0; bj < 2; ++bj) { f32x4 x0, x1;
                    if (xin32) { x0 = *(const f32x4*)(xin32 + off + bj * 128); x1 = *(const f32x4*)(xin32 + off + bj * 128 + 4); }
                    else { const u32x4 w = *(const u32x4*)(xb + off + bj * 128); x0 = (f32x4){bf_lo(w.x), bf_hi(w.x), bf_lo(w.y), bf_hi(w.y)}; x1 = (f32x4){bf_lo(w.z), bf_hi(w.z), bf_lo(w.w), bf_hi(w.w)}; }
                    x0 = x0 + acc[ai][bj][m][0]; x1 = x1 + acc[ai][bj][m][1];
                    ss += (x0[0] * x0[0] + x0[1] * x0[1]) + (x0[2] * x0[2] + x0[3] * x0[3]) + (x1[0] * x1[0] + x1[1] * x1[1]) + (x1[2] * x1[2] + x1[3] * x1[3]);
                    if (xout32) { *(f32x4*)(xout32 + off + bj * 128) = x0; *(f32x4*)(xout32 + off + bj * 128 + 4) = x1; }
                    else { u32x4 w; w.x = cvt_pk_bf16(x0[0], x0[1]); w.y = cvt_pk_bf16(x0[2], x0[3]); w.z = cvt_pk_bf16(x1[0], x1[1]); w.w = cvt_pk_bf16(x1[2], x1[3]); *(u32x4*)(xb + off + bj * 128) = w; } }
                ss += __shfl_xor(ss, 16); ss += __shfl_xor(ss, 32);
                if (fq == 0) __hip_atomic_fetch_add(ssq + row, ss, __ATOMIC_RELAXED, __HIP_MEMORY_SCOPE_AGENT);
                asm volatile("" ::: "memory"); }
        return false;
    }
};
struct EpiGU {
    static constexpr bool PERM = true;
    bf16_t* O; const float* ssq;
    __device__ __forceinline__ bool operator()(f32x4 (&acc)[2][2][4][2], const UnitD& u, int wr, int wc, int fr, int fq) const {
        const int row0 = u.pm * 256 + wr * 64 + fr, col0 = u.pn * 128 + wc * 32 + 8 * fq;
#pragma unroll
        for (int ai = 0; ai < 2; ++ai)
#pragma unroll
            for (int m = 0; m < 4; ++m) { f32x4 v[2]; const float rs = __builtin_amdgcn_rsqf(ssq[row0 + ai * 128 + m * 16] * (1.f / DM) + RMS_EPS);
#pragma unroll
                for (int n = 0; n < 2; ++n)
#pragma unroll
                    for (int j = 0; j < 4; ++j) { const float g = acc[ai][0][m][n][j] * rs; v[n][j] = g * fast_sigmoid(g) * (acc[ai][1][m][n][j] * rs); }
                u32x4 w; w.x = cvt_pk_bf16(v[0][0], v[0][1]); w.y = cvt_pk_bf16(v[0][2], v[0][3]); w.z = cvt_pk_bf16(v[1][0], v[1][1]); w.w = cvt_pk_bf16(v[1][2], v[1][3]);
                *(u32x4*)(O + (size_t)(row0 + ai * 128 + m * 16) * FF + col0) = w; }
        return false;
    }
};
}

namespace attn {
constexpr int D = 128, NW = 8, QBLK = 32, KVBLK = 64, QB = NW * QBLK, WIN = 128;
constexpr int SHM_V = KVBLK * D * 2, SHM_K = KVBLK * D * 2;
constexpr int LDS_BYTES = 2 * SHM_V + 2 * SHM_K + NW * 64 * 4;
constexpr int LDQ = NIN, LDKV = NIN, LDO = AW;
constexpr float SCALE = 0.08838834764831845f;
constexpr float THR = 8.f;
#define KSWZ(row, colB) ((row) * 256 + ((colB) ^ (((row) & 7) << 4)))
#define SBAR() __builtin_amdgcn_sched_barrier(0)
__device__ __forceinline__ int v_st(int k, int c) { const int kk = (k & ~0xC) | ((k & 4) << 1) | ((k & 8) >> 1); return ((kk >> 3) * 4 + (c >> 5)) * 512 + ((kk & 7) * 32 + (c & 31)) * 2; }
__device__ __forceinline__ int v_rd_base(int lane) { return ((lane & 3) << 3) | (((lane >> 2) & 3) << 6) | (((lane >> 4) & 1) << 5) | (((lane >> 5) & 1) << 8); }
constexpr int v_rd_off(int d0, int ks, int half) { return d0 * 512 + ks * 4096 + half * 2048; }
__device__ __forceinline__ int crow(int r, int hi) { return (r & 3) + 8 * (r >> 2) + 4 * hi; }
__device__ __forceinline__ unsigned cvtpk(float lo, float hi) { unsigned r; asm volatile("v_cvt_pk_bf16_f32 %0, %1, %2" : "=v"(r) : "v"(lo), "v"(hi)); return r; }
__device__ __forceinline__ bf16x8 load8(const bf16_t* p) { return *reinterpret_cast<const bf16x8*>(p); }
__device__ __forceinline__ void mask_tile(f32x16& p0, f32x16& p1, int dq) {
    const float NEG = -__builtin_inff();
#pragma unroll
    for (int r = 0; r < 16; ++r) {
        const int c = (r & 3) + 8 * (r >> 2);
        if ((unsigned)(dq - c) >= (unsigned)(2 * WIN + 1)) p0[r] = NEG;
        if ((unsigned)(dq - c - 32) >= (unsigned)(2 * WIN + 1)) p1[r] = NEG;
    }
}
__device__ __forceinline__ void partialSM(f32x16& p0, f32x16& p1, float& m_reg, float& mn, float& alpha) {
    float pmax = p0[0]; for (int r = 1; r < 16; ++r) pmax = fmaxf(pmax, p0[r]); for (int r = 0; r < 16; ++r) pmax = fmaxf(pmax, p1[r]);
    { auto rr = __builtin_amdgcn_permlane32_swap(__float_as_uint(pmax), __float_as_uint(pmax), false, false);
      pmax = fmaxf(__uint_as_float(rr[0]), __uint_as_float(rr[1])); }
    constexpr float C2 = 1.4426950408889634f * SCALE;
    if (__builtin_expect(__all((pmax - m_reg) * SCALE <= THR), 1)) { mn = m_reg; alpha = 1.f; }
    else { mn = fmaxf(m_reg, pmax); alpha = __builtin_amdgcn_exp2f((m_reg - mn) * C2); m_reg = mn; }
    const float mnL = -mn * C2;
    for (int r = 0; r < 16; ++r) p0[r] = fmaf(p0[r], C2, mnL); for (int r = 0; r < 16; ++r) p1[r] = fmaf(p1[r], C2, mnL);
    for (int r = 0; r < 16; ++r) p0[r] = __builtin_amdgcn_exp2f(p0[r]);
}
__device__ __forceinline__ void finishSM(f32x16& p0, f32x16& p1, float alpha, float& l_reg, bf16x8& pa0, bf16x8& pa1, bf16x8& pa2, bf16x8& pa3) {
    for (int r = 0; r < 16; ++r) p1[r] = __builtin_amdgcn_exp2f(p1[r]);
    float ps = 0; for (int r = 0; r < 16; ++r) ps += p0[r]; for (int r = 0; r < 16; ++r) ps += p1[r];
    { auto rr = __builtin_amdgcn_permlane32_swap(__float_as_uint(ps), __float_as_uint(ps), false, false);
      ps = __uint_as_float(rr[0]) + __uint_as_float(rr[1]); }
    l_reg = l_reg * alpha + ps;
#define PK4(P, B_, OUT) do { unsigned a0 = cvtpk(P[B_+0], P[B_+1]), a1 = cvtpk(P[B_+2], P[B_+3]);                          \
        unsigned b0 = cvtpk(P[B_+4], P[B_+5]), b1 = cvtpk(P[B_+6], P[B_+7]);                                             \
        auto r0 = __builtin_amdgcn_permlane32_swap(a0, b0, false, false); auto r1 = __builtin_amdgcn_permlane32_swap(a1, b1, false, false); \
        u32x4 w = {r0[0], r1[0], r0[1], r1[1]}; OUT = *reinterpret_cast<bf16x8*>(&w); } while (0)
    PK4(p0, 0, pa0); PK4(p0, 8, pa1); PK4(p1, 0, pa2); PK4(p1, 8, pa3);
#undef PK4
}
template <int KB>
__device__ __forceinline__ void qkt(f32x16& p0, f32x16& p1, const char* K_lds, int r32, int hi, const char* q_lds, bool act) {
    if (!act) { const float NEG = -__builtin_inff();
#pragma unroll
        for (int r = 0; r < 16; ++r) { p0[r] = NEG; p1[r] = NEG; } return; }
    p0 = f32x16{}; p1 = f32x16{};
    const char* kb[4];
#pragma unroll
    for (int dd = 0; dd < 4; ++dd) kb[dd] = K_lds + KB * SHM_K + KSWZ(r32, (dd * 16 + hi * 8) * 2);
#pragma unroll
    for (int d0 = 0; d0 < 8; ++d0) { const char* a = kb[d0 & 3] + (d0 >> 2) * 128;
        bf16x8 b0 = *reinterpret_cast<const bf16x8*>(a);
        bf16x8 b1 = *reinterpret_cast<const bf16x8*>(a + 32 * 256);
        bf16x8 q = *reinterpret_cast<const bf16x8*>(q_lds + d0 * 1024);
        p0 = __builtin_amdgcn_mfma_f32_32x32x16_bf16(b0, q, p0, 0, 0, 0);
        p1 = __builtin_amdgcn_mfma_f32_32x32x16_bf16(b1, q, p1, 0, 0, 0); }
}
template <int VB>
__device__ __forceinline__ void pv_tile(f32x16* o, int vb0, bf16x8 pa0, bf16x8 pa1, bf16x8 pa2, bf16x8 pa3, bool act) {
    if (!act) return;
#define TRRD(dst, off) asm volatile("ds_read_b64_tr_b16 %0, %1 offset:%2" : "=&v"(dst) : "v"(vb0), "i"(off) : "memory")
#define PV_D0(d0) do { s16x4 l0, l1, l2, l3, h0, h1, h2, h3; constexpr int b_ = VB * SHM_V + v_rd_off(d0, 0, 0);   \
        TRRD(l0, b_); TRRD(h0, b_ + 2048); TRRD(l1, b_ + 4096); TRRD(h1, b_ + 6144); TRRD(l2, b_ + 8192); TRRD(h2, b_ + 10240); TRRD(l3, b_ + 12288); TRRD(h3, b_ + 14336); \
        asm volatile("s_waitcnt lgkmcnt(0)" ::: "memory"); SBAR();   \
        o[d0] = __builtin_amdgcn_mfma_f32_32x32x16_bf16(pa0, (bf16x8){l0[0], l0[1], l0[2], l0[3], h0[0], h0[1], h0[2], h0[3]}, o[d0], 0, 0, 0);   \
        o[d0] = __builtin_amdgcn_mfma_f32_32x32x16_bf16(pa1, (bf16x8){l1[0], l1[1], l1[2], l1[3], h1[0], h1[1], h1[2], h1[3]}, o[d0], 0, 0, 0);   \
        o[d0] = __builtin_amdgcn_mfma_f32_32x32x16_bf16(pa2, (bf16x8){l2[0], l2[1], l2[2], l2[3], h2[0], h2[1], h2[2], h2[3]}, o[d0], 0, 0, 0);   \
        o[d0] = __builtin_amdgcn_mfma_f32_32x32x16_bf16(pa3, (bf16x8){l3[0], l3[1], l3[2], l3[3], h3[0], h3[1], h3[2], h3[3]}, o[d0], 0, 0, 0); } while (0)
    PV_D0(0); PV_D0(1); PV_D0(2); PV_D0(3);
#undef PV_D0
#undef TRRD
}
struct BlockRef { const bf16_t* Q; const bf16_t* K; const bf16_t* V; bf16_t* O; int P0; float msink; };
struct Seam { bf16x8 st_v0, st_v1, st_k0, st_k1; };
constexpr int LDS_Q = LDS_BYTES;
constexpr int LDS_TOTAL = LDS_Q + NW * 8192;
__device__ __forceinline__ int jlo_of(int P0) { const int lowk = P0 - WIN; return lowk > 0 ? lowk / KVBLK : 0; }
#define ROW(p, k0, rr) ((p) + (size_t)((k0) + (rr)) * LDKV + sc)
#define VMW() asm volatile("s_waitcnt vmcnt(0)" ::: "memory")
#define SLOAD_H(Kp, Vp, k0) do { S.st_v0 = load8(ROW(Vp, k0, sr)); S.st_v1 = load8(ROW(Vp, k0, 32 + sr));              \
                         S.st_k0 = load8(ROW(Kp, k0, sr)); S.st_k1 = load8(ROW(Kp, k0, 32 + sr)); } while (0)
#define SWRITE_HK(bf) do { *(bf16x8*)(K_lds + (bf) * SHM_K + kws) = S.st_k0; *(bf16x8*)(K_lds + (bf) * SHM_K + kws + 32 * 256) = S.st_k1; } while (0)
#define SWRITE_HV(bf) do { *(bf16x8*)(V_lds + (bf) * SHM_V + vst0) = S.st_v0; *(bf16x8*)(V_lds + (bf) * SHM_V + vst1) = S.st_v1; } while (0)
#define SWRITE_H(bf) do { SWRITE_HV(bf); SWRITE_HK(bf); } while (0)
__device__ __forceinline__ void attn_block(const BlockRef& cur, char* lds) {
    int tid = threadIdx.x; asm volatile("" : "+v"(tid));
    const int wid = __builtin_amdgcn_readfirstlane(tid >> 6), lane = tid & 63, r32 = lane & 31, hi = lane >> 5;
    const int j_lo = jlo_of(cur.P0);
    int j_hi = (cur.P0 + QB - 1 + WIN) / KVBLK + 1; if (j_hi > SEQ / KVBLK) j_hi = SEQ / KVBLK;
    const int NT = j_hi - j_lo;
    const int qlo = cur.P0 + wid * QBLK, qm = qlo + r32 - 4 * hi + WIN;
    char* V_lds = lds; char* K_lds = lds + 2 * SHM_V;
    float* ws = (float*)(lds + 2 * SHM_V + 2 * SHM_K) + wid * 64; float* li_l = ws, * al_l = ws + 32;
    char* q_lds = lds + LDS_Q + wid * 8192 + lane * 16;
    float m_reg = cur.msink, l_reg = 1.f; f32x16 o[4] = {};
    const int sr = tid >> 4, sc = (tid & 15) * 8, vst0 = v_st(sr, sc), vst1 = v_st(32 + sr, sc), kws = KSWZ(sr, sc * 2);
    const int vb0 = (int)(uintptr_t)V_lds + v_rd_base(lane);
    const bf16_t* Kh = cur.K; const bf16_t* Vh = cur.V;
    Seam S;
#define KBASE(t) ((j_lo + (t)) * KVBLK)
    {
        SLOAD_H(Kh, Vh, KBASE(0));
#pragma unroll
        for (int d0 = 0; d0 < 8; ++d0) { const bf16x8 q = load8(cur.Q + (size_t)(wid * QBLK + r32) * LDQ + d0 * 16 + hi * 8); *reinterpret_cast<bf16x8*>(q_lds + d0 * 1024) = q; }
        VMW(); SWRITE_HK(0);
        __syncthreads();
    }
#define RESC(a) do { if (__any((a) < 1.f)) { if (hi == 0) al_l[r32] = (a); asm volatile("s_waitcnt lgkmcnt(0)" ::: "memory");              \
                     for (int d_ = 0; d_ < 4; ++d_) for (int r = 0; r < 16; ++r) o[d_][r] *= al_l[crow(r, hi)]; } } while (0)
#define ACT(t) (KBASE(t) <= qlo + QBLK - 1 + WIN && KBASE(t) + KVBLK - 1 >= qlo - WIN)
#define MASKT(P0_, P1_, t) do { const int kb_ = KBASE(t); if (ACT(t) && (kb_ + KVBLK - 1 > qlo + WIN || kb_ < qlo + QBLK - 1 - WIN)) mask_tile(P0_, P1_, qm - kb_); } while (0)
    f32x16 pA0, pA1, pB0, pB1; float mnA, mnB, alA, alB; bf16x8 pa0, pa1, pa2, pa3;
    SWRITE_HV(0); SBAR();
    if (NT > 1) { SLOAD_H(Kh, Vh, KBASE(1)); }
    SBAR(); qkt<0>(pA0, pA1, K_lds, r32, hi, q_lds, ACT(0));
    MASKT(pA0, pA1, 0); partialSM(pA0, pA1, m_reg, mnA, alA);
    if (NT > 1) { VMW(); SWRITE_H(1); }
    __syncthreads();
#define HALF_STEP(PX0, PX1, mnX, alX, PY0, PY1, alY, t, KB, VB, SB) do {                                                      \
        SBAR(); qkt<KB>(PX0, PX1, K_lds, r32, hi, q_lds, ACT(t));                                                \
        finishSM(PY0, PY1, alY, l_reg, pa0, pa1, pa2, pa3); SBAR();                                                           \
        if ((t) + 1 < NT) { SLOAD_H(Kh, Vh, KBASE((t) + 1)); SBAR(); }                                                         \
        pv_tile<VB>(o, vb0, pa0, pa1, pa2, pa3, ACT((t) - 1)); MASKT(PX0, PX1, (t)); partialSM(PX0, PX1, m_reg, mnX, alX);    \
        __syncthreads();                                                                                                      \
        if ((t) + 1 < NT) { VMW(); SWRITE_H(SB); }                                                                            \
        RESC(alX); __syncthreads(); } while (0)
    for (int t = 1; t + 1 < NT; t += 2) {
        HALF_STEP(pB0, pB1, mnB, alB, pA0, pA1, alA, t, 1, 0, 0);
        HALF_STEP(pA0, pA1, mnA, alA, pB0, pB1, alB, t + 1, 0, 1, 1);
    }
    const bool even = (NT & 1) == 0;
    if (even) { SBAR(); qkt<1>(pB0, pB1, K_lds, r32, hi, q_lds, ACT(NT - 1)); SBAR(); }
    finishSM(pA0, pA1, alA, l_reg, pa0, pa1, pa2, pa3); SBAR();
    pv_tile<0>(o, vb0, pa0, pa1, pa2, pa3, ACT(even ? NT - 2 : NT - 1));
    if (even) { MASKT(pB0, pB1, NT - 1); partialSM(pB0, pB1, m_reg, mnB, alB); __syncthreads(); RESC(alB);
        finishSM(pB0, pB1, alB, l_reg, pa0, pa1, pa2, pa3); SBAR(); pv_tile<1>(o, vb0, pa0, pa1, pa2, pa3, ACT(NT - 1)); }
    SBAR();
    if (hi == 0) li_l[r32] = l_reg; asm volatile("s_waitcnt lgkmcnt(0)" ::: "memory");
    float rli[16];
#pragma unroll
    for (int r = 0; r < 16; ++r) rli[r] = __builtin_amdgcn_rcpf(li_l[crow(r, hi)]);
    bf16_t* Ow = cur.O + (size_t)(wid * QBLK) * LDO;
#pragma unroll
    for (int r = 0; r < 16; ++r) { const int orow = crow(r, hi);
#pragma unroll
        for (int d0 = 0; d0 < 4; ++d0) { const float v = o[d0][r] * rli[r];
            const float vn = __shfl_xor(v, 1);
            if ((r32 & 1) == 0) *(unsigned*)(Ow + (size_t)orow * LDO + d0 * 32 + r32) = cvtpk(v, vn); } }
    __syncthreads();
#undef RESC
#undef KBASE
#undef ACT
#undef MASKT
#undef HALF_STEP
}
#undef ROW
#undef VMW
#undef SLOAD_H
#undef SWRITE_HK
#undef SWRITE_HV
#undef SWRITE_H
#undef KSWZ
#undef SBAR
}
static_assert(attn::LDS_TOTAL <= LDSCTL_OFF && pg8::STAGE_BYTES <= LDSCTL_OFF && MISC_OFF + 128 <= LDS_BYTES, "LDS map");

#define XB_TMO      128
#define XB_XCNT(j)  (256  + 64 * (j))
#define XB_XSUB(j)  (1280 + 64 * (j))
#define XB_XGEN(j)  (2304 + 64 * (j))
#define XB_TOP      3328
#define XB_TOPGEN   3392
#define XCD_BAR_WORDS 3456
#define XB_SPIN_CAP (1u << 18)

__device__ __forceinline__ unsigned xb_ld(unsigned* p)              { return __hip_atomic_load(p, __ATOMIC_RELAXED, __HIP_MEMORY_SCOPE_AGENT); }
__device__ __forceinline__ unsigned xb_add(unsigned* p, unsigned v) { return __hip_atomic_fetch_add(p, v, __ATOMIC_RELAXED, __HIP_MEMORY_SCOPE_AGENT); }
__device__ __forceinline__ unsigned xb_xcc_id() { return (unsigned)__builtin_amdgcn_s_getreg((3 << 11) | 20) & 0xFu; }
#define XB_SPIN(cond, bar) do { unsigned _sp = 0; while (cond) { __builtin_amdgcn_s_sleep(1); \
    if ((++_sp & 255u) == 0u) { if (xb_ld(&(bar)[XB_TMO])) break; if (_sp > XB_SPIN_CAP) { atomicAdd(&(bar)[XB_TMO], 1u); break; } } } } while (0)

struct XcdBarrier {
    unsigned* bar; unsigned x;
    volatile LAS unsigned* st;
};
__device__ __forceinline__ XcdBarrier xcd_barrier_post(unsigned* bar, volatile LAS unsigned* st) {
    XcdBarrier b; b.bar = bar; b.x = xb_xcc_id(); b.st = st;
    if (threadIdx.x == 0) (void)xb_add(&bar[XB_XCNT(b.x)], 1u);
    return b;
}
__device__ __forceinline__ void xcd_barrier_complete(unsigned* bar, unsigned x, unsigned& nloc, unsigned& nx) {
    const unsigned G = gridDim.x * gridDim.y * gridDim.z;
    unsigned sum, cnt, mine, sp = 0u;
    for (;;) {
        sum = 0u; cnt = 0u; mine = 0u;
#pragma unroll
        for (unsigned j = 0; j < 16; ++j) { const unsigned c = xb_ld(&bar[XB_XCNT(j)]); sum += c; cnt += (c > 0u) ? 1u : 0u; mine = (j == x) ? c : mine; }
        if (sum == G) break;
        __builtin_amdgcn_s_sleep(1);
        if ((++sp & 255u) == 0u) { if (xb_ld(&bar[XB_TMO])) break; if (sp > XB_SPIN_CAP) { atomicAdd(&bar[XB_TMO], 1u); break; } }
    }
    nloc = mine > 0u ? mine : 1u; nx = cnt > 0u ? cnt : 1u;
}
__device__ __forceinline__ void xcd_barrier(const XcdBarrier& b) {
    asm volatile("s_waitcnt vmcnt(0)" ::: "memory");
    __syncthreads();
    if (threadIdx.x == 0) {
        unsigned* bar = b.bar; const unsigned bx_ = xb_xcc_id();
        __builtin_amdgcn_s_waitcnt(0);
        unsigned nloc = b.st[0], nx = b.st[1];
        if (nloc == 0u) { xcd_barrier_complete(bar, bx_, nloc, nx); b.st[0] = nloc; b.st[1] = nx; }
        const unsigned old = xb_add(&bar[XB_XSUB(bx_)], 1u);
        const unsigned gen = old / nloc;
        if (old + 1u == (gen + 1u) * nloc) {
            __builtin_amdgcn_fence(__ATOMIC_RELEASE, "agent");
            asm volatile("s_waitcnt vmcnt(0)" ::: "memory");
            const unsigned og = xb_add(&bar[XB_TOP], 1u);
            const unsigned tg = og / nx;
            if (og + 1u == (tg + 1u) * nx) xb_add(&bar[XB_TOPGEN], 1u);
            else XB_SPIN(xb_ld(&bar[XB_TOPGEN]) == tg, bar);
            __builtin_amdgcn_fence(__ATOMIC_ACQUIRE, "agent");
            xb_add(&bar[XB_XGEN(bx_)], 1u);
            asm volatile("s_waitcnt vmcnt(0)" ::: "memory");
        } else {
            XB_SPIN(xb_ld(&bar[XB_XGEN(bx_)]) == gen, bar);
            __builtin_amdgcn_fence(__ATOMIC_ACQUIRE, "agent");
            asm volatile("s_waitcnt vmcnt(0)" ::: "memory");
        }
    }
    __syncthreads();
}

struct Args { const float* in[13]; float* out; unsigned char* ws; };

__device__ __forceinline__ float wave_sum(float v) {
#pragma unroll
    for (int o = 1; o < 64; o <<= 1) v += __shfl_xor(v, o);
    return v;
}
template <int MAP> __device__ __forceinline__ int rowmap(int n) {
    if (MAP == 1) {
        if (n < C_V) { const int d = n & 127; if (d < 32) { const int e = d & 15, p = ((e >> 2) << 3) + ((d >> 4) << 2) + (e & 3); return n - d + p; } }
        return n;
    }
    if (MAP == 2) {
        if (n < FF) return ((n >> 7) << 8) + (n & 127);
        const int h = n - FF; return ((h >> 7) << 8) + 128 + (h & 127);
    }
    return n;
}
template <int MAP, bool GAIN>
__device__ __forceinline__ void transpose_item(const float* W, int K, int N, bf16_t* WT, int row_off, LAS float* scr, int item, int lane, const float* gain) {
    asm volatile("" : "+v"(lane));
    const int nblk = N / 32, kb = item / nblk, nb = item - kb * nblk, k0 = 64 * kb, n0 = 32 * nb;
#pragma unroll 8
    for (int i = 0; i < 32; ++i) { const int kk = 2 * i + (lane >> 5); float w = W[(size_t)(k0 + kk) * N + n0 + (lane & 31)]; if (GAIN) w *= gain[k0 + kk]; scr[kk * 33 + (lane & 31)] = w; }
    LDS_WAIT(); asm volatile("" ::: "memory");
    const int c = lane & 7;
#pragma unroll
    for (int j = 0; j < 4; ++j) { const int n = (lane >> 3) + 8 * j; const LAS float* s = scr + (8 * c) * 33 + n;
        u32x4 o; o.x = cvt_pk_bf16(s[0 * 33], s[1 * 33]); o.y = cvt_pk_bf16(s[2 * 33], s[3 * 33]); o.z = cvt_pk_bf16(s[4 * 33], s[5 * 33]); o.w = cvt_pk_bf16(s[6 * 33], s[7 * 33]);
        *(GAS u32x4*)(WT + (size_t)(row_off + rowmap<MAP>(n0 + n)) * K + k0 + 8 * c) = o; }
    LDS_WAIT(); asm volatile("" ::: "memory");
}
__device__ __forceinline__ void row_to_bf16_ssq(const float* xrow, bf16_t* orow, float* ssq_out, int lane) {
    asm volatile("" : "+v"(lane));
    const GAS f32x4* xr = (const GAS f32x4*)xrow + lane;
    f32x4 v[16]; float s = 0.f;
#pragma unroll
    for (int j = 0; j < 16; ++j) { v[j] = xr[64 * j]; s += (v[j].x * v[j].x + v[j].y * v[j].y) + (v[j].z * v[j].z + v[j].w * v[j].w); }
    s = wave_sum(s);
    if (lane == 0) *ssq_out = s;
    GAS unsigned long long* o8 = (GAS unsigned long long*)orow + lane;
#pragma unroll
    for (int j = 0; j < 16; ++j) o8[64 * j] = (unsigned long long)cvt_pk_bf16(v[j].x, v[j].y) | ((unsigned long long)cvt_pk_bf16(v[j].z, v[j].w) << 32);
}
__device__ __forceinline__ void row_final_norm(const float* xrow, const float* g, float* orow, float ssq, int lane, bool poison) {
    asm volatile("" : "+v"(lane));
    const GAS f32x4* xr = (const GAS f32x4*)xrow + lane; const GAS f32x4* gr = (const GAS f32x4*)g + lane;
    float rstd = 1.0f / sqrtf(ssq * (1.f / DM) + RMS_EPS);
    if (poison) rstd = __builtin_nanf("");
    GAS f32x4* o4 = (GAS f32x4*)orow + lane;
#pragma unroll
    for (int j = 0; j < 16; ++j) { const f32x4 xv = xr[64 * j], gv = gr[64 * j]; o4[64 * j] = xv * rstd * gv; }
}
__device__ __forceinline__ void sincos_tab(float ang, float& c, float& s) {
    const double a = (double)ang;
    const double k = __builtin_rint(a * 0.63661977236758134308);
    const double r = __builtin_fma(-k, 6.12323399573676603587e-17, __builtin_fma(-k, 1.57079632679489655800, a));
    const double r2 = r * r;
    double sp = -1.0 / 1307674368000.0; sp = sp * r2 + 1.0 / 6227020800.0; sp = sp * r2 - 1.0 / 39916800.0; sp = sp * r2 + 1.0 / 362880.0; sp = sp * r2 - 1.0 / 5040.0; sp = sp * r2 + 1.0 / 120.0; sp = sp * r2 - 1.0 / 6.0; sp = sp * r2 + 1.0;
    const double sn = sp * r;
    double cp = 1.0 / 20922789888000.0; cp = cp * r2 - 1.0 / 87178291200.0; cp = cp * r2 + 1.0 / 479001600.0; cp = cp * r2 - 1.0 / 3628800.0; cp = cp * r2 + 1.0 / 40320.0; cp = cp * r2 - 1.0 / 720.0; cp = cp * r2 + 1.0 / 24.0; cp = cp * r2 - 0.5; cp = cp * r2 + 1.0;
    const int q = ((int)k) & 3;
    const double cs = (q == 0) ? cp : (q == 1) ? -sn : (q == 2) ? -cp : sn;
    const double ss = (q == 0) ? sn : (q == 1) ? cp : (q == 2) ? -sn : -cp;
    c = (float)cs; s = (float)ss;
}
__device__ __forceinline__ float inv_freq_of(int i) {
    switch (i) {
        case 0: return 0x1.000000p+0f; case 1: return 0x1.c2ef78p-2f; case 2: return 0x1.8d2760p-3f; case 3: return 0x1.5dc95ap-4f;
        case 4: return 0x1.341190p-5f; case 5: return 0x1.0f5386p-6f; case 6: return 0x1.ddee9ep-8f; case 7: return 0x1.a4ee40p-9f;
        case 8: return 0x1.72ba42p-10f; case 9: return 0x1.46831ap-11f; case 10: return 0x1.1f91f0p-12f; case 11: return 0x1.fa8b86p-14f;
        case 12: return 0x1.be218cp-15f; case 13: return 0x1.88ec20p-16f; case 14: return 0x1.5a0f4ep-17f; default: return 0x1.30c94ep-18f;
    }
}

__global__ void __launch_bounds__(NWAVES * 64, 2) fwd_kernel(Args args) {
    extern __shared__ __attribute__((aligned(16))) unsigned char lds[];
    LAS unsigned char* const L = (LAS unsigned char*)lds;
    volatile LAS unsigned* const MISC = (volatile LAS unsigned*)(L + MISC_OFF);
    const int tid = threadIdx.x, lane = tid & 63, wave = __builtin_amdgcn_readfirstlane(tid >> 6);
    const int G = gridDim.x; const int bx = blockIdx.x; const int vcu = (G % 8 == 0) ? (bx % 8) * (G / 8) + bx / 8 : bx;
    unsigned char* const ws = args.ws;
    gu32* const ctl = (gu32*)(ws + WS_CTL);
    for (int u = tid; u < (LDS_BYTES - LDSCTL_OFF) / 4; u += NWAVES * 64) ((LAS unsigned*)(L + LDSCTL_OFF))[u] = 0u;
    __syncthreads();
    const XcdBarrier bar = xcd_barrier_post((unsigned*)(ctl + CW_BAR), MISC + 8);
#define GRID_BAR() xcd_barrier(bar)
    const int gw = vcu * NWAVES + wave, NGW = G * NWAVES;
    const int gt = vcu * (NWAVES * 64) + tid, NGT = G * NWAVES * 64;

    float* const cosT = (float*)(ws + WS_ROT); float* const sinT = cosT + SEQ * 16;
    bf16_t* const XB = (bf16_t*)(ws + WS_H); float* const SSQ = (float*)(ws + WS_CTL) + CW_SSQ;
    bf16_t* const PROJ = (bf16_t*)(ws + WS_PROJ); bf16_t* const ATTO = (bf16_t*)(ws + WS_ATTO);
    bf16_t* const POOLED = (bf16_t*)(ws + WS_POOLED); bf16_t* const MIXED = (bf16_t*)(ws + WS_MIXED); bf16_t* const MERGED = (bf16_t*)(ws + WS_MERGED);
    float* const X = (float*)(ws + WS_X); bf16_t* const ACT = (bf16_t*)(ws + WS_ACT);

    {
        LAS float* scr = (LAS float*)(L + wave * 16384);
        constexpr int I_IN = (DM / 64) * (NIN / 32), I_PW = (512 / 64) * (512 / 32), I_BR = (AW / 64) * (DM / 32), I_OUT = (DM / 64) * (DM / 32), I_GU = (DM / 64) * (NGU / 32), I_DN = (FF / 64) * (DM / 32);
        constexpr int I_LAYER = I_IN + 4 * I_PW + 2 * I_BR + I_OUT + I_GU + I_DN;
        REPEAT(0) for (int it = gw; it < DEPTH * I_LAYER; it += NGW) {
            const int l = it / I_LAYER; int r = it - l * I_LAYER;
            unsigned char* wl = ws + WS_W + (size_t)l * W_LAYER;
            if (r < I_IN) { transpose_item<1, true>(args.in[2] + (size_t)l * DM * NIN, DM, NIN, (bf16_t*)(wl + WO_IN), 0, scr, r, lane, args.in[1] + (size_t)l * DM); continue; } r -= I_IN;
            if (r < 4 * I_PW) { const int g = r / I_PW; transpose_item<0, false>(args.in[4] + ((size_t)l * 4 + g) * 512 * 512, 512, 512, (bf16_t*)(wl + WO_POOL), g * 512, scr, r - g * I_PW, lane, nullptr); continue; } r -= 4 * I_PW;
            if (r < I_BR) { transpose_item<0, false>(args.in[6] + (size_t)l * AW * DM, AW, DM, (bf16_t*)(wl + WO_BA), 0, scr, r, lane, nullptr); continue; } r -= I_BR;
            if (r < I_BR) { transpose_item<0, false>(args.in[7] + (size_t)l * PW * DM, PW, DM, (bf16_t*)(wl + WO_BP), 0, scr, r, lane, nullptr); continue; } r -= I_BR;
            if (r < I_OUT) { transpose_item<0, false>(args.in[8] + (size_t)l * DM * DM, DM, DM, (bf16_t*)(wl + WO_OUT), 0, scr, r, lane, nullptr); continue; } r -= I_OUT;
            if (r < I_GU) { transpose_item<2, true>(args.in[10] + (size_t)l * DM * NGU, DM, NGU, (bf16_t*)(wl + WO_GU), 0, scr, r, lane, args.in[9] + (size_t)l * DM); continue; } r -= I_GU;
            transpose_item<0, false>(args.in[11] + (size_t)l * FF * DM, FF, DM, (bf16_t*)(wl + WO_DN), 0, scr, r, lane, nullptr);
        }
        for (int e = gt; e < SEQ * 16; e += NGT) { const int pos = e >> 4, i = e & 15; float c, s; sincos_tab((float)pos * inv_freq_of(i), c, s); cosT[e] = c; sinT[e] = s; }
        for (int m = gw; m < M; m += NGW) row_to_bf16_ssq(args.in[0] + (size_t)m * DM, XB + (size_t)m * DM, SSQ + m, lane);
    }
    GRID_BAR();

    for (int l = 0; l < DEPTH; ++l) {
        unsigned char* const wl = ws + WS_W + (size_t)l * W_LAYER;
        REPEAT(1) {
        {
            pg8::SchedPlain S; S.T.init(M / 256, NIN / 256, G, bx); S.A = (const char*)XB; S.B = (const char*)(wl + WO_IN); S.tA = (size_t)256 * DM * 2; S.tB = (size_t)256 * DM * 2; S.nt = DM / 64;
            pg8::EpiIn E{PROJ, cosT, sinT, SSQ + (size_t)(2 * l) * M};
            pg8::gemm_phase<pg8::EpiIn, pg8::SchedPlain>(L, DM, DM, S, E);
        }
        GRID_BAR(); }
        REPEAT(2) {
        {
            const float* sink = args.in[3] + l * NHEAD;
            constexpr int NITEMS = BATCH * NHEAD * (SEQ / 256);
            for (int Li = bx; Li < NITEMS; Li += G) {
                const int qb_ = Li & 7, h_ = (Li >> 3) & 15, b_ = Li >> 7; const size_t r0_ = (size_t)b_ * SEQ;
                attn::BlockRef cur;
                cur.Q = PROJ + (r0_ + qb_ * 256) * NIN + C_Q + h_ * HD; cur.K = PROJ + r0_ * NIN + C_K + (h_ >> 2) * HD; cur.V = PROJ + r0_ * NIN + C_V + (h_ >> 2) * HD;
                cur.O = ATTO + (r0_ + qb_ * 256) * AW + h_ * HD; cur.P0 = qb_ * 256; cur.msink = sink[h_] * 11.313708498984761f;
                attn::attn_block(cur, (char*)lds);
            }
            int gtp = gt; asm volatile("" : "+v"(gtp));
            for (int idx = gtp; idx < M * (PW / 8); idx += NGT) {
                const int row = idx >> 8, ch8 = idx & 255, half = 1 << (ch8 >> 6), t = row & (SEQ - 1);
                const int lo = (t - half) > 0 ? (t - half) : 0, hi = (t + half - 1) < (SEQ - 1) ? (t + half - 1) : (SEQ - 1);
                const bf16_t* base = PROJ + (size_t)(row - t) * NIN + C_U + ch8 * 8;
                float a[8] = {0.f, 0.f, 0.f, 0.f, 0.f, 0.f, 0.f, 0.f};
                for (int j = lo; j <= hi; ++j) { const u32x4 w = *(const u32x4*)(base + (size_t)j * NIN);
                    a[0] += bf_lo(w.x); a[1] += bf_hi(w.x); a[2] += bf_lo(w.y); a[3] += bf_hi(w.y); a[4] += bf_lo(w.z); a[5] += bf_hi(w.z); a[6] += bf_lo(w.w); a[7] += bf_hi(w.w); }
                const u32x4 own = *(const u32x4*)(base + (size_t)t * NIN);
                const float inv = 1.0f / (float)(hi - lo + 1);
                u32x4 o; o.x = cvt_pk_bf16(a[0] * inv - bf_lo(own.x), a[1] * inv - bf_hi(own.x)); o.y = cvt_pk_bf16(a[2] * inv - bf_lo(own.y), a[3] * inv - bf_hi(own.y));
                o.z = cvt_pk_bf16(a[4] * inv - bf_lo(own.z), a[5] * inv - bf_hi(own.z)); o.w = cvt_pk_bf16(a[6] * inv - bf_lo(own.w), a[7] * inv - bf_hi(own.w));
                *(u32x4*)(POOLED + (size_t)row * PW + ch8 * 8) = o;
            }
        }
        GRID_BAR(); }
        REPEAT(3) {
        {
            pg8::SchedPool S; S.T.init(M / 256, PW / 256, G, bx); S.A = (const char*)POOLED; S.B = (const char*)(wl + WO_POOL); S.tA = (size_t)256 * PW * 2; S.tB = (size_t)256 * 512 * 2; S.nt = 512 / 64;
            pg8::EpiPool E{MIXED, args.in[5] + (size_t)l * PW};
            pg8::gemm_phase<pg8::EpiPool, pg8::SchedPool>(L, PW, 512, S, E);
        }
        GRID_BAR(); }
        REPEAT(4) {
        {
            pg8::SchedBranch S; S.T.init(M / 256, DM / 256, G, bx); S.A1 = (const char*)ATTO; S.B1 = (const char*)(wl + WO_BA); S.A2 = (const char*)MIXED; S.B2 = (const char*)(wl + WO_BP);
            S.tA = (size_t)256 * AW * 2; S.tB = (size_t)256 * AW * 2; S.nt = AW / 64;
            pg8::EpiBranch E{PROJ, MERGED};
            pg8::gemm_phase<pg8::EpiBranch, pg8::SchedBranch>(L, AW, AW, S, E);
        }
        GRID_BAR(); }
        REPEAT(5) {
        {
            pg8::SchedPlain S; S.T.init(M / 256, DM / 256, G, bx); S.A = (const char*)MERGED; S.B = (const char*)(wl + WO_OUT); S.tA = (size_t)256 * DM * 2; S.tB = (size_t)256 * DM * 2; S.nt = DM / 64;
            pg8::EpiRes E{l == 0 ? args.in[0] : nullptr, XB, nullptr, SSQ + (size_t)(2 * l + 1) * M};
            pg8::gemm_phase<pg8::EpiRes, pg8::SchedPlain>(L, DM, DM, S, E);
        }
        GRID_BAR(); }
        REPEAT(7) {
        {
            pg8::SchedPlain S; S.T.init(M / 256, NGU / 256, G, bx); S.A = (const char*)XB; S.B = (const char*)(wl + WO_GU); S.tA = (size_t)256 * DM * 2; S.tB = (size_t)256 * DM * 2; S.nt = DM / 64;
            pg8::EpiGU E{ACT, SSQ + (size_t)(2 * l + 1) * M};
            pg8::gemm_phase<pg8::EpiGU, pg8::SchedPlain>(L, DM, DM, S, E);
        }
        GRID_BAR(); }
        REPEAT(8) {
        {
            pg8::SchedPlain S; S.T.init(M / 256, DM / 256, G, bx); S.A = (const char*)ACT; S.B = (const char*)(wl + WO_DN); S.tA = (size_t)256 * FF * 2; S.tB = (size_t)256 * FF * 2; S.nt = FF / 64;
            pg8::EpiRes E{nullptr, XB, (l + 1 < DEPTH) ? nullptr : X, SSQ + (size_t)(2 * l + 2) * M};
            pg8::gemm_phase<pg8::EpiRes, pg8::SchedPlain>(L, FF, FF, S, E);
        }
        GRID_BAR(); }
        if (l + 1 == DEPTH) {
            const bool poison = xb_ld((unsigned*)(ctl + CW_BAR) + XB_TMO) != 0u;
            const float* sq = SSQ + (size_t)(2 * DEPTH) * M;
            for (int m = gw; m < M; m += NGW) row_final_norm(X + (size_t)m * DM, args.in[12], args.out + (size_t)m * DM, sq[m], lane, poison);
        }
    }
#undef GRID_BAR
}

extern "C" void kernel_launch(void* const* d_in, const int* in_sizes, int n_in, void* d_out, int out_size, void* d_ws, size_t ws_size, hipStream_t stream) {
    static int grid = 0;
    if (grid == 0) {
        if (n_in != 13 || in_sizes[0] != M * DM || out_size != M * DM || ws_size < WS_END) {
            fprintf(stderr, "kernel_launch: unexpected shapes (n_in %d, in0 %d, out %d, ws %zu, need %zu); nothing launched\n", n_in, n_in > 0 ? in_sizes[0] : -1, out_size, ws_size, (size_t)WS_END); grid = -1; return; }
        int dev = 0, cus = 0, per_cu = 0;
        if (hipGetDevice(&dev) != hipSuccess || hipDeviceGetAttribute(&cus, hipDeviceAttributeMultiprocessorCount, dev) != hipSuccess) { fprintf(stderr, "kernel_launch: device query failed\n"); grid = -1; return; }
        if (hipFuncSetAttribute((const void*)fwd_kernel, hipFuncAttributeMaxDynamicSharedMemorySize, LDS_BYTES) != hipSuccess) { fprintf(stderr, "kernel_launch: hipFuncSetAttribute failed\n"); grid = -1; return; }
        if (hipOccupancyMaxActiveBlocksPerMultiprocessor(&per_cu, (const void*)fwd_kernel, NWAVES * 64, LDS_BYTES) != hipSuccess || per_cu < 1)
            fprintf(stderr, "kernel_launch: note: occupancy query reports %d workgroups per CU\n", per_cu);
        (void)hipGetLastError();
        grid = cus;
    }
    if (grid < 0) return;
    if (hipMemsetAsync((char*)d_ws + WS_CTL, 0, CTL_ZERO_BYTES, stream) != hipSuccess) { fprintf(stderr, "kernel_launch: memset failed\n"); return; }
    Args a{};
    for (int i = 0; i < 13; ++i) a.in[i] = (const float*)d_in[i];
    a.out = (float*)d_out; a.ws = (unsigned char*)d_ws;
    hipLaunchKernelGGL(fwd_kernel, dim3(grid), dim3(NWAVES * 64), LDS_BYTES, stream, a);
    const hipError_t le = hipPeekAtLastError();
    if (le != hipSuccess) fprintf(stderr, "kernel_launch: launch failed: %s\n", hipGetErrorName(le));
}
```

```cpp
#include <hip/hip_runtime.h>
#include <hip/hip_bf16.h>
#include <cstdio>
#include <cstdint>
#ifndef REPMASK
#define REPMASK 0
#endif
#define REPEAT(k) _Pragma("unroll") for (int rep_ = 0; rep_ < 1 + ((REPMASK >> (k)) & 1); ++rep_)

#define GAS __attribute__((address_space(1)))
#define LAS __attribute__((address_space(3)))
typedef unsigned short bf16_t;
typedef short bf16x8 __attribute__((ext_vector_type(8)));
typedef short s16x4 __attribute__((ext_vector_type(4)));
typedef float f32x4 __attribute__((ext_vector_type(4)));
typedef float f32x16 __attribute__((ext_vector_type(16)));
typedef unsigned u32x4 __attribute__((ext_vector_type(4)));
typedef int i32x4 __attribute__((ext_vector_type(4)));
typedef GAS unsigned gu32;

constexpr int BATCH = 4, SEQ = 2048, M = BATCH * SEQ, DM = 4096, NHEAD = 16, NKVH = 4, HD = 128, DEPTH = 2;
constexpr int AW = 2048, KVW = 512, PW = 2048, NIN = 13312, FF = 11008, NGU = 2 * FF;
constexpr int C_Q = 0, C_K = 2048, C_V = 2560, C_U = 3072, C_GA = 5120, C_GB = 9216;
constexpr float RMS_EPS = 1e-6f;

constexpr size_t MiB = 1u << 20;
constexpr size_t WS_CTL = 0, CTL_ZERO_BYTES = 1 * MiB;
constexpr size_t WS_ROT = 1 * MiB;
constexpr size_t WS_W = 2 * MiB;
constexpr size_t WO_IN = 0, WO_POOL = 108 * MiB, WO_BA = 112 * MiB, WO_BP = 130 * MiB, WO_OUT = 148 * MiB, WO_DN = 182 * MiB, W_LAYER = 274 * MiB;
static_assert((size_t)NIN * DM * 2 <= WO_POOL - WO_IN && (size_t)4 * 512 * 512 * 2 <= WO_BA - WO_POOL && (size_t)DM * AW * 2 <= WO_BP - WO_BA && (size_t)DM * DM * 2 <= WO_DN - WO_OUT && (size_t)DM * FF * 2 <= W_LAYER - WO_DN, "weight map");
constexpr size_t WS_ACTS = WS_W + DEPTH * W_LAYER;
constexpr size_t WS_H = WS_ACTS, WS_PROJ = WS_H + 64 * MiB, WS_ATTO = WS_PROJ + 208 * MiB, WS_POOLED = WS_ATTO + 32 * MiB, WS_MIXED = WS_POOLED + 32 * MiB,
                 WS_MERGED = WS_MIXED + 32 * MiB, WS_X = WS_MERGED + 64 * MiB, WS_ACT = WS_X + 128 * MiB, WS_PART = WS_ACT + 172 * MiB, WS_WQ = WS_PART + 10 * MiB, WQ_LAYER = 88 * MiB, WS_XQ = WS_WQ + DEPTH * WQ_LAYER, WS_SW = WS_XQ + 64 * MiB, WS_ROWS = WS_SW + 1 * MiB,
                 WS_WQI = WS_ROWS + 1 * MiB, WQI_LAYER = 104 * MiB, WS_SWI = WS_WQI + DEPTH * WQI_LAYER, WS_END = WS_SWI + 1 * MiB;
static_assert((size_t)NGU * DM <= WQ_LAYER && (size_t)DEPTH * NGU * 4 <= 1 * MiB && (size_t)NIN * DM <= WQI_LAYER && (size_t)DEPTH * NIN * 4 <= 1 * MiB && (size_t)M * DM * 2 <= 64 * MiB, "int8 map");
constexpr int CVT8_HOLD = 8;
constexpr int PN8 = 20;
static_assert((size_t)M * NIN * 2 <= 208 * MiB && (size_t)M * FF * 2 <= 172 * MiB, "activation map");
constexpr int CW_SSQ = 32768;
constexpr int CW_DONE = 28672;
constexpr int CW_BAR = 4096, CW_GBAR = 8192, GBAR_STRIDE = 4096;

constexpr int RING_BYTES = 131072, LDSCTL_OFF = 139264, MISC_OFF = LDSCTL_OFF + 320, LDS_BYTES = 147456;
constexpr int NWAVES = 8;

#define LDS_WAIT() asm volatile("s_waitcnt lgkmcnt(0)" ::: "memory")
#define VM_WAIT() asm volatile("s_waitcnt vmcnt(0)" ::: "memory")
__device__ __forceinline__ unsigned cvt_pk_bf16(float lo, float hi) { unsigned r; asm volatile("v_cvt_pk_bf16_f32 %0, %1, %2" : "=v"(r) : "v"(lo), "v"(hi)); return r; }
__device__ __forceinline__ float bf_lo(unsigned w) { return __uint_as_float(w << 16); }
__device__ __forceinline__ float bf_hi(unsigned w) { return __uint_as_float(w & 0xffff0000u); }
__device__ __forceinline__ int tid_of(int wave) { unsigned m = ~0u; asm volatile("" : "+s"(m)); return wave * 64 + (int)__builtin_amdgcn_mbcnt_hi(m, __builtin_amdgcn_mbcnt_lo(m, 0u)); }
template <int K> __device__ __forceinline__ float xchg(float v) { static_assert(K >= 1 && K <= 16, "xchg"); return __builtin_bit_cast(float, __builtin_amdgcn_ds_swizzle(__builtin_bit_cast(int, v), (K << 10) | 0x1f)); }
__device__ __forceinline__ float sum32(float v) { auto r = __builtin_amdgcn_permlane32_swap(__float_as_uint(v), __float_as_uint(v), false, false); const unsigned a = r[0], b = r[1]; return __uint_as_float(a) + __uint_as_float(b); }
__device__ __forceinline__ float max32(float v) { auto r = __builtin_amdgcn_permlane32_swap(__float_as_uint(v), __float_as_uint(v), false, false); const unsigned a = r[0], b = r[1]; return fmaxf(__uint_as_float(a), __uint_as_float(b)); }
__device__ __forceinline__ float wave_max(float v) { v = fmaxf(v, xchg<1>(v)); v = fmaxf(v, xchg<2>(v)); v = fmaxf(v, xchg<4>(v)); v = fmaxf(v, xchg<8>(v)); v = fmaxf(v, xchg<16>(v)); return max32(v); }
__device__ __forceinline__ float fast_sigmoid(float x) { return __builtin_amdgcn_rcpf(1.0f + __builtin_amdgcn_exp2f(-1.4426950408889634f * x)); }

namespace pg8 {
constexpr int BM = 256, BK = 64, HALF = 128, HTB = HALF * BK * 2, STAGE_BYTES = 8 * HTB, NXCD = 8, WGM = 8;
__host__ __device__ __forceinline__ int lds_byte(int r, int c) { const int st = (r >> 4) * 2 + (c >> 5), rr = r & 15, cc = c & 31, ob = rr * 64 + cc * 2; return st * 1024 + (ob ^ (((ob >> 9) & 1) << 5)); }
__host__ __device__ __forceinline__ void stage_rc(int b, int& R, int& C) { const int st = b / 1024, sb = b % 1024, swz = sb ^ (((sb >> 9) & 1) << 5); R = (st >> 1) * 16 + swz / 64; C = (st & 1) * 32 + (swz % 64) / 2; }
__host__ __device__ __forceinline__ int perm32(int rho) { const int n = rho >> 4, i = rho & 15; return 8 * (i >> 2) + 4 * n + (i & 3); }

struct UnitD { const char* A; const char* B; int pm, pn, nt, kind, slot; };

struct TileOrder {
    int nM, nN, nwg, G, c;
    __device__ __forceinline__ void init(int nM_, int nN_, int G_, int c_) { nM = nM_; nN = nN_; nwg = nM * nN; G = G_; c = c_; }
    __device__ __forceinline__ bool tile(int i, int& pm, int& pn) const {
        const long L = (long)i * G + c; if (L >= nwg) return false;
        int wgid = (int)L; { const int q = nwg / NXCD, r = nwg % NXCD, xcd = wgid % NXCD, off = wgid / NXCD; wgid = (xcd < r ? xcd * (q + 1) : r * (q + 1) + (xcd - r) * q) + off; }
        const int nig = WGM * nN, gid = wgid / nig, fm = gid * WGM, gsz = (nM - fm) < WGM ? (nM - fm) : WGM;
        pm = fm + ((wgid % nig) % gsz); pn = (wgid % nig) / gsz; return true;
    }
};
struct SchedPlain {
    TileOrder T; const char* A; const char* B; size_t tA, tB; int nt;
    __device__ __forceinline__ bool next(int i, UnitD& u) const { int pm, pn; if (!T.tile(i, pm, pn)) return false; u.pm = pm; u.pn = pn; u.A = A + (size_t)pm * tA; u.B = B + (size_t)pn * tB; u.nt = nt; u.kind = 0; return true; }
};
struct SchedPool {
    TileOrder T; const char* A; const char* B; size_t tA, tB; int nt;
    __device__ __forceinline__ bool next(int i, UnitD& u) const { int pm, pn; if (!T.tile(i, pm, pn)) return false; u.pm = pm; u.pn = pn; u.A = A + (size_t)pm * tA + (size_t)(pn >> 1) * 1024; u.B = B + (size_t)pn * tB; u.nt = nt; u.kind = 0; return true; }
};
struct SchedBranch {
    TileOrder T; const char* A1; const char* B1; const char* A2; const char* B2; size_t tA, tB; int nt;
    __device__ __forceinline__ bool next(int i, UnitD& u) const { int pm, pn; if (!T.tile(i >> 1, pm, pn)) return false; const int s = i & 1; u.pm = pm; u.pn = pn;
        u.A = (s ? A2 : A1) + (size_t)pm * tA; u.B = (s ? B2 : B1) + (size_t)pn * tB; u.nt = nt; u.kind = s; return true; }
};

}
struct Args { const float* in[13]; float* out; unsigned char* ws; };
__device__ __forceinline__ int destrow(int s) { return (s & ~31) + pg8::perm32(s & 31); }
__device__ __forceinline__ int srccol(int map, int s) {
    const int d = destrow(s);
    if (map == 1) {
        if (d < C_V) { const int p = d & 127; if (p < 32) { const int e = ((p >> 3) << 2) | (p & 3); return d - p + e + (((p >> 2) & 1) << 4); } }
        return d;
    }
    if (map == 2) {
        const int t = d >> 8, r = d & 255; return r < 128 ? (t << 7) + r : FF + (t << 7) + (r - 128);
    }
    return d;
}
constexpr int NB_IN = PN8 * 256 / 256;
constexpr int I_IN = (DM / 32) * 4 * NB_IN, I_PW = (512 / 32) * (512 / 64), I_BR = (AW / 32) * (DM / 64), I_OUT = (DM / 32) * (DM / 64), I_GU = 0, I_DN = (FF / 32) * (DM / 64);
constexpr int IO_POOL = I_IN, IO_BA = IO_POOL + 4 * I_PW, IO_BP = IO_BA + I_BR, IO_OUT = IO_BP + I_BR, IO_GU = IO_OUT + I_OUT, IO_DN = IO_GU + I_GU, I_LAYER = IO_DN + I_DN;
static_assert(I_LAYER == (PN8 == 20 ? 49152 : 45056), "item map");
struct CvtItem { const float* src; unsigned char* dst; const float* gain; int N, slot0, map, c32; };
template <unsigned KINDS>
__device__ __forceinline__ CvtItem cvt_decode(const Args& args, unsigned char* wsp, int it) {
    const int l = it / I_LAYER; int r = it - l * I_LAYER; unsigned char* wl = wsp + WS_W + (size_t)l * W_LAYER;
    const float* W = nullptr; unsigned char* D = nullptr; const float* gain = nullptr; int N = 512, K = DM, map = 0, k32 = 0, sq = 0;
    if ((KINDS & 1u) && r < IO_POOL) { k32 = r / (4 * NB_IN); sq = r - k32 * (4 * NB_IN); W = args.in[2] + (size_t)l * DM * NIN; N = NIN; D = wl + WO_IN; map = 1; gain = args.in[1] + (size_t)l * DM; }
    else if ((KINDS & 2u) && r < IO_BA) { r -= IO_POOL; const int g = r / I_PW; r -= g * I_PW; k32 = r >> 3; sq = r & 7; W = args.in[4] + ((size_t)l * 4 + g) * 512 * 512; N = 512; K = 512; D = wl + WO_POOL + (size_t)g * 512 * 512 * 2; }
    else if ((KINDS & 4u) && r < IO_BP) { r -= IO_BA; k32 = r >> 6; sq = r & 63; W = args.in[6] + (size_t)l * AW * DM; N = DM; K = AW; D = wl + WO_BA; }
    else if ((KINDS & 8u) && r < IO_OUT) { r -= IO_BP; k32 = r >> 6; sq = r & 63; W = args.in[7] + (size_t)l * PW * DM; N = DM; K = PW; D = wl + WO_BP; }
    else if ((KINDS & 16u) && r < IO_GU) { r -= IO_OUT; k32 = r >> 6; sq = r & 63; W = args.in[8] + (size_t)l * DM * DM; N = DM; D = wl + WO_OUT; }
    else if (KINDS & 64u) { r -= IO_DN; k32 = r >> 6; sq = r & 63; W = args.in[11] + (size_t)l * FF * DM; N = DM; K = FF; D = wl + WO_DN; }
    CvtItem d; d.N = N; d.slot0 = 64 * sq; d.map = map; d.c32 = k32 & 1; d.gain = gain ? gain + 32 * k32 : nullptr;
    d.src = W + (size_t)(32 * k32) * N; d.dst = D + (size_t)(sq >> 2) * ((size_t)K * 512) + (size_t)(k32 >> 1) * 32768;
    return d;
}
__device__ __forceinline__ void cvtk_load(const CvtItem& d, float (&w)[32], int lane) {
    const unsigned loff = (unsigned)srccol(d.map, d.slot0 + lane) * 4u;
#pragma unroll
    for (int j = 0; j < 32; ++j) w[j] = *(const float*)((const char*)(d.src + (size_t)j * d.N) + loff);
}
__device__ __forceinline__ float cvtk_gain_load(const CvtItem& d, int lane) { const float* gp = d.gain ? d.gain : d.src; return gp[lane & 31]; }
__device__ __forceinline__ unsigned img_seg(int r, int c32) { return (unsigned)((r >> 7) * pg8::HTB + ((((r & 127) >> 4) * 2 + c32) * 1024) + (r & 15) * 64); }
__device__ __forceinline__ void cvtk_store(const CvtItem& d, const float (&w)[32], float gl, int lane) {
    const int r = (d.slot0 & 255) + lane; const unsigned seg = img_seg(r, d.c32), x = (r & 8) ? 32u : 0u;
    const bool hg = d.gain != nullptr;
#pragma unroll
    for (int j = 0; j < 4; ++j) { float g[8];
#pragma unroll
        for (int e = 0; e < 8; ++e) { const float t = __builtin_bit_cast(float, __builtin_amdgcn_readlane(__builtin_bit_cast(int, gl), 8 * j + e)); g[e] = hg ? t : 1.f; }
        u32x4 o; o.x = cvt_pk_bf16(w[8 * j] * g[0], w[8 * j + 1] * g[1]); o.y = cvt_pk_bf16(w[8 * j + 2] * g[2], w[8 * j + 3] * g[3]); o.z = cvt_pk_bf16(w[8 * j + 4] * g[4], w[8 * j + 5] * g[5]); o.w = cvt_pk_bf16(w[8 * j + 6] * g[6], w[8 * j + 7] * g[7]);
        *(GAS u32x4*)(d.dst + seg + ((16u * j) ^ x)) = o; }
}

struct BgJob { const Args* args; unsigned char* wsp; int base, n, first, nw; };
template <unsigned KINDS> struct BgOn { static constexpr bool ON = true; static constexpr unsigned K = KINDS; };
struct BgOff { static constexpr bool ON = false; static constexpr unsigned K = 0; };
constexpr int BGN = 1;
template <unsigned KINDS>
__device__ __forceinline__ void bg_drain(const BgJob& job, int& bgk, int lane) {
    asm volatile("" : "+v"(lane));
    for (int j = job.first + bgk * job.nw; j < job.n; j += job.nw) { const CvtItem d = cvt_decode<KINDS>(*job.args, job.wsp, job.base + j); float wv[32];
        const float gl = cvtk_gain_load(d, lane); cvtk_load(d, wv, lane); asm volatile("" ::: "memory"); cvtk_store(d, wv, gl, lane); asm volatile("" ::: "memory"); ++bgk; }
}
namespace pg8 {
template <bool I8> struct AccT { typedef f32x4 type; };
template <> struct AccT<true> { typedef i32x4 type; };
__device__ __forceinline__ void mma16(f32x4& c, bf16x8 b, bf16x8 a) { c = __builtin_amdgcn_mfma_f32_16x16x32_bf16(b, a, c, 0, 0, 0); }
__device__ __forceinline__ void mma16_bf(i32x4& c, bf16x8 b, bf16x8 a) { f32x4 t = __builtin_bit_cast(f32x4, c); t = __builtin_amdgcn_mfma_f32_16x16x32_bf16(b, a, t, 0, 0, 0); c = __builtin_bit_cast(i32x4, t); }
__device__ __forceinline__ void mma16(i32x4& c, bf16x8 b, bf16x8 a) { c = __builtin_amdgcn_mfma_i32_16x16x64_i8(__builtin_bit_cast(i32x4, b), __builtin_bit_cast(i32x4, a), c, 0, 0, 0); }
template <class Epi, class Sched, class Bg = BgOff>
__device__ __forceinline__ void gemm_phase(const int wave_, LAS unsigned char* lds, const int lda, const Sched& S, const Epi& E, const BgJob* job = nullptr, int* bgkp = nullptr) {
    int tid = tid_of(wave_); asm volatile("" : "+v"(tid));
    const int wid = wave_, lane = tid & 63, wr = wid >> 2, wc = wid & 3, fr = lane & 15, fq = lane >> 4;
    unsigned voffA[2], voffB[2];
#pragma unroll
    for (int i = 0; i < 2; ++i) { int R, C; stage_rc(tid * 16 + i * 8192, R, C);
        voffA[i] = (unsigned)(R * lda + C) * 2u; voffB[i] = (unsigned)(tid * 16 + i * 8192); }
    static_assert(Epi::PERM, "the KG-major weight copies are written in PERM slot order");
    const size_t kstep = (size_t)(BK * 2), kstepB = 2 * HTB;
    const size_t hstepA = (size_t)HALF * lda * 2, hstepB = HTB;
    const unsigned ldsw = (unsigned)wid * 1024u;
    const int aoff = lds_byte(wr * 64 + fr, fq * 8), boff = lds_byte(wc * 32 + fr, fq * 8);
#define PG8_SA(b, h) (((b) * 2 + (h)) * HTB)
#define PG8_SB(b, h) ((4 + (b) * 2 + (h)) * HTB)
#define PG8_STAGE(bufoff, gbase, voff) do { _Pragma("unroll") for (int _i = 0; _i < 2; ++_i) \
        __builtin_amdgcn_global_load_lds((const unsigned*)((const char*)(gbase) + (voff)[_i]), (LAS unsigned*)(lds + (bufoff) + ldsw + _i * 8192), 16, 0, 0); } while (0)
#define PG8_LDA(dst, b, h) do { _Pragma("unroll") for (int m = 0; m < 4; ++m) _Pragma("unroll") for (int k = 0; k < 2; ++k) dst[m][k] = *(const LAS bf16x8*)(lds + PG8_SA(b, h) + aoff + m * 2048 + k * 1024); } while (0)
#define PG8_LDB(dst, b, h) do { _Pragma("unroll") for (int n = 0; n < 2; ++n) _Pragma("unroll") for (int k = 0; k < 2; ++k) dst[n][k] = *(const LAS bf16x8*)(lds + PG8_SB(b, h) + boff + n * 2048 + k * 1024); } while (0)
#define PG8_MMA(FN, ai, bj, At, Bt) do { __builtin_amdgcn_s_setprio(1); _Pragma("unroll") for (int m = 0; m < 4; ++m) _Pragma("unroll") for (int n = 0; n < 2; ++n) _Pragma("unroll") for (int k = 0; k < 2; ++k) \
        FN(acc[ai][bj][m][n], Bt[n][k], At[m][k]); __builtin_amdgcn_s_setprio(0); } while (0)
#define PG8_WAIT_V(n) asm volatile("s_waitcnt vmcnt(" #n ")" ::: "memory")
#define PG8_WAIT_L(n) asm volatile("s_waitcnt lgkmcnt(" #n ")" ::: "memory")
#define PG8_BAR __builtin_amdgcn_s_barrier()
#define PG8_SCHED __builtin_amdgcn_sched_barrier(0)
#define PG8_ZERO() do { _Pragma("unroll") for (int a = 0; a < 2; ++a) _Pragma("unroll") for (int b = 0; b < 2; ++b) _Pragma("unroll") for (int m = 0; m < 4; ++m) _Pragma("unroll") for (int n = 0; n < 2; ++n) acc[a][b][m][n] = (acc_t){0, 0, 0, 0}; } while (0)
#define PG8_KLOOP(FN) \
        for (int t = 0; t < nt; t += 2) { \
            const bool last = (t == nt - 2); \
            const char* a1 = cA + (size_t)(t + 1) * kstep; \
            const char* a2 = last ? nA : cA + (size_t)(t + 2) * kstep; const char* b2 = last ? nB : cB + (size_t)(t + 2) * kstepB; \
            const char* a3 = a2 + kstep; const char* b3 = b2 + kstepB; \
 \
            PG8_LDB(B0, 0, 0); PG8_LDB(B1, 0, 1); PG8_SCHED; PG8_LDA(At, 0, 0); PG8_STAGE(PG8_SA(1, 1), a1 + hstepA, voffA); \
            PG8_WAIT_V(8); PG8_WAIT_L(0); PG8_BAR; PG8_MMA(FN, 0, 0, At, B0); PG8_MMA(FN, 0, 1, At, B1); PG8_BAR; PG8_SCHED; \
 \
            PG8_LDA(At, 0, 1); PG8_STAGE(PG8_SB(0, 0), b2, voffB); PG8_STAGE(PG8_SB(0, 1), b2 + hstepB, voffB); PG8_STAGE(PG8_SA(0, 0), a2, voffA); \
            PG8_WAIT_V(8); PG8_WAIT_L(0); PG8_BAR; PG8_MMA(FN, 1, 0, At, B0); PG8_MMA(FN, 1, 1, At, B1); PG8_BAR; PG8_SCHED; \
 \
            PG8_LDB(B0, 1, 0); PG8_LDB(B1, 1, 1); PG8_SCHED; PG8_LDA(At, 1, 0); PG8_STAGE(PG8_SA(0, 1), a2 + hstepA, voffA); \
            PG8_WAIT_V(8); PG8_WAIT_L(0); PG8_BAR; PG8_MMA(FN, 0, 0, At, B0); PG8_MMA(FN, 0, 1, At, B1); PG8_BAR; PG8_SCHED; \
 \
            PG8_LDA(At, 1, 1); PG8_STAGE(PG8_SB(1, 0), b3, voffB); PG8_STAGE(PG8_SB(1, 1), b3 + hstepB, voffB); PG8_STAGE(PG8_SA(1, 0), a3, voffA); \
            PG8_WAIT_V(8); PG8_WAIT_L(0); PG8_BAR; PG8_MMA(FN, 1, 0, At, B0); PG8_MMA(FN, 1, 1, At, B1); PG8_BAR; PG8_SCHED; \
        }
    UnitD cur, nxt; int ui = 0;
    if (!S.next(0, cur)) return;
    typedef typename AccT<Epi::I8 || Epi::MIXED>::type acc_t;
    acc_t acc[2][2][4][2];
    bool k8 = Epi::MIXED && cur.kind != 0;
    PG8_ZERO();
    bf16x8 At[4][2], B0[2][2], B1[2][2];
    const char* cA = cur.A; const char* cB = cur.B;
    cur.slot = 0; if constexpr (Epi::PRE) E.prefetch(cur, wid, lane);
    PG8_STAGE(PG8_SB(0, 0), cB, voffB); PG8_STAGE(PG8_SB(0, 1), cB + hstepB, voffB); PG8_STAGE(PG8_SA(0, 0), cA, voffA); PG8_STAGE(PG8_SA(0, 1), cA + hstepA, voffA);
    if (wr == 1) PG8_BAR;
    PG8_WAIT_V(2); PG8_BAR;
    PG8_STAGE(PG8_SB(1, 0), cB + kstepB, voffB); PG8_STAGE(PG8_SA(1, 0), cA + kstep, voffA); PG8_STAGE(PG8_SB(1, 1), cB + hstepB + kstepB, voffB);
    PG8_WAIT_V(6); PG8_BAR;
    for (;;) {
        const bool has_next = S.next(ui + 1, nxt);
        const char* nA = has_next ? nxt.A : cA; const char* nB = has_next ? nxt.B : cB;
        const int nt = cur.nt;
        if constexpr (Epi::MIXED) { if (k8) { PG8_KLOOP(mma16) } else { PG8_KLOOP(mma16_bf) } } else { PG8_KLOOP(mma16) }
        if (wr == 0) PG8_BAR;
        float bw[BGN][32], bgl[BGN]; int bj[BGN];
        int lx = lane; asm volatile("" : "+v"(lx)); const int frx = lx & 15, fqx = lx >> 4;
        E.pre(acc, cur, wr, wc, frx, fqx);
        if constexpr (Bg::ON) { int ln = lane; asm volatile("" : "+v"(ln));
#pragma unroll
            for (int q = 0; q < BGN; ++q) { bj[q] = job->first + (*bgkp + q) * job->nw;
                if (bj[q] < job->n) { const CvtItem d = cvt_decode<Bg::K>(*job->args, job->wsp, job->base + bj[q]); bgl[q] = cvtk_gain_load(d, ln); cvtk_load(d, bw[q], ln); } }
            *bgkp += BGN; asm volatile("" ::: "memory");
        }
        const bool keep = E(acc, cur, wr, wc, frx, fqx);
        if constexpr (Bg::ON) { asm volatile("" ::: "memory"); int ln = lane; asm volatile("" : "+v"(ln));
#pragma unroll
            for (int q = 0; q < BGN; ++q) if (bj[q] < job->n) { const CvtItem d = cvt_decode<Bg::K>(*job->args, job->wsp, job->base + bj[q]); cvtk_store(d, bw[q], bgl[q], ln); }
            asm volatile("" ::: "memory"); }
        if (!has_next) break;
        if (!keep) PG8_ZERO();
        cur = nxt; cA = nA; cB = nB; ++ui; k8 = Epi::MIXED && cur.kind != 0;
        cur.slot = ui & 1; if constexpr (Epi::PRE) E.prefetch(cur, wid, lane);
        if (wr == 1) PG8_BAR;
    }
    PG8_WAIT_V(0);
    PG8_BAR;
#undef PG8_SA
#undef PG8_SB
#undef PG8_STAGE
#undef PG8_LDA
#undef PG8_LDB
#undef PG8_MMA
#undef PG8_KLOOP
#undef PG8_WAIT_V
#undef PG8_WAIT_L
#undef PG8_BAR
#undef PG8_SCHED
#undef PG8_ZERO
}

struct EpiIn {
    static constexpr bool PERM = true, I8 = false, MIXED = false, PRE = false;
    __device__ __forceinline__ void pre(f32x4 (&)[2][2][4][2], const UnitD&, int, int, int, int) const {}
    bf16_t* P; const float* cosT; const float* sinT; const LAS float* rtab; int tab_pm;
    __device__ __forceinline__ bool operator()(f32x4 (&acc)[2][2][4][2], const UnitD& u, int wr, int wc, int fr, int fq) const {
        const int row0 = u.pm * 256 + wr * 64 + fr, col0 = u.pn * 256 + wc * 32 + 8 * fq;
        const int mode = (u.pn < 10) ? ((wc == 0) ? 1 : 0) : ((u.pn >= 20) ? 2 : 0);
#pragma unroll
        for (int ai = 0; ai < 2; ++ai)
#pragma unroll
            for (int m = 0; m < 4; ++m) {
                const int row = row0 + ai * 128 + m * 16;
                f32x4 v[2][2];
                const float rs = (u.pm == tab_pm) ? rtab[wr * 64 + fr + ai * 128 + m * 16] : __builtin_nanf("");
#pragma unroll
                for (int bj = 0; bj < 2; ++bj) { v[bj][0] = acc[ai][bj][m][0] * rs; v[bj][1] = acc[ai][bj][m][1] * rs; }
                if (mode == 1) {
                    const int pos = row & (SEQ - 1);
                    const f32x4 c = *(const f32x4*)(cosT + pos * 16 + 4 * fq), s = *(const f32x4*)(sinT + pos * 16 + 4 * fq);
#pragma unroll
                    for (int bj = 0; bj < 2; ++bj) { const f32x4 a = v[bj][0], b = v[bj][1]; v[bj][0] = a * c - b * s; v[bj][1] = b * c + a * s; }
                } else if (mode == 2) {
#pragma unroll
                    for (int bj = 0; bj < 2; ++bj)
#pragma unroll
                        for (int n = 0; n < 2; ++n)
#pragma unroll
                            for (int j = 0; j < 4; ++j) v[bj][n][j] = fast_sigmoid(v[bj][n][j]);
                }
                bf16_t* rowp = P + (size_t)row * NIN + col0;
#pragma unroll
                for (int bj = 0; bj < 2; ++bj) { u32x4 w; w.x = cvt_pk_bf16(v[bj][0][0], v[bj][0][1]); w.y = cvt_pk_bf16(v[bj][0][2], v[bj][0][3]); w.z = cvt_pk_bf16(v[bj][1][0], v[bj][1][1]); w.w = cvt_pk_bf16(v[bj][1][2], v[bj][1][3]);
                    *(u32x4*)(rowp + bj * 128) = w; }
            }
        return false;
    }
};
struct EpiInMix {
    static constexpr bool PERM = true, I8 = false, MIXED = true, PRE = true;
    bf16_t* P; const float* cosT; const float* sinT; const LAS float* rtab; int tab_pm; const float* sw; LAS float* scb;
    __device__ __forceinline__ void prefetch(const UnitD& u, int wid, int lane) const { asm volatile("" : "+v"(lane)); if (u.kind != 0 && wid < 4) __builtin_amdgcn_global_load_lds((const unsigned*)(sw + u.pn * 256 + wid * 64 + lane), (LAS unsigned*)(scb + u.slot * 256 + wid * 64), 4, 0, 0); }
    __device__ __forceinline__ void pre(i32x4 (&acc)[2][2][4][2], const UnitD& u, int wr, int wc, int fr, int fq) const {
        const int row0 = u.pm * 256 + wr * 64 + fr;
        const int mode = (u.pn < 10) ? ((wc == 0) ? 1 : 0) : ((u.pn >= 20) ? 2 : 0);
        if (mode == 1) {
            f32x4 c[8], sn[8];
#pragma unroll
            for (int q = 0; q < 8; ++q) { const int pos = (row0 + (q >> 2) * 128 + (q & 3) * 16) & (SEQ - 1); const unsigned to = (unsigned)(pos * 16 + 4 * fq) * 4u; c[q] = *(const f32x4*)((const char*)cosT + to); sn[q] = *(const f32x4*)((const char*)sinT + to); }
#pragma unroll
            for (int q = 0; q < 8; ++q)
#pragma unroll
                for (int bj = 0; bj < 2; ++bj) { const f32x4 a = __builtin_bit_cast(f32x4, acc[q >> 2][bj][q & 3][0]), b = __builtin_bit_cast(f32x4, acc[q >> 2][bj][q & 3][1]);
                    acc[q >> 2][bj][q & 3][0] = __builtin_bit_cast(i32x4, a * c[q] - b * sn[q]); acc[q >> 2][bj][q & 3][1] = __builtin_bit_cast(i32x4, b * c[q] + a * sn[q]); }
        }
    }
    __device__ __forceinline__ bool operator()(i32x4 (&acc)[2][2][4][2], const UnitD& u, int wr, int wc, int fr, int fq) const {
        const int row0 = u.pm * 256 + wr * 64 + fr, col0 = u.pn * 256 + wc * 32 + 8 * fq;
        const bool k8 = u.kind != 0;
        const int mode = (u.pn < 10) ? ((wc == 0) ? 1 : 0) : ((u.pn >= 20) ? 2 : 0);
        f32x4 sc[2][2];
#pragma unroll
        for (int bj = 0; bj < 2; ++bj)
#pragma unroll
            for (int n = 0; n < 2; ++n) sc[bj][n] = k8 ? *(const LAS f32x4*)(scb + u.slot * 256 + wc * 32 + 8 * fq + bj * 128 + 4 * n) : (f32x4){1.f, 1.f, 1.f, 1.f};
#pragma unroll
        for (int ai = 0; ai < 2; ++ai)
#pragma unroll
            for (int m = 0; m < 4; ++m) {
                const int row = row0 + ai * 128 + m * 16;
                f32x4 v[2][2];
                const float rs = (u.pm == tab_pm) ? rtab[(k8 ? 256 : 0) + wr * 64 + fr + ai * 128 + m * 16] : __builtin_nanf("");
#pragma unroll
                for (int bj = 0; bj < 2; ++bj)
#pragma unroll
                    for (int n = 0; n < 2; ++n) { const i32x4 a = acc[ai][bj][m][n];
                        const f32x4 f = k8 ? (f32x4){(float)a[0], (float)a[1], (float)a[2], (float)a[3]} : __builtin_bit_cast(f32x4, a);
                        v[bj][n] = f * (sc[bj][n] * rs); }
                if (mode == 2) {
#pragma unroll
                    for (int bj = 0; bj < 2; ++bj)
#pragma unroll
                        for (int n = 0; n < 2; ++n)
#pragma unroll
                            for (int j = 0; j < 4; ++j) v[bj][n][j] = fast_sigmoid(v[bj][n][j]);
                }
                bf16_t* rowp = P + (size_t)row * NIN + col0;
#pragma unroll
                for (int bj = 0; bj < 2; ++bj) { u32x4 w; w.x = cvt_pk_bf16(v[bj][0][0], v[bj][0][1]); w.y = cvt_pk_bf16(v[bj][0][2], v[bj][0][3]); w.z = cvt_pk_bf16(v[bj][1][0], v[bj][1][1]); w.w = cvt_pk_bf16(v[bj][1][2], v[bj][1][3]);
                    *(u32x4*)(rowp + bj * 128) = w; }
            }
        return false;
    }
};
struct SchedInMix {
    static constexpr int NBA = (PN8 == 20) ? 3 : 2, NBB = (PN8 == 20) ? 2 : 1, NIA = (PN8 == 20) ? 3 : 4, NIB = (PN8 == 20) ? 5 : 6;
    static_assert(4 * NBA + 4 * NBB == PN8 && 4 * NIA + 4 * NIB == NIN / 256 - PN8 && 2 * NBA + NIA == 2 * NBB + NIB, "balanced deal");
    int pm, j; const char* Ab; const char* Aq; const char* Bb; const char* Bq;
    __device__ __forceinline__ void init(int bx) { const int x = bx & 7, w = bx >> 3; pm = 8 * (x >> 1) + (w & 7); j = 4 * (x & 1) + (w >> 3); }
    __device__ __forceinline__ bool next(int i, UnitD& u) const {
        const int nb = j < 4 ? NBA : NBB, ni = j < 4 ? NIA : NIB;
        if (i >= nb + ni) return false;
        const bool k8 = i >= nb;
        const int pn = k8 ? PN8 + (j < 4 ? j * NIA : 4 * NIA + (j - 4) * NIB) + (i - nb) : (j < 4 ? j * NBA : 4 * NBA + (j - 4) * NBB) + i;
        u.pm = pm; u.pn = pn; u.kind = k8 ? 1 : 0; u.nt = k8 ? DM / 128 : DM / 64;
        u.A = (k8 ? Aq : Ab) + (size_t)pm * 256 * DM * 2; u.B = (k8 ? Bq : Bb) + (size_t)pn * (k8 ? 256 * DM : 256 * DM * 2);
        return true;
    }
};
struct EpiPool {
    static constexpr bool PERM = true, I8 = false, MIXED = false, PRE = false;
    __device__ __forceinline__ void pre(f32x4 (&)[2][2][4][2], const UnitD&, int, int, int, int) const {}
    bf16_t* O; const float* scale;
    __device__ __forceinline__ bool operator()(f32x4 (&acc)[2][2][4][2], const UnitD& u, int wr, int wc, int fr, int fq) const {
        const int row0 = u.pm * 256 + wr * 64 + fr, col0 = u.pn * 256 + wc * 32 + 8 * fq;
        f32x4 sc[2][2];
#pragma unroll
        for (int bj = 0; bj < 2; ++bj)
#pragma unroll
            for (int n = 0; n < 2; ++n) sc[bj][n] = *(const f32x4*)(scale + col0 + bj * 128 + 4 * n);
#pragma unroll
        for (int ai = 0; ai < 2; ++ai)
#pragma unroll
            for (int m = 0; m < 4; ++m) { bf16_t* rowp = O + (size_t)(row0 + ai * 128 + m * 16) * PW + col0;
#pragma unroll
                for (int bj = 0; bj < 2; ++bj) { const f32x4 v0 = acc[ai][bj][m][0] * sc[bj][0], v1 = acc[ai][bj][m][1] * sc[bj][1];
                    u32x4 w; w.x = cvt_pk_bf16(v0[0], v0[1]); w.y = cvt_pk_bf16(v0[2], v0[3]); w.z = cvt_pk_bf16(v1[0], v1[1]); w.w = cvt_pk_bf16(v1[2], v1[3]);
                    *(u32x4*)(rowp + bj * 128) = w; } }
        return false;
    }
};
struct EpiBranch {
    static constexpr bool PERM = true, I8 = false, MIXED = false, PRE = false;
    __device__ __forceinline__ void pre(f32x4 (&)[2][2][4][2], const UnitD&, int, int, int, int) const {}
    const bf16_t* P; bf16_t* O;
    __device__ __forceinline__ bool operator()(f32x4 (&acc)[2][2][4][2], const UnitD& u, int wr, int wc, int fr, int fq) const {
        const int row0 = u.pm * 256 + wr * 64 + fr, col0 = u.pn * 256 + wc * 32 + 8 * fq;
        if (u.kind == 0) {
#pragma unroll
            for (int ai = 0; ai < 2; ++ai)
#pragma unroll
                for (int mh = 0; mh < 2; ++mh) {
                    u32x4 ga[2][2], gb[2][2];
#pragma unroll
                    for (int mm = 0; mm < 2; ++mm)
#pragma unroll
                        for (int bj = 0; bj < 2; ++bj) { const bf16_t* rowp = P + (size_t)(row0 + ai * 128 + (2 * mh + mm) * 16) * NIN + col0 + bj * 128; ga[mm][bj] = *(const u32x4*)(rowp + C_GA); gb[mm][bj] = *(const u32x4*)(rowp + C_GB); }
#pragma unroll
                    for (int mm = 0; mm < 2; ++mm)
#pragma unroll
                        for (int bj = 0; bj < 2; ++bj) { const u32x4 a = ga[mm][bj], b = gb[mm][bj]; const int m = 2 * mh + mm;
                            f32x4 r0, r1;
                            r0[0] = bf_lo(a.x) * __builtin_amdgcn_rcpf(fmaxf(bf_lo(b.x), 1e-20f)); r0[1] = bf_hi(a.x) * __builtin_amdgcn_rcpf(fmaxf(bf_hi(b.x), 1e-20f));
                            r0[2] = bf_lo(a.y) * __builtin_amdgcn_rcpf(fmaxf(bf_lo(b.y), 1e-20f)); r0[3] = bf_hi(a.y) * __builtin_amdgcn_rcpf(fmaxf(bf_hi(b.y), 1e-20f));
                            r1[0] = bf_lo(a.z) * __builtin_amdgcn_rcpf(fmaxf(bf_lo(b.z), 1e-20f)); r1[1] = bf_hi(a.z) * __builtin_amdgcn_rcpf(fmaxf(bf_hi(b.z), 1e-20f));
                            r1[2] = bf_lo(a.w) * __builtin_amdgcn_rcpf(fmaxf(bf_lo(b.w), 1e-20f)); r1[3] = bf_hi(a.w) * __builtin_amdgcn_rcpf(fmaxf(bf_hi(b.w), 1e-20f));
                            acc[ai][bj][m][0] = acc[ai][bj][m][0] * r0; acc[ai][bj][m][1] = acc[ai][bj][m][1] * r1; }
                    asm volatile("" ::: "memory");
                }
            return true;
        }
#pragma unroll
        for (int ai = 0; ai < 2; ++ai) {
            u32x4 gb[4][2];
#pragma unroll
            for (int m = 0; m < 4; ++m)
#pragma unroll
                for (int bj = 0; bj < 2; ++bj) gb[m][bj] = *(const u32x4*)(P + (size_t)(row0 + ai * 128 + m * 16) * NIN + col0 + bj * 128 + C_GB);
#pragma unroll
            for (int m = 0; m < 4; ++m) { bf16_t* outp = O + (size_t)(row0 + ai * 128 + m * 16) * DM + col0;
#pragma unroll
                for (int bj = 0; bj < 2; ++bj) { const u32x4 b = gb[m][bj];
                    f32x4 s0, s1;
                    s0[0] = fmaxf(bf_lo(b.x), 1e-20f); s0[1] = fmaxf(bf_hi(b.x), 1e-20f); s0[2] = fmaxf(bf_lo(b.y), 1e-20f); s0[3] = fmaxf(bf_hi(b.y), 1e-20f);
                    s1[0] = fmaxf(bf_lo(b.z), 1e-20f); s1[1] = fmaxf(bf_hi(b.z), 1e-20f); s1[2] = fmaxf(bf_lo(b.w), 1e-20f); s1[3] = fmaxf(bf_hi(b.w), 1e-20f);
                    const f32x4 v0 = acc[ai][bj][m][0] * s0, v1 = acc[ai][bj][m][1] * s1;
                    u32x4 w; w.x = cvt_pk_bf16(v0[0], v0[1]); w.y = cvt_pk_bf16(v0[2], v0[3]); w.z = cvt_pk_bf16(v1[0], v1[1]); w.w = cvt_pk_bf16(v1[2], v1[3]);
                    *(u32x4*)(outp + bj * 128) = w; } }
            asm volatile("" ::: "memory");
        }
        return false;
    }
};
struct EpiRes {
    static constexpr bool PERM = true, I8 = false, MIXED = false, PRE = false;
    __device__ __forceinline__ void pre(f32x4 (&)[2][2][4][2], const UnitD&, int, int, int, int) const {}
    const float* xin32; const bf16_t* xb; bf16_t* xbo; float* xout32; float* part;
    __device__ __forceinline__ void finish(f32x4 (&acc)[2][2][4][2], int ai, int m, const f32x4 (&xi)[2][2], int row, size_t off, int fq, int slot) const {
        float ss = 0.f;
#pragma unroll
        for (int bj = 0; bj < 2; ++bj) { const f32x4 x0 = xi[bj][0] + acc[ai][bj][m][0], x1 = xi[bj][1] + acc[ai][bj][m][1];
            ss += (x0[0] * x0[0] + x0[1] * x0[1]) + (x0[2] * x0[2] + x0[3] * x0[3]) + (x1[0] * x1[0] + x1[1] * x1[1]) + (x1[2] * x1[2] + x1[3] * x1[3]);
            if (xout32) { *(f32x4*)(xout32 + off + bj * 128) = x0; *(f32x4*)(xout32 + off + bj * 128 + 4) = x1; }
            else { u32x4 w; w.x = cvt_pk_bf16(x0[0], x0[1]); w.y = cvt_pk_bf16(x0[2], x0[3]); w.z = cvt_pk_bf16(x1[0], x1[1]); w.w = cvt_pk_bf16(x1[2], x1[3]); *(u32x4*)(xbo + off + bj * 128) = w; } }
        ss += xchg<16>(ss); ss = sum32(ss);
        if (fq == 0) part[(size_t)row * 64 + slot] = ss;
    }
    __device__ __forceinline__ bool operator()(f32x4 (&acc)[2][2][4][2], const UnitD& u, int wr, int wc, int fr, int fq) const {
        const int row0 = u.pm * 256 + wr * 64 + fr, col0 = u.pn * 256 + wc * 32 + 8 * fq;
        if (xin32) {
#pragma unroll
            for (int ai = 0; ai < 2; ++ai)
#pragma unroll
                for (int mh = 0; mh < 2; ++mh) {
                    f32x4 xr[2][2][2];
#pragma unroll
                    for (int mm = 0; mm < 2; ++mm)
#pragma unroll
                        for (int bj = 0; bj < 2; ++bj) { const float* p = xin32 + (size_t)(row0 + ai * 128 + (2 * mh + mm) * 16) * DM + col0 + bj * 128; xr[mm][bj][0] = *(const f32x4*)p; xr[mm][bj][1] = *(const f32x4*)(p + 4); }
#pragma unroll
                    for (int mm = 0; mm < 2; ++mm) { const int m = 2 * mh + mm, row = row0 + ai * 128 + m * 16; finish(acc, ai, m, xr[mm], row, (size_t)row * DM + col0, fq, 4 * u.pn + wc); }
                    asm volatile("" ::: "memory");
                }
        } else {
#pragma unroll
            for (int ai = 0; ai < 2; ++ai) {
                u32x4 xw[4][2];
#pragma unroll
                for (int m = 0; m < 4; ++m)
#pragma unroll
                    for (int bj = 0; bj < 2; ++bj) xw[m][bj] = *(const u32x4*)(xb + (size_t)(row0 + ai * 128 + m * 16) * DM + col0 + bj * 128);
#pragma unroll
                for (int m = 0; m < 4; ++m) { const int row = row0 + ai * 128 + m * 16; f32x4 xi[2][2];
#pragma unroll
                    for (int bj = 0; bj < 2; ++bj) { const u32x4 w = xw[m][bj]; xi[bj][0] = (f32x4){bf_lo(w.x), bf_hi(w.x), bf_lo(w.y), bf_hi(w.y)}; xi[bj][1] = (f32x4){bf_lo(w.z), bf_hi(w.z), bf_lo(w.w), bf_hi(w.w)}; }
                    finish(acc, ai, m, xi, row, (size_t)row * DM + col0, fq, 4 * u.pn + wc); }
                asm volatile("" ::: "memory");
            }
        }
        return false;
    }
};
struct EpiGU {
    static constexpr bool PERM = true, I8 = false, MIXED = false, PRE = false;
    __device__ __forceinline__ void pre(f32x4 (&)[2][2][4][2], const UnitD&, int, int, int, int) const {}
    bf16_t* O; const LAS float* rtab; int tab_pm;
    __device__ __forceinline__ bool operator()(f32x4 (&acc)[2][2][4][2], const UnitD& u, int wr, int wc, int fr, int fq) const {
        const int row0 = u.pm * 256 + wr * 64 + fr, col0 = u.pn * 128 + wc * 32 + 8 * fq;
#pragma unroll
        for (int ai = 0; ai < 2; ++ai)
#pragma unroll
            for (int m = 0; m < 4; ++m) { f32x4 v[2]; const float rs = (u.pm == tab_pm) ? rtab[wr * 64 + fr + ai * 128 + m * 16] : __builtin_nanf("");
#pragma unroll
                for (int n = 0; n < 2; ++n)
#pragma unroll
                    for (int j = 0; j < 4; ++j) { const float g = acc[ai][0][m][n][j] * rs; v[n][j] = g * fast_sigmoid(g) * (acc[ai][1][m][n][j] * rs); }
                u32x4 w; w.x = cvt_pk_bf16(v[0][0], v[0][1]); w.y = cvt_pk_bf16(v[0][2], v[0][3]); w.z = cvt_pk_bf16(v[1][0], v[1][1]); w.w = cvt_pk_bf16(v[1][2], v[1][3]);
                *(u32x4*)(O + (size_t)(row0 + ai * 128 + m * 16) * FF + col0) = w; }
        return false;
    }
};
struct EpiGU8 {
    static constexpr bool PERM = true, I8 = true, MIXED = false, PRE = true;
    __device__ __forceinline__ void pre(i32x4 (&)[2][2][4][2], const UnitD&, int, int, int, int) const {}
    bf16_t* O; const LAS float* rtab; int tab_pm; const float* sw; LAS float* scb;
    __device__ __forceinline__ void prefetch(const UnitD& u, int wid, int lane) const { asm volatile("" : "+v"(lane)); if (wid < 4) __builtin_amdgcn_global_load_lds((const unsigned*)(sw + u.pn * 256 + wid * 64 + lane), (LAS unsigned*)(scb + u.slot * 256 + wid * 64), 4, 0, 0); }
    __device__ __forceinline__ bool operator()(i32x4 (&acc)[2][2][4][2], const UnitD& u, int wr, int wc, int fr, int fq) const {
        const int row0 = tab_pm * 256 + wr * 64 + fr, col0 = u.pn * 128 + wc * 32 + 8 * fq;
        const LAS float* swc = scb + u.slot * 256 + wc * 32 + 8 * fq;
        f32x4 sg[2], su[2];
        sg[0] = *(const LAS f32x4*)swc; sg[1] = *(const LAS f32x4*)(swc + 4); su[0] = *(const LAS f32x4*)(swc + 128); su[1] = *(const LAS f32x4*)(swc + 132);
#pragma unroll
        for (int ai = 0; ai < 2; ++ai)
#pragma unroll
            for (int m = 0; m < 4; ++m) { f32x4 v[2]; const float rs = rtab[wr * 64 + fr + ai * 128 + m * 16];
#pragma unroll
                for (int n = 0; n < 2; ++n)
#pragma unroll
                    for (int j = 0; j < 4; ++j) { const float g = (float)acc[ai][0][m][n][j] * (rs * sg[n][j]); v[n][j] = g * fast_sigmoid(g) * ((float)acc[ai][1][m][n][j] * (rs * su[n][j])); }
                u32x4 w; w.x = cvt_pk_bf16(v[0][0], v[0][1]); w.y = cvt_pk_bf16(v[0][2], v[0][3]); w.z = cvt_pk_bf16(v[1][0], v[1][1]); w.w = cvt_pk_bf16(v[1][2], v[1][3]);
                *(u32x4*)(O + (size_t)(row0 + ai * 128 + m * 16) * FF + col0) = w; }
        return false;
    }
};
}

namespace attn {
constexpr int D = 128, NW = 8, QBLK = 32, KVBLK = 64, QROWS = 64, WIN = 128;
constexpr int SHM_V = KVBLK * D * 2, SHM_K = KVBLK * D * 2;
constexpr int LDS_BYTES = 2 * SHM_V + 2 * SHM_K + NW * 64 * 4;
constexpr int LDQ = NIN, LDKV = NIN, LDO = AW;
constexpr float SCALE = 0.08838834764831845f;
constexpr float THR = 8.f;
#define KSWZ(row, colB) ((row) * 256 + ((colB) ^ (((row) & 7) << 4)))
#define SBAR() __builtin_amdgcn_sched_barrier(0)
__device__ __forceinline__ int v_st(int k, int c) { const int kk = (k & ~0xC) | ((k & 4) << 1) | ((k & 8) >> 1); return ((kk >> 3) * 4 + (c >> 5)) * 512 + ((kk & 7) * 32 + (c & 31)) * 2; }
__device__ __forceinline__ int v_rd_base(int lane) { return ((lane & 3) << 3) | (((lane >> 2) & 3) << 6) | (((lane >> 4) & 1) << 5) | (((lane >> 5) & 1) << 8); }
constexpr int v_rd_off(int d0, int ks, int half) { return d0 * 512 + ks * 4096 + half * 2048; }
__device__ __forceinline__ int crow(int r, int hi) { return (r & 3) + 8 * (r >> 2) + 4 * hi; }
__device__ __forceinline__ unsigned cvtpk(float lo, float hi) { unsigned r; asm volatile("v_cvt_pk_bf16_f32 %0, %1, %2" : "=v"(r) : "v"(lo), "v"(hi)); return r; }
__device__ __forceinline__ bf16x8 load8(const bf16_t* p) { return *reinterpret_cast<const bf16x8*>(p); }
__device__ __forceinline__ void mask_tile(f32x16& p0, f32x16& p1, int dq) {
    const float NEG = -__builtin_inff();
#pragma unroll
    for (int r = 0; r < 16; ++r) {
        const int c = (r & 3) + 8 * (r >> 2);
        if ((unsigned)(dq - c) >= (unsigned)(2 * WIN + 1)) p0[r] = NEG;
        if ((unsigned)(dq - c - 32) >= (unsigned)(2 * WIN + 1)) p1[r] = NEG;
    }
}
__device__ __forceinline__ void partialSM(f32x16& p0, f32x16& p1, float& m_reg, float& mn, float& alpha) {
    float pmax = p0[0]; for (int r = 1; r < 16; ++r) pmax = fmaxf(pmax, p0[r]); for (int r = 0; r < 16; ++r) pmax = fmaxf(pmax, p1[r]);
    { auto rr = __builtin_amdgcn_permlane32_swap(__float_as_uint(pmax), __float_as_uint(pmax), false, false);
      pmax = fmaxf(__uint_as_float(rr[0]), __uint_as_float(rr[1])); }
    constexpr float C2 = 1.4426950408889634f * SCALE;
    if (__builtin_expect(__all((pmax - m_reg) * SCALE <= THR), 1)) { mn = m_reg; alpha = 1.f; }
    else { mn = fmaxf(m_reg, pmax); alpha = __builtin_amdgcn_exp2f((m_reg - mn) * C2); m_reg = mn; }
    const float mnL = -mn * C2;
    for (int r = 0; r < 16; ++r) p0[r] = fmaf(p0[r], C2, mnL); for (int r = 0; r < 16; ++r) p1[r] = fmaf(p1[r], C2, mnL);
    for (int r = 0; r < 16; ++r) p0[r] = __builtin_amdgcn_exp2f(p0[r]);
}
__device__ __forceinline__ void finishSM(f32x16& p0, f32x16& p1, float alpha, float& l_reg, bf16x8& pa0, bf16x8& pa1, bf16x8& pa2, bf16x8& pa3) {
    for (int r = 0; r < 16; ++r) p1[r] = __builtin_amdgcn_exp2f(p1[r]);
    float ps = 0; for (int r = 0; r < 16; ++r) ps += p0[r]; for (int r = 0; r < 16; ++r) ps += p1[r];
    { auto rr = __builtin_amdgcn_permlane32_swap(__float_as_uint(ps), __float_as_uint(ps), false, false);
      ps = __uint_as_float(rr[0]) + __uint_as_float(rr[1]); }
    l_reg = l_reg * alpha + ps;
#define PK4(P, B_, OUT) do { unsigned a0 = cvtpk(P[B_+0], P[B_+1]), a1 = cvtpk(P[B_+2], P[B_+3]);                          \
        unsigned b0 = cvtpk(P[B_+4], P[B_+5]), b1 = cvtpk(P[B_+6], P[B_+7]);                                             \
        auto r0 = __builtin_amdgcn_permlane32_swap(a0, b0, false, false); auto r1 = __builtin_amdgcn_permlane32_swap(a1, b1, false, false); \
        u32x4 w = {r0[0], r1[0], r0[1], r1[1]}; OUT = *reinterpret_cast<bf16x8*>(&w); } while (0)
    PK4(p0, 0, pa0); PK4(p0, 8, pa1); PK4(p1, 0, pa2); PK4(p1, 8, pa3);
#undef PK4
}
template <int KB>
__device__ __forceinline__ void qkt(f32x16& p0, f32x16& p1, const char* K_lds, int r32, int hi, const char* q_lds, bool act) {
    if (!act) { const float NEG = -__builtin_inff();
#pragma unroll
        for (int r = 0; r < 16; ++r) { p0[r] = NEG; p1[r] = NEG; } return; }
    p0 = f32x16{}; p1 = f32x16{};
    const char* kb[4];
#pragma unroll
    for (int dd = 0; dd < 4; ++dd) kb[dd] = K_lds + KB * SHM_K + KSWZ(r32, (dd * 16 + hi * 8) * 2);
#pragma unroll
    for (int d0 = 0; d0 < 8; ++d0) { const char* a = kb[d0 & 3] + (d0 >> 2) * 128;
        bf16x8 b0 = *reinterpret_cast<const bf16x8*>(a);
        bf16x8 b1 = *reinterpret_cast<const bf16x8*>(a + 32 * 256);
        bf16x8 q = *reinterpret_cast<const bf16x8*>(q_lds + d0 * 1024);
        p0 = __builtin_amdgcn_mfma_f32_32x32x16_bf16(b0, q, p0, 0, 0, 0);
        p1 = __builtin_amdgcn_mfma_f32_32x32x16_bf16(b1, q, p1, 0, 0, 0); }
}
template <int VB>
__device__ __forceinline__ void pv_tile(f32x16* o, int vb0, bf16x8 pa0, bf16x8 pa1, bf16x8 pa2, bf16x8 pa3, bool act) {
    if (!act) return;
#define TRRD(dst, off) asm volatile("ds_read_b64_tr_b16 %0, %1 offset:%2" : "=&v"(dst) : "v"(vb0), "i"(off) : "memory")
#define PV_D0(d0) do { s16x4 l0, l1, l2, l3, h0, h1, h2, h3; constexpr int b_ = VB * SHM_V + v_rd_off(d0, 0, 0);   \
        TRRD(l0, b_); TRRD(h0, b_ + 2048); TRRD(l1, b_ + 4096); TRRD(h1, b_ + 6144); TRRD(l2, b_ + 8192); TRRD(h2, b_ + 10240); TRRD(l3, b_ + 12288); TRRD(h3, b_ + 14336); \
        asm volatile("s_waitcnt lgkmcnt(0)" ::: "memory"); SBAR();   \
        o[d0] = __builtin_amdgcn_mfma_f32_32x32x16_bf16(pa0, (bf16x8){l0[0], l0[1], l0[2], l0[3], h0[0], h0[1], h0[2], h0[3]}, o[d0], 0, 0, 0);   \
        o[d0] = __builtin_amdgcn_mfma_f32_32x32x16_bf16(pa1, (bf16x8){l1[0], l1[1], l1[2], l1[3], h1[0], h1[1], h1[2], h1[3]}, o[d0], 0, 0, 0);   \
        o[d0] = __builtin_amdgcn_mfma_f32_32x32x16_bf16(pa2, (bf16x8){l2[0], l2[1], l2[2], l2[3], h2[0], h2[1], h2[2], h2[3]}, o[d0], 0, 0, 0);   \
        o[d0] = __builtin_amdgcn_mfma_f32_32x32x16_bf16(pa3, (bf16x8){l3[0], l3[1], l3[2], l3[3], h3[0], h3[1], h3[2], h3[3]}, o[d0], 0, 0, 0); } while (0)
    PV_D0(0); PV_D0(1); PV_D0(2); PV_D0(3);
#undef PV_D0
#undef TRRD
}
struct BlockRef { const bf16_t* Q; const bf16_t* K; const bf16_t* V; bf16_t* O; int P0; const float* sink4; };
struct Seam { bf16x8 st_v0, st_v1, st_k0, st_k1; };
constexpr int LDS_Q = LDS_BYTES;
constexpr int LDS_TOTAL = LDS_Q + NW * 8192;
__device__ __forceinline__ int jlo_of(int P0) { const int lowk = P0 - WIN; return lowk > 0 ? lowk / KVBLK : 0; }
#define ROW(p, k0, rr) ((p) + (size_t)((k0) + (rr)) * LDKV + sc)
#define VMW() asm volatile("s_waitcnt vmcnt(0)" ::: "memory")
#define SLOAD_H(Kp, Vp, k0) do { S.st_v0 = load8(ROW(Vp, k0, sr)); S.st_v1 = load8(ROW(Vp, k0, 32 + sr));              \
                         S.st_k0 = load8(ROW(Kp, k0, sr)); S.st_k1 = load8(ROW(Kp, k0, 32 + sr)); } while (0)
#define SWRITE_HK(bf) do { *(bf16x8*)(K_lds + (bf) * SHM_K + kws) = S.st_k0; *(bf16x8*)(K_lds + (bf) * SHM_K + kws + 32 * 256) = S.st_k1; } while (0)
#define SWRITE_HV(bf) do { *(bf16x8*)(V_lds + (bf) * SHM_V + vst0) = S.st_v0; *(bf16x8*)(V_lds + (bf) * SHM_V + vst1) = S.st_v1; } while (0)
#define SWRITE_H(bf) do { SWRITE_HV(bf); SWRITE_HK(bf); } while (0)
__device__ __forceinline__ void attn_block(const int wave_, const BlockRef& cur, char* lds) {
    int tid = tid_of(wave_); asm volatile("" : "+v"(tid));
    const int wid = wave_, lane = tid & 63, r32 = lane & 31, hi = lane >> 5;
    const int j_lo = jlo_of(cur.P0);
    int j_hi = (cur.P0 + QROWS - 1 + WIN) / KVBLK + 1; if (j_hi > SEQ / KVBLK) j_hi = SEQ / KVBLK;
    const int NT = j_hi - j_lo;
    const int qlo = cur.P0 + (wid & 1) * QBLK, qm = qlo + r32 - 4 * hi + WIN;
    char* V_lds = lds; char* K_lds = lds + 2 * SHM_V;
    float* ws = (float*)(lds + 2 * SHM_V + 2 * SHM_K) + wid * 64; float* li_l = ws, * al_l = ws + 32;
    char* q_lds = lds + LDS_Q + wid * 8192 + lane * 16;
    float m_reg = cur.sink4[wid >> 1] * 11.313708498984761f, l_reg = 1.f; f32x16 o[4] = {};
    const int sr = tid >> 4, sc = (tid & 15) * 8, vst0 = v_st(sr, sc), vst1 = v_st(32 + sr, sc), kws = KSWZ(sr, sc * 2);
    const int vb0 = (int)(uintptr_t)V_lds + v_rd_base(lane);
    const bf16_t* Kh = cur.K; const bf16_t* Vh = cur.V;
    Seam S;
#define KBASE(t) ((j_lo + (t)) * KVBLK)
    {
        SLOAD_H(Kh, Vh, KBASE(0));
#pragma unroll
        for (int d0 = 0; d0 < 8; ++d0) { const bf16x8 q = load8(cur.Q + (size_t)((wid & 1) * QBLK + r32) * LDQ + (wid >> 1) * D + d0 * 16 + hi * 8); *reinterpret_cast<bf16x8*>(q_lds + d0 * 1024) = q; }
        VMW(); SWRITE_HK(0);
        __syncthreads();
    }
#define RESC(a) do { if (__any((a) < 1.f)) { if (hi == 0) al_l[r32] = (a); asm volatile("s_waitcnt lgkmcnt(0)" ::: "memory");              \
                     for (int d_ = 0; d_ < 4; ++d_) for (int r = 0; r < 16; ++r) o[d_][r] *= al_l[crow(r, hi)]; } } while (0)
#define ACT(t) (KBASE(t) <= qlo + QBLK - 1 + WIN && KBASE(t) + KVBLK - 1 >= qlo - WIN)
#define MASKT(P0_, P1_, t) do { const int kb_ = KBASE(t); if (ACT(t) && (kb_ + KVBLK - 1 > qlo + WIN || kb_ < qlo + QBLK - 1 - WIN)) mask_tile(P0_, P1_, qm - kb_); } while (0)
    f32x16 pA0, pA1, pB0, pB1; float mnA, mnB, alA, alB; bf16x8 pa0, pa1, pa2, pa3;
    SWRITE_HV(0); SBAR();
    if (NT > 1) { SLOAD_H(Kh, Vh, KBASE(1)); }
    SBAR(); qkt<0>(pA0, pA1, K_lds, r32, hi, q_lds, ACT(0));
    MASKT(pA0, pA1, 0); partialSM(pA0, pA1, m_reg, mnA, alA);
    if (NT > 1) { VMW(); SWRITE_H(1); }
    __syncthreads();
#define HALF_STEP(PX0, PX1, mnX, alX, PY0, PY1, alY, t, KB, VB, SB) do {                                                      \
        SBAR(); qkt<KB>(PX0, PX1, K_lds, r32, hi, q_lds, ACT(t));                                                \
        finishSM(PY0, PY1, alY, l_reg, pa0, pa1, pa2, pa3); SBAR();                                                           \
        if ((t) + 1 < NT) { SLOAD_H(Kh, Vh, KBASE((t) + 1)); SBAR(); }                                                         \
        pv_tile<VB>(o, vb0, pa0, pa1, pa2, pa3, ACT((t) - 1)); MASKT(PX0, PX1, (t)); partialSM(PX0, PX1, m_reg, mnX, alX);    \
        __syncthreads();                                                                                                      \
        if ((t) + 1 < NT) { VMW(); SWRITE_H(SB); }                                                                            \
        RESC(alX); __syncthreads(); } while (0)
    for (int t = 1; t + 1 < NT; t += 2) {
        HALF_STEP(pB0, pB1, mnB, alB, pA0, pA1, alA, t, 1, 0, 0);
        HALF_STEP(pA0, pA1, mnA, alA, pB0, pB1, alB, t + 1, 0, 1, 1);
    }
    const bool even = (NT & 1) == 0;
    if (even) { SBAR(); qkt<1>(pB0, pB1, K_lds, r32, hi, q_lds, ACT(NT - 1)); SBAR(); }
    finishSM(pA0, pA1, alA, l_reg, pa0, pa1, pa2, pa3); SBAR();
    pv_tile<0>(o, vb0, pa0, pa1, pa2, pa3, ACT(even ? NT - 2 : NT - 1));
    if (even) { MASKT(pB0, pB1, NT - 1); partialSM(pB0, pB1, m_reg, mnB, alB); __syncthreads(); RESC(alB);
        finishSM(pB0, pB1, alB, l_reg, pa0, pa1, pa2, pa3); SBAR(); pv_tile<1>(o, vb0, pa0, pa1, pa2, pa3, ACT(NT - 1)); }
    SBAR();
    if (hi == 0) li_l[r32] = l_reg; asm volatile("s_waitcnt lgkmcnt(0)" ::: "memory");
    float rli[16];
#pragma unroll
    for (int r = 0; r < 16; ++r) rli[r] = __builtin_amdgcn_rcpf(li_l[crow(r, hi)]);
    bf16_t* Ow = cur.O + (size_t)((wid & 1) * QBLK) * LDO + (wid >> 1) * D;
#pragma unroll
    for (int r = 0; r < 16; ++r) { const int orow = crow(r, hi);
#pragma unroll
        for (int d0 = 0; d0 < 4; ++d0) { const float v = o[d0][r] * rli[r];
            const float vn = xchg<1>(v);
            if ((r32 & 1) == 0) *(unsigned*)(Ow + (size_t)orow * LDO + d0 * 32 + r32) = cvtpk(v, vn); } }
    __syncthreads();
#undef RESC
#undef KBASE
#undef ACT
#undef MASKT
#undef HALF_STEP
}
#undef ROW
#undef VMW
#undef SLOAD_H
#undef SWRITE_HK
#undef SWRITE_HV
#undef SWRITE_H
#undef KSWZ
#undef SBAR
}
static_assert(attn::LDS_TOTAL <= LDSCTL_OFF && pg8::STAGE_BYTES <= LDSCTL_OFF && MISC_OFF + 128 <= LDS_BYTES, "LDS map");

#define XB_TMO      128
#define XB_XCNT(j)  (256  + 64 * (j))
#define XB_XSUB(j)  (1280 + 64 * (j))
#define XB_XGEN(j)  (2304 + 64 * (j))
#define XB_TOP      3328
#define XB_TOPGEN   3392
#define XCD_BAR_WORDS 3456
#define XB_SPIN_CAP (1u << 18)

__device__ __forceinline__ unsigned xb_ld(unsigned* p)              { return __hip_atomic_load(p, __ATOMIC_RELAXED, __HIP_MEMORY_SCOPE_AGENT); }
__device__ __forceinline__ unsigned xb_add(unsigned* p, unsigned v) { return __hip_atomic_fetch_add(p, v, __ATOMIC_RELAXED, __HIP_MEMORY_SCOPE_AGENT); }
__device__ __forceinline__ unsigned xb_xcc_id() { return (unsigned)__builtin_amdgcn_s_getreg((3 << 11) | 20) & 0xFu; }
#define XB_SPIN(cond, bar) do { unsigned _sp = 0; while (cond) { __builtin_amdgcn_s_sleep(1); \
    if ((++_sp & 255u) == 0u) { if (xb_ld(&(bar)[XB_TMO])) break; if (_sp > XB_SPIN_CAP) { atomicAdd(&(bar)[XB_TMO], 1u); break; } } } } while (0)

struct XcdBarrier {
    unsigned* bar; unsigned x;
    volatile LAS unsigned* st;
    unsigned n;
};
__device__ __forceinline__ XcdBarrier xcd_barrier_post(unsigned* bar, volatile LAS unsigned* st, unsigned n) {
    XcdBarrier b; b.bar = bar; b.x = xb_xcc_id(); b.st = st; b.n = n;
    if (threadIdx.x == 0) (void)xb_add(&bar[XB_XCNT(b.x)], 1u);
    return b;
}
__device__ __forceinline__ void xcd_barrier_complete(unsigned* bar, unsigned x, unsigned& nloc, unsigned& nx, const unsigned G) {
    unsigned sum, cnt, mine, sp = 0u;
    for (;;) {
        sum = 0u; cnt = 0u; mine = 0u;
#pragma unroll
        for (unsigned j = 0; j < 16; ++j) { const unsigned c = xb_ld(&bar[XB_XCNT(j)]); sum += c; cnt += (c > 0u) ? 1u : 0u; mine = (j == x) ? c : mine; }
        if (sum == G) break;
        __builtin_amdgcn_s_sleep(1);
        if ((++sp & 255u) == 0u) { if (xb_ld(&bar[XB_TMO])) break; if (sp > XB_SPIN_CAP) { atomicAdd(&bar[XB_TMO], 1u); break; } }
    }
    nloc = mine > 0u ? mine : 1u; nx = cnt > 0u ? cnt : 1u;
}
__device__ __forceinline__ void xcd_barrier(const XcdBarrier& b, const int wave_) {
    asm volatile("s_waitcnt vmcnt(0)" ::: "memory");
    __syncthreads();
    int tid0 = tid_of(wave_); asm volatile("" : "+v"(tid0));
    if (tid0 == 0) {
        unsigned* bar = b.bar; const unsigned bx_ = xb_xcc_id();
        __builtin_amdgcn_s_waitcnt(0);
        unsigned nloc = b.st[0], nx = b.st[1];
        if (nloc == 0u) { xcd_barrier_complete(bar, bx_, nloc, nx, b.n); b.st[0] = nloc; b.st[1] = nx; }
        const unsigned old = xb_add(&bar[XB_XSUB(bx_)], 1u);
        const unsigned gen = old / nloc;
        if (old + 1u == (gen + 1u) * nloc) {
            __builtin_amdgcn_fence(__ATOMIC_RELEASE, "agent");
            asm volatile("s_waitcnt vmcnt(0)" ::: "memory");
            const unsigned og = xb_add(&bar[XB_TOP], 1u);
            const unsigned tg = og / nx;
            if (og + 1u == (tg + 1u) * nx) xb_add(&bar[XB_TOPGEN], 1u);
            else XB_SPIN(xb_ld(&bar[XB_TOPGEN]) == tg, bar);
            __builtin_amdgcn_fence(__ATOMIC_ACQUIRE, "agent");
            xb_add(&bar[XB_XGEN(bx_)], 1u);
            asm volatile("s_waitcnt vmcnt(0)" ::: "memory");
        } else {
            XB_SPIN(xb_ld(&bar[XB_XGEN(bx_)]) == gen, bar);
            __builtin_amdgcn_fence(__ATOMIC_ACQUIRE, "agent");
            asm volatile("s_waitcnt vmcnt(0)" ::: "memory");
        }
    }
    __syncthreads();
}


__device__ __forceinline__ float wave_sum(float v) {
    v += xchg<1>(v); v += xchg<2>(v); v += xchg<4>(v); v += xchg<8>(v); v += xchg<16>(v);
    return sum32(v);
}
__device__ __forceinline__ void cvt8_block(const float* W, int N, int n0, const float* gain, unsigned char* WT8, int map, float* scales, LAS float* cmx, int wave, int lane) {
    asm volatile("" : "+v"(lane));
    const int c = lane & 31, half = lane >> 5, slot = n0 + c;
    const float* wb = W + (size_t)(wave * 512) * N; const float* gb = gain + wave * 512;
    const unsigned loff = (unsigned)(32 * half * N + srccol(map, slot)) * 4u; const bool hi = half != 0;
    float gv[8];
#pragma unroll
    for (int it = 0; it < 8; ++it) gv[it] = gb[64 * it + lane];
    unsigned pk[8][16]; float mx = 0.f;
#pragma unroll
    for (int it = 0; it < 8; ++it)
#pragma unroll
        for (int h = 0; h < 2; ++h) { float w[16];
#pragma unroll
            for (int i = 0; i < 16; ++i) w[i] = *(const float*)((const char*)(wb + (size_t)(64 * it + 16 * h + i) * N) + loff);
#pragma unroll
            for (int i = 0; i < 16; ++i) { const int gi = __builtin_bit_cast(int, gv[it]); const float g0 = __builtin_bit_cast(float, __builtin_amdgcn_readlane(gi, 16 * h + i)), g1 = __builtin_bit_cast(float, __builtin_amdgcn_readlane(gi, 32 + 16 * h + i)); w[i] *= hi ? g1 : g0; }
#pragma unroll
            for (int i = 0; i < 8; ++i) { const unsigned p = cvt_pk_bf16(w[2 * i], w[2 * i + 1]); pk[it][8 * h + i] = p; mx = fmaxf(mx, fmaxf(fabsf(bf_lo(p)), fabsf(bf_hi(p)))); }
            asm volatile("" ::: "memory"); }
    mx = max32(mx);
    if (lane < 32) cmx[wave * 32 + lane] = mx;
    LDS_WAIT(); __syncthreads();
    float a = 0.f;
#pragma unroll
    for (int q = 0; q < 8; ++q) a = fmaxf(a, cmx[q * 32 + c]);
    const float inv = a > 0.f ? 127.0f / a : 0.f;
    if (wave == 0 && lane < 32) scales[destrow(slot)] = a * (1.0f / 127.0f);
    unsigned char* dp = WT8 + (size_t)(slot >> 8) * ((size_t)DM * 256) + (size_t)(4 * wave) * 32768 + img_seg(slot & 255, 0);
    const unsigned xs = (slot & 8) ? 32u : 0u;
#pragma unroll
    for (int it = 0; it < 8; ++it)
#pragma unroll
        for (int q = 0; q < 2; ++q) { unsigned o[4];
#pragma unroll
            for (int e = 0; e < 4; ++e) { unsigned p0 = pk[it][8 * q + 2 * e], p1 = pk[it][8 * q + 2 * e + 1]; asm volatile("" : "+v"(p0), "+v"(p1));
                o[e] = ((unsigned)(int)__builtin_rintf(bf_lo(p0) * inv) & 0xffu) | (((unsigned)(int)__builtin_rintf(bf_hi(p0) * inv) & 0xffu) << 8) | (((unsigned)(int)__builtin_rintf(bf_lo(p1) * inv) & 0xffu) << 16) | (((unsigned)(int)__builtin_rintf(bf_hi(p1) * inv) & 0xffu) << 24); }
            *(GAS u32x4*)(dp + (it >> 1) * 32768 + (it & 1) * 1024 + ((16u * (2 * half + q)) ^ xs)) = (u32x4){o[0], o[1], o[2], o[3]}; }
    __syncthreads();
}
struct CvtJob { int b0, n0, b1, n1, b2, n2; };
__device__ __forceinline__ int cvt_index(const CvtJob& J, int j) { return j < J.n0 ? J.b0 + j : (j < J.n0 + J.n1 ? J.b1 + (j - J.n0) : J.b2 + (j - J.n0 - J.n1)); }
template <unsigned KINDS>
__device__ __forceinline__ void cvt_run(const Args& args, unsigned char* wsp, const CvtJob& J, int w, int nw, int lane) {
    asm volatile("" : "+v"(lane));
    const int total = J.n0 + J.n1 + J.n2;
    for (int j = w; j < total; j += nw) { const CvtItem d = cvt_decode<KINDS>(args, wsp, cvt_index(J, j)); float wv[32];
        const float gl = cvtk_gain_load(d, lane);
        cvtk_load(d, wv, lane);
        asm volatile("" ::: "memory");
        cvtk_store(d, wv, gl, lane);
        asm volatile("" ::: "memory"); }
}
__device__ __forceinline__ void row_prologue(const float* xrow, bf16_t* xb, unsigned char* xq, float* rstd_out, float* rowf8_out, int lane) {
    asm volatile("" : "+v"(lane));
    const GAS f32x4* sp = (const GAS f32x4*)xrow + 4 * lane;
    f32x4 v[4][4]; float amax = 0.f, ss = 0.f;
#pragma unroll
    for (int j = 0; j < 4; ++j)
#pragma unroll
        for (int q = 0; q < 4; ++q) { v[j][q] = sp[256 * j + q];
#pragma unroll
            for (int e = 0; e < 4; ++e) { amax = fmaxf(amax, fabsf(v[j][q][e])); ss += v[j][q][e] * v[j][q][e]; } }
    amax = wave_max(amax);
    ss = wave_sum(ss);
    const float inv = amax > 0.f ? 127.0f / amax : 0.f;
    GAS u32x4* bp = (GAS u32x4*)xb + 2 * lane; GAS u32x4* qp = (GAS u32x4*)xq + lane;
#pragma unroll
    for (int j = 0; j < 4; ++j) { unsigned w[4];
#pragma unroll
        for (int q = 0; q < 4; ++q) { unsigned x = 0u;
#pragma unroll
            for (int e = 0; e < 4; ++e) { const int iv = (int)__builtin_rintf(v[j][q][e] * inv); x |= ((unsigned)iv & 0xffu) << (8 * e); }
            w[q] = x; }
        qp[64 * j] = (u32x4){w[0], w[1], w[2], w[3]};
        bp[128 * j] = (u32x4){cvt_pk_bf16(v[j][0][0], v[j][0][1]), cvt_pk_bf16(v[j][0][2], v[j][0][3]), cvt_pk_bf16(v[j][1][0], v[j][1][1]), cvt_pk_bf16(v[j][1][2], v[j][1][3])};
        bp[128 * j + 1] = (u32x4){cvt_pk_bf16(v[j][2][0], v[j][2][1]), cvt_pk_bf16(v[j][2][2], v[j][2][3]), cvt_pk_bf16(v[j][3][0], v[j][3][1]), cvt_pk_bf16(v[j][3][2], v[j][3][3])}; }
    if (lane == 0) { const float rstd = 1.0f / sqrtf(ss * (1.f / DM) + RMS_EPS); *rstd_out = rstd; *rowf8_out = rstd * amax * (1.0f / 127.0f); }
}
__device__ __forceinline__ void build_rstd_table(LAS float* tab, const float* part, int np, int pm, int wave, int lane, bool raw = false) {
    asm volatile("" : "+v"(lane));
    if (raw && np == 1) { if (lane < 32) tab[wave * 32 + lane] = part[pm * 256 + wave * 32 + lane]; LDS_WAIT(); __syncthreads(); return; }
    const float* p = part + (size_t)(pm * 256 + wave * 32) * np + lane;
#pragma unroll 8
    for (int r = 0; r < 32; ++r) { float v = (lane < np) ? p[(size_t)r * np] : 0.f; v = wave_sum(v); if (lane == 0) tab[wave * 32 + r] = raw ? v : 1.0f / sqrtf(v * (1.f / DM) + RMS_EPS); }
    LDS_WAIT(); __syncthreads();
}
struct QRow { u32x4 a[4], b[4]; };
__device__ __forceinline__ void quant_row_load(QRow& r, const bf16_t* src, int lane) {
    const GAS u32x4* sp = (const GAS u32x4*)src + 2 * lane;
#pragma unroll
    for (int j = 0; j < 4; ++j) { r.a[j] = sp[128 * j]; r.b[j] = sp[128 * j + 1]; }
}
__device__ __forceinline__ float quant_row_finish(const QRow& r, unsigned char* dst, int lane, float* ssq) {
    float v[4][16]; float amax = 0.f, ss = 0.f;
#pragma unroll
    for (int j = 0; j < 4; ++j) { const u32x4 a = r.a[j], b = r.b[j];
        v[j][0] = bf_lo(a.x); v[j][1] = bf_hi(a.x); v[j][2] = bf_lo(a.y); v[j][3] = bf_hi(a.y); v[j][4] = bf_lo(a.z); v[j][5] = bf_hi(a.z); v[j][6] = bf_lo(a.w); v[j][7] = bf_hi(a.w);
        v[j][8] = bf_lo(b.x); v[j][9] = bf_hi(b.x); v[j][10] = bf_lo(b.y); v[j][11] = bf_hi(b.y); v[j][12] = bf_lo(b.z); v[j][13] = bf_hi(b.z); v[j][14] = bf_lo(b.w); v[j][15] = bf_hi(b.w);
#pragma unroll
        for (int e = 0; e < 16; ++e) { amax = fmaxf(amax, fabsf(v[j][e])); ss += v[j][e] * v[j][e]; } }
    amax = wave_max(amax);
    if (ssq) *ssq = wave_sum(ss);
    const float inv = amax > 0.f ? 127.0f / amax : 0.f;
    GAS u32x4* dp = (GAS u32x4*)dst + lane;
#pragma unroll
    for (int j = 0; j < 4; ++j) { unsigned w[4];
#pragma unroll
        for (int q = 0; q < 4; ++q) { unsigned x = 0u;
#pragma unroll
            for (int e = 0; e < 4; ++e) { const int iv = (int)__builtin_rintf(v[j][4 * q + e] * inv); x |= ((unsigned)iv & 0xffu) << (8 * e); }
            w[q] = x; }
        dp[64 * j] = (u32x4){w[0], w[1], w[2], w[3]}; }
    return amax * (1.0f / 127.0f);
}
__device__ __forceinline__ float quant_row_i8(const bf16_t* src, unsigned char* dst, int lane, float* ssq) {
    asm volatile("" : "+v"(lane));
    QRow r; quant_row_load(r, src, lane); return quant_row_finish(r, dst, lane, ssq);
}
__device__ __forceinline__ void quant_rows_act(const bf16_t* XB, unsigned char* XQ, float* rstd_out  , float* rowf8_out, int m0, int m1, int step, int lane) {
    asm volatile("" : "+v"(lane));
#define QACT_FIN(R, m) do { float ssq; const float sc = quant_row_finish(R, XQ + (size_t)(m) * DM * 2, lane, &ssq); \
        if (lane == 0) { const float rstd = 1.0f / sqrtf(ssq * (1.f / DM) + RMS_EPS); if (rstd_out) rstd_out[m] = rstd; rowf8_out[m] = rstd * sc; } } while (0)
    int m = m0; if (m >= m1) return;
    QRow ra, rb; quant_row_load(ra, XB + (size_t)m * DM, lane);
    for (;;) {
        const int mb = m + step; const bool more_b = mb < m1;
        if (more_b) quant_row_load(rb, XB + (size_t)mb * DM, lane);
        QACT_FIN(ra, m);
        if (!more_b) break;
        const int ma = mb + step; const bool more_a = ma < m1;
        if (more_a) quant_row_load(ra, XB + (size_t)ma * DM, lane);
        QACT_FIN(rb, mb);
        if (!more_a) break;
        m = ma;
    }
#undef QACT_FIN
}
__device__ __forceinline__ void row_final_norm(const bf16_t* xrow, const float* g, float* orow, const float* part64, int lane, bool poison) {
    asm volatile("" : "+v"(lane));
    const GAS u32x4* xr = (const GAS u32x4*)xrow + lane; const GAS f32x4* gr = (const GAS f32x4*)g + 2 * lane;
    float rstd = 1.0f / sqrtf(wave_sum(part64[lane]) * (1.f / DM) + RMS_EPS);
    if (poison) rstd = __builtin_nanf("");
    GAS f32x4* o4 = (GAS f32x4*)orow + 2 * lane;
#pragma unroll
    for (int j = 0; j < 8; ++j) { const u32x4 w = xr[64 * j]; const f32x4 g0 = gr[128 * j], g1 = gr[128 * j + 1];
        o4[128 * j] = (f32x4){bf_lo(w.x), bf_hi(w.x), bf_lo(w.y), bf_hi(w.y)} * rstd * g0; o4[128 * j + 1] = (f32x4){bf_lo(w.z), bf_hi(w.z), bf_lo(w.w), bf_hi(w.w)} * rstd * g1; }
}
__device__ __forceinline__ void sincos_tab(float ang, float& c, float& s) {
    const double a = (double)ang;
    const double k = __builtin_rint(a * 0.63661977236758134308);
    const double r = __builtin_fma(-k, 6.12323399573676603587e-17, __builtin_fma(-k, 1.57079632679489655800, a));
    const double r2 = r * r;
    double sp = -1.0 / 1307674368000.0; sp = sp * r2 + 1.0 / 6227020800.0; sp = sp * r2 - 1.0 / 39916800.0; sp = sp * r2 + 1.0 / 362880.0; sp = sp * r2 - 1.0 / 5040.0; sp = sp * r2 + 1.0 / 120.0; sp = sp * r2 - 1.0 / 6.0; sp = sp * r2 + 1.0;
    const double sn = sp * r;
    double cp = 1.0 / 20922789888000.0; cp = cp * r2 - 1.0 / 87178291200.0; cp = cp * r2 + 1.0 / 479001600.0; cp = cp * r2 - 1.0 / 3628800.0; cp = cp * r2 + 1.0 / 40320.0; cp = cp * r2 - 1.0 / 720.0; cp = cp * r2 + 1.0 / 24.0; cp = cp * r2 - 0.5; cp = cp * r2 + 1.0;
    const int q = ((int)k) & 3;
    const double cs = (q == 0) ? cp : (q == 1) ? -sn : (q == 2) ? -cp : sn;
    const double ss = (q == 0) ? sn : (q == 1) ? cp : (q == 2) ? -sn : -cp;
    c = (float)cs; s = (float)ss;
}
__device__ __forceinline__ float inv_freq_of(int i) {
    switch (i) {
        case 0: return 0x1.000000p+0f; case 1: return 0x1.c2ef78p-2f; case 2: return 0x1.8d2760p-3f; case 3: return 0x1.5dc95ap-4f;
        case 4: return 0x1.341190p-5f; case 5: return 0x1.0f5386p-6f; case 6: return 0x1.ddee9ep-8f; case 7: return 0x1.a4ee40p-9f;
        case 8: return 0x1.72ba42p-10f; case 9: return 0x1.46831ap-11f; case 10: return 0x1.1f91f0p-12f; case 11: return 0x1.fa8b86p-14f;
        case 12: return 0x1.be218cp-15f; case 13: return 0x1.88ec20p-16f; case 14: return 0x1.5a0f4ep-17f; default: return 0x1.30c94ep-18f;
    }
}

template <int W>
__device__ __forceinline__ void pool_rows(const bf16_t* PROJ, bf16_t* POOLED, int row, int ch8) {
    constexpr int H = W / 2;
    {
        const int t = row & (SEQ - 1);
        const bf16_t* base = PROJ + (size_t)(row - t) * NIN + C_U + ch8 * 8;
        u32x4 wv[W];
#pragma unroll
        for (int i = 0; i < W; ++i) { const int j = t - H + i, jc = j < 0 ? 0 : (j > SEQ - 1 ? SEQ - 1 : j); wv[i] = *(const u32x4*)(base + (size_t)jc * NIN); }
        asm volatile("" ::: "memory");
        float a[8] = {0.f, 0.f, 0.f, 0.f, 0.f, 0.f, 0.f, 0.f};
#pragma unroll
        for (int i = 0; i < W; ++i) { const u32x4 w = wv[i]; const float m = ((unsigned)(t - H + i) < (unsigned)SEQ) ? 1.f : 0.f;
            a[0] = fmaf(bf_lo(w.x), m, a[0]); a[1] = fmaf(bf_hi(w.x), m, a[1]); a[2] = fmaf(bf_lo(w.y), m, a[2]); a[3] = fmaf(bf_hi(w.y), m, a[3]);
            a[4] = fmaf(bf_lo(w.z), m, a[4]); a[5] = fmaf(bf_hi(w.z), m, a[5]); a[6] = fmaf(bf_lo(w.w), m, a[6]); a[7] = fmaf(bf_hi(w.w), m, a[7]); }
        const u32x4 own = wv[H];
        const int lo = (t - H) > 0 ? (t - H) : 0, hi = (t + H - 1) < (SEQ - 1) ? (t + H - 1) : (SEQ - 1);
        const float inv = 1.0f / (float)(hi - lo + 1);
        u32x4 o; o.x = cvt_pk_bf16(a[0] * inv - bf_lo(own.x), a[1] * inv - bf_hi(own.x)); o.y = cvt_pk_bf16(a[2] * inv - bf_lo(own.y), a[3] * inv - bf_hi(own.y));
        o.z = cvt_pk_bf16(a[4] * inv - bf_lo(own.z), a[5] * inv - bf_hi(own.z)); o.w = cvt_pk_bf16(a[6] * inv - bf_lo(own.w), a[7] * inv - bf_hi(own.w));
        *(u32x4*)(POOLED + (size_t)row * PW + ch8 * 8) = o;
    }
}

__global__ void __launch_bounds__(NWAVES * 64, 2) fwd_kernel(Args args_k) {
    extern __shared__ __attribute__((aligned(16))) unsigned char lds[];
    LAS unsigned char* const L = (LAS unsigned char*)lds;
    volatile LAS unsigned* const MISC = (volatile LAS unsigned*)(L + MISC_OFF);
    const int wave = __builtin_amdgcn_readfirstlane((int)threadIdx.x >> 6);
#define OPAQUE_TID() int tid = tid_of(wave); asm volatile("" : "+v"(tid)); const int lane = tid & 63; (void)lane
    const int G = gridDim.x; const int bx = blockIdx.x; const int vcu = ((G & 7) == 0) ? (bx & 7) * (G >> 3) + (bx >> 3) : bx;
    unsigned char* const ws = args_k.ws;
#if defined(__HIP_DEVICE_COMPILE__)
#define LOAD_ARGS() const __attribute__((address_space(4))) unsigned long long* ap_ = (const __attribute__((address_space(4))) unsigned long long*)__builtin_amdgcn_kernarg_segment_ptr(); asm volatile("" : "+s"(ap_)); \
    Args args; { static_assert(sizeof(Args) == 15 * 8, "Args"); unsigned long long* ad_ = (unsigned long long*)&args; _Pragma("unroll") for (int i_ = 0; i_ < 15; ++i_) ad_[i_] = ap_[i_]; }
#else
#define LOAD_ARGS() const Args args = args_k
#endif
    gu32* const ctl = (gu32*)(ws + WS_CTL);
    for (int u = threadIdx.x; u < (LDS_BYTES - LDSCTL_OFF) / 4; u += NWAVES * 64) ((LAS unsigned*)(L + LDSCTL_OFF))[u] = 0u;
    __syncthreads();
    const XcdBarrier bar = xcd_barrier_post((unsigned*)(ctl + CW_BAR), MISC + 8, (unsigned)G);
    if (G != 256) return;
    constexpr bool grouped = true;
    static_assert(DEPTH == 2, "the background conversion streams are laid out for two layers");
    const int gsh = grouped ? 2 : 0, grp = grouped ? ((bx & 7) >> 1) : 0, gsz = G >> gsh, rank = grouped ? ((bx & 1) * 32 + (bx >> 3)) : vcu;
    XcdBarrier sbar = bar;
    if (grouped) sbar = xcd_barrier_post((unsigned*)(ctl + CW_GBAR + grp * GBAR_STRIDE), MISC + 10, 64u);
#define GRID_BAR() xcd_barrier(bar, wave)
#define SEAM_BAR() xcd_barrier(sbar, wave)
    int bgk = 0;
#define BG_POST(k) do { int t0_ = tid_of(wave); asm volatile("" : "+v"(t0_)); if (rank == 0 && t0_ == 0) (void)xb_add((unsigned*)(ctl + CW_DONE + 64 * (k)), 1u); } while (0)
#define BG_WAIT(k) do { int t0_ = tid_of(wave); asm volatile("" : "+v"(t0_)); if (t0_ == 0) { unsigned* p_ = (unsigned*)(ctl + CW_DONE + 64 * (k)); XB_SPIN(xb_ld(p_) < 4u, (unsigned*)(ctl + CW_BAR)); \
        __builtin_amdgcn_fence(__ATOMIC_ACQUIRE, "agent"); asm volatile("s_waitcnt vmcnt(0)" ::: "memory"); } __syncthreads(); } while (0)
#define BG_JOB(base_, n_) const BgJob bgj{&args, wsp, (base_), (n_), gw, NGW}
    const int gw = vcu * NWAVES + wave, NGW = G * NWAVES;
    const int NGT = G * NWAVES * 64;
    const int sw = rank * NWAVES + wave, NSW = gsz * NWAVES;
    const int NST = gsz * NWAVES * 64;
    const int nrow_g = M >> gsh, row_g0 = grp * nrow_g;

#define OPAQUE_WS() LOAD_ARGS(); GAS unsigned char* wsg_ = (GAS unsigned char*)args.ws; asm volatile("" : "+s"(wsg_)); unsigned char* wsp = (unsigned char*)wsg_;     int bxo = blockIdx.x; asm volatile("" : "+s"(bxo)); (void)bxo;     \
    float* const cosT = (float*)(wsp + WS_ROT); float* const sinT = cosT + SEQ * 16; bf16_t* const XB = (bf16_t*)(wsp + WS_H); float* const SSQ = (float*)(wsp + WS_CTL) + CW_SSQ; \
    bf16_t* const PROJ = (bf16_t*)(wsp + WS_PROJ); bf16_t* const ATTO = (bf16_t*)(wsp + WS_ATTO); bf16_t* const POOLED = (bf16_t*)(wsp + WS_POOLED); bf16_t* const MIXED = (bf16_t*)(wsp + WS_MIXED); \
    bf16_t* const MERGED = (bf16_t*)(wsp + WS_MERGED); float* const X = (float*)(wsp + WS_X); bf16_t* const ACT = (bf16_t*)(wsp + WS_ACT); float* const PART = (float*)(wsp + WS_PART); unsigned char* const XQ = wsp + WS_XQ; float* const ROWS = (float*)(wsp + WS_ROWS); unsigned char* const wl = wsp + WS_W + (size_t)l * W_LAYER; \
    (void)cosT; (void)sinT; (void)XB; (void)SSQ; (void)PROJ; (void)ATTO; (void)POOLED; (void)MIXED; (void)MERGED; (void)X; (void)ACT; (void)PART; (void)XQ; (void)ROWS; (void)wl

    {
        LOAD_ARGS(); GAS unsigned char* wsg_ = (GAS unsigned char*)args.ws; asm volatile("" : "+s"(wsg_)); unsigned char* wsp = (unsigned char*)wsg_;
        float* const cosT = (float*)(wsp + WS_ROT); float* const sinT = cosT + SEQ * 16; bf16_t* const XB = (bf16_t*)(wsp + WS_H); float* const SSQ = (float*)(wsp + WS_CTL) + CW_SSQ;
        REPEAT(0) { OPAQUE_TID(); const CvtJob J = CvtJob{0, I_IN, IO_DN, I_DN, I_LAYER + IO_DN, I_DN}; cvt_run<65u>(args, wsp, J, gw, NGW, lane); }
        { constexpr int NBG = (NIN - PN8 * 256) / 32, NBU = NGU / 32, NBL = NBG + NBU;
          OPAQUE_TID();
          for (int b = vcu; b < DEPTH * NBL; b += G) { const int l = b / NBL, r = b - l * NBL; const bool gt8 = r < NBG;
            cvt8_block(gt8 ? args.in[2] + (size_t)l * DM * NIN : args.in[10] + (size_t)l * DM * NGU, gt8 ? NIN : NGU, gt8 ? PN8 * 256 + 32 * r : 32 * (r - NBG), (gt8 ? args.in[1] : args.in[9]) + (size_t)l * DM,
                       gt8 ? wsp + WS_WQI + (size_t)l * WQI_LAYER : wsp + WS_WQ + (size_t)l * WQ_LAYER, gt8 ? 0 : 2, gt8 ? (float*)(wsp + WS_SWI) + (size_t)l * NIN : (float*)(wsp + WS_SW) + (size_t)l * NGU,
                       (LAS float*)(L + RING_BYTES), wave, lane); } }
        { OPAQUE_TID();
        for (int e = vcu * (NWAVES * 64) + tid; e < SEQ * 16; e += NGT) { const int pos = e >> 4, i = e & 15; float c, s; sincos_tab((float)pos * inv_freq_of(i), c, s); cosT[e] = c; sinT[e] = s; }
        { unsigned char* const XQ = wsp + WS_XQ; float* const ROWS = (float*)(wsp + WS_ROWS);
          for (int m = gw; m < M; m += NGW) row_prologue(args.in[0] + (size_t)m * DM, XB + (size_t)m * DM, XQ + (size_t)m * DM * 2, ROWS + m, ROWS + M + m, lane); } }
    }
    GRID_BAR();

#ifdef STAGGER_US
    if (grouped && grp > 0) { const unsigned long long t0 = __builtin_amdgcn_s_memrealtime(); while (__builtin_amdgcn_s_memrealtime() - t0 < (unsigned long long)(grp * STAGGER_US * 100)) __builtin_amdgcn_s_sleep(8); }
#endif
    for (int l = 0; l < DEPTH; ++l) {
        REPEAT(1) {
        {
            OPAQUE_WS();
            LAS float* const rtab = (LAS float*)(L + RING_BYTES);
            if (l > 0) { { OPAQUE_TID(); int swo = sw; asm volatile("" : "+s"(swo)); quant_rows_act(XB, XQ, ROWS, ROWS + M, row_g0 + swo, row_g0 + nrow_g, NSW, lane); }
            SEAM_BAR(); }
            if (grouped) {
                pg8::SchedInMix S; S.init(bxo); S.Ab = (const char*)XB; S.Aq = (const char*)XQ; S.Bb = (const char*)(wl + WO_IN); S.Bq = (const char*)(wsp + WS_WQI + (size_t)l * WQI_LAYER);
                { OPAQUE_TID(); build_rstd_table(rtab, ROWS, 1, S.pm, wave, lane, true); build_rstd_table(rtab + 256, ROWS + M, 1, S.pm, wave, lane, true); }
                pg8::EpiInMix E{PROJ, cosT, sinT, rtab, S.pm, (const float*)(wsp + WS_SWI) + (size_t)l * NIN, (LAS float*)(L + RING_BYTES + 2048)};
                if (l == 0) bgk = 0;
                BG_JOB(l == 0 ? IO_POOL : I_LAYER + IO_DN, l == 0 ? IO_DN - IO_POOL : 0);
                pg8::gemm_phase<pg8::EpiInMix, pg8::SchedInMix, BgOn<94u>>(wave, L, DM, S, E, &bgj, &bgk);
                { OPAQUE_TID(); bg_drain<94u>(bgj, bgk, lane); }
            } else {
                pg8::SchedPlain S; S.T.init(M / 256, NIN / 256, G, bxo); S.A = (const char*)XB; S.B = (const char*)(wl + WO_IN); S.tA = (size_t)256 * DM * 2; S.tB = (size_t)256 * DM * 2; S.nt = DM / 64;
                int tab_pm = -1;
                { pg8::UnitD u0; if (S.next(0, u0)) { OPAQUE_TID(); tab_pm = u0.pm; build_rstd_table(rtab, ROWS, 1, tab_pm, wave, lane, true); } }
                pg8::EpiIn E{PROJ, cosT, sinT, rtab, tab_pm};
                pg8::gemm_phase<pg8::EpiIn, pg8::SchedPlain>(wave, L, DM, S, E);
            }
        }
        SEAM_BAR(); BG_POST(l == 0 ? 0 : 3); }
        REPEAT(2) {
        {
            OPAQUE_WS();
            const float* sink = args.in[3] + l * NHEAD;
            constexpr int NITEMS = BATCH * NHEAD * (SEQ / 256);
            for (int Li = grp * (NITEMS >> gsh) + rank; Li < (grp + 1) * (NITEMS >> gsh); Li += gsz) {
                const int qc_ = Li & 31, kh_ = (Li >> 5) & 3, b_ = Li >> 7; const size_t r0_ = (size_t)b_ * SEQ;
                attn::BlockRef cur;
                cur.Q = PROJ + (r0_ + qc_ * 64) * NIN + C_Q + kh_ * 4 * HD; cur.K = PROJ + r0_ * NIN + C_K + kh_ * HD; cur.V = PROJ + r0_ * NIN + C_V + kh_ * HD;
                cur.O = ATTO + (r0_ + qc_ * 64) * AW + kh_ * 4 * HD; cur.P0 = qc_ * 64; cur.sink4 = sink + kh_ * 4;
                attn::attn_block(wave, cur, (char*)lds);
            }
            { OPAQUE_TID(); int swo = sw; asm volatile("" : "+s"(swo));
              for (int p = swo; p < nrow_g * 4; p += NSW) { const int row = row_g0 + (p >> 2), g = p & 3, ch8 = g * 64 + lane;
                if (g == 0) pool_rows<2>(PROJ, POOLED, row, ch8); else if (g == 1) pool_rows<4>(PROJ, POOLED, row, ch8); else if (g == 2) pool_rows<8>(PROJ, POOLED, row, ch8); else pool_rows<16>(PROJ, POOLED, row, ch8); } }
        }
        SEAM_BAR(); if (l == 0) BG_WAIT(0); }
        REPEAT(3) {
        {
            OPAQUE_WS();
            pg8::SchedPool S; S.T.init(M / 256, PW / 256, G, bxo); S.A = (const char*)POOLED; S.B = (const char*)(wl + WO_POOL); S.tA = (size_t)256 * PW * 2; S.tB = (size_t)256 * 512 * 2; S.nt = 512 / 64;
            pg8::EpiPool E{MIXED, args.in[5] + (size_t)l * PW};
            if (l == 0) bgk = 0;
            BG_JOB(IO_DN, 0);
            pg8::gemm_phase<pg8::EpiPool, pg8::SchedPool, BgOn<64u>>(wave, L, PW, S, E, &bgj, &bgk);
        }
        SEAM_BAR(); }
        REPEAT(4) {
        {
            OPAQUE_WS();
            pg8::SchedBranch S; S.T.init(M / 256, DM / 256, G, bxo); S.A1 = (const char*)ATTO; S.B1 = (const char*)(wl + WO_BA); S.A2 = (const char*)MIXED; S.B2 = (const char*)(wl + WO_BP);
            S.tA = (size_t)256 * AW * 2; S.tB = (size_t)256 * AW * 2; S.nt = AW / 64;
            pg8::EpiBranch E{PROJ, MERGED};
            BG_JOB(IO_DN, 0);
            pg8::gemm_phase<pg8::EpiBranch, pg8::SchedBranch, BgOn<64u>>(wave, L, AW, S, E, &bgj, &bgk);
        }
        SEAM_BAR(); }
        REPEAT(5) {
        {
            OPAQUE_WS();
            pg8::SchedPlain S; S.T.init(M / 256, DM / 256, G, bxo); S.A = (const char*)MERGED; S.B = (const char*)(wl + WO_OUT); S.tA = (size_t)256 * DM * 2; S.tB = (size_t)256 * DM * 2; S.nt = DM / 64;
            const bool dry = ((REPMASK >> 5) & 1) && rep_ == 0;
            pg8::EpiRes E{l == 0 ? args.in[0] : nullptr, XB, dry ? (bf16_t*)(wsp + WS_END) : XB, nullptr, PART + (size_t)(dry ? 4 : 2 * l) * M * 64};
            BG_JOB(IO_DN, 0);
            pg8::gemm_phase<pg8::EpiRes, pg8::SchedPlain, BgOn<64u>>(wave, L, DM, S, E, &bgj, &bgk);
            { OPAQUE_TID(); bg_drain<64u>(bgj, bgk, lane); }
        }
        SEAM_BAR(); if (l == 0) BG_POST(1); }
        REPEAT(7) {
        {
            OPAQUE_WS();
            { OPAQUE_TID(); int swo = sw; asm volatile("" : "+s"(swo)); quant_rows_act(XB, XQ, nullptr, ROWS + M, row_g0 + swo, row_g0 + nrow_g, NSW, lane); }
            SEAM_BAR();
            pg8::SchedPlain S; S.T.init(M / 256, NGU / 256, G, bxo); S.A = (const char*)XQ; S.B = (const char*)(wsp + WS_WQ + (size_t)l * WQ_LAYER); S.tA = (size_t)256 * DM * 2; S.tB = (size_t)256 * DM; S.nt = DM / 128;
            LAS float* const rtab = (LAS float*)(L + RING_BYTES);
            int tab_pm = -1;
            { pg8::UnitD u0; if (S.next(0, u0)) { OPAQUE_TID(); tab_pm = u0.pm; build_rstd_table(rtab, ROWS + M, 1, tab_pm, wave, lane, true); } }
            pg8::EpiGU8 E{ACT, rtab, tab_pm, (const float*)(wsp + WS_SW) + (size_t)l * NGU, (LAS float*)(L + RING_BYTES + 2048)};
            if (l == 0) bgk = 0;
            BG_JOB(I_LAYER, l == 0 ? IO_DN : 0);
            pg8::gemm_phase<pg8::EpiGU8, pg8::SchedPlain, BgOn<31u>>(wave, L, DM, S, E, &bgj, &bgk);
            { OPAQUE_TID(); bg_drain<31u>(bgj, bgk, lane); }
        }
        SEAM_BAR(); if (l == 0) { BG_POST(2); BG_WAIT(1); } else BG_WAIT(3); }
        REPEAT(8) {
        {
            OPAQUE_WS();
            pg8::SchedPlain S; S.T.init(M / 256, DM / 256, G, bxo); S.A = (const char*)ACT; S.B = (const char*)(wl + WO_DN); S.tA = (size_t)256 * FF * 2; S.tB = (size_t)256 * FF * 2; S.nt = FF / 64;
            const bool dry = ((REPMASK >> 8) & 1) && rep_ == 0;
            pg8::EpiRes E{nullptr, XB, dry ? (bf16_t*)(wsp + WS_END) : XB, nullptr, PART + (size_t)(dry ? 4 : 2 * l + 1) * M * 64};
            if (l == 0) bgk = 0;
            BG_JOB(I_LAYER + IO_DN, 0);
            pg8::gemm_phase<pg8::EpiRes, pg8::SchedPlain, BgOn<64u>>(wave, L, FF, S, E, &bgj, &bgk);
        }
        SEAM_BAR(); if (l == 0) BG_WAIT(2); }
        if (l + 1 == DEPTH) {
            OPAQUE_WS(); OPAQUE_TID();
            const bool poison = (xb_ld((unsigned*)(ctl + CW_BAR) + XB_TMO) | xb_ld(sbar.bar + XB_TMO)) != 0u;
            const float* pq = PART + (size_t)(2 * DEPTH - 1) * M * 64;
            for (int m = row_g0 + sw; m < row_g0 + nrow_g; m += NSW) row_final_norm(XB + (size_t)m * DM, args.in[12], args.out + (size_t)m * DM, pq + (size_t)m * 64, lane, poison);
        }
    }
#undef GRID_BAR
#undef SEAM_BAR
#undef BG_POST
#undef BG_WAIT
#undef BG_JOB
#undef OPAQUE_WS
#undef OPAQUE_TID
}

extern "C" void kernel_launch(void* const* d_in, const int* in_sizes, int n_in, void* d_out, int out_size, void* d_ws, size_t ws_size, hipStream_t stream) {
    static int grid = 0;
    if (grid == 0) {
        if (n_in != 13 || in_sizes[0] != M * DM || out_size != M * DM || ws_size < WS_END + 64 * MiB) {
            fprintf(stderr, "kernel_launch: unexpected shapes (n_in %d, in0 %d, out %d, ws %zu, need %zu); nothing launched\n", n_in, n_in > 0 ? in_sizes[0] : -1, out_size, ws_size, (size_t)WS_END); grid = -1; return; }
        int dev = 0, cus = 0, per_cu = 0;
        if (hipGetDevice(&dev) != hipSuccess || hipDeviceGetAttribute(&cus, hipDeviceAttributeMultiprocessorCount, dev) != hipSuccess) { fprintf(stderr, "kernel_launch: device query failed\n"); grid = -1; return; }
        if (hipFuncSetAttribute((const void*)fwd_kernel, hipFuncAttributeMaxDynamicSharedMemorySize, LDS_BYTES) != hipSuccess) { fprintf(stderr, "kernel_launch: hipFuncSetAttribute failed\n"); grid = -1; return; }
        if (hipOccupancyMaxActiveBlocksPerMultiprocessor(&per_cu, (const void*)fwd_kernel, NWAVES * 64, LDS_BYTES) != hipSuccess || per_cu < 1)
            fprintf(stderr, "kernel_launch: note: occupancy query reports %d workgroups per CU\n", per_cu);
        (void)hipGetLastError();
        if (cus != 256) { fprintf(stderr, "kernel_launch: this build needs a 256-CU device (found %d CUs); nothing launched\n", cus); grid = -1; return; }
        grid = cus;
    }
    if (grid < 0) return;
    if (hipMemsetAsync((char*)d_ws + WS_CTL, 0, CTL_ZERO_BYTES, stream) != hipSuccess) { fprintf(stderr, "kernel_launch: memset failed\n"); return; }
    Args a{};
    for (int i = 0; i < 13; ++i) a.in[i] = (const float*)d_in[i];
    a.out = (float*)d_out; a.ws = (unsigned char*)d_ws;
    hipLaunchKernelGGL(fwd_kernel, dim3(grid), dim3(NWAVES * 64), LDS_BYTES, stream, a);
    const hipError_t le = hipPeekAtLastError();
    if (le != hipSuccess) fprintf(stderr, "kernel_launch: launch failed: %s\n", hipGetErrorName(le));
}
```

```cpp
#include <hip/hip_runtime.h>
#include <hip/hip_bf16.h>
#include <cstdio>
#include <cstdint>
#ifndef REPMASK
#define REPMASK 0
#endif
#define REPEAT(k) _Pragma("unroll") for (int rep_ = 0; rep_ < 1 + ((REPMASK >> (k)) & 1); ++rep_)

#define GAS __attribute__((address_space(1)))
#define LAS __attribute__((address_space(3)))
typedef unsigned short bf16_t;
typedef short bf16x8 __attribute__((ext_vector_type(8)));
typedef short s16x4 __attribute__((ext_vector_type(4)));
typedef float f32x4 __attribute__((ext_vector_type(4)));
typedef float f32x16 __attribute__((ext_vector_type(16)));
typedef unsigned u32x4 __attribute__((ext_vector_type(4)));
typedef int i32x4 __attribute__((ext_vector_type(4)));
typedef GAS unsigned gu32;

constexpr int BATCH = 4, SEQ = 2048, M = BATCH * SEQ, DM = 4096, NHEAD = 16, NKVH = 4, HD = 128, DEPTH = 2;
constexpr int AW = 2048, KVW = 512, PW = 2048, NIN = 13312, FF = 11008, NGU = 2 * FF;
constexpr int C_Q = 0, C_K = 2048, C_V = 2560, C_U = 3072, C_GA = 5120, C_GB = 9216;
constexpr float RMS_EPS = 1e-6f;

constexpr size_t MiB = 1u << 20;
constexpr size_t WS_CTL = 0, CTL_ZERO_BYTES = 1 * MiB;
constexpr size_t WS_ROT = 1 * MiB;
constexpr size_t WS_W = 2 * MiB;
constexpr size_t WO_IN = 0, WO_POOL = 108 * MiB, WO_BA = 112 * MiB, WO_BP = 130 * MiB, WO_OUT = 148 * MiB, WO_DN = 182 * MiB, W_LAYER = 274 * MiB;
static_assert((size_t)NIN * DM * 2 <= WO_POOL - WO_IN && (size_t)4 * 512 * 512 * 2 <= WO_BA - WO_POOL && (size_t)DM * AW * 2 <= WO_BP - WO_BA && (size_t)DM * DM * 2 <= WO_DN - WO_OUT && (size_t)DM * FF * 2 <= W_LAYER - WO_DN, "weight map");
constexpr size_t WS_ACTS = WS_W + DEPTH * W_LAYER;
constexpr size_t WS_H = WS_ACTS, WS_PROJ = WS_H + 64 * MiB, WS_ATTO = WS_PROJ + 208 * MiB, WS_POOLED = WS_ATTO + 32 * MiB, WS_MIXED = WS_POOLED + 32 * MiB,
                 WS_MERGED = WS_MIXED + 32 * MiB, WS_X = WS_MERGED + 64 * MiB, WS_ACT = WS_X + 128 * MiB, WS_PART = WS_ACT + 172 * MiB, WS_WQ = WS_PART + 10 * MiB, WQ_LAYER = 88 * MiB, WS_XQ = WS_WQ + DEPTH * WQ_LAYER, WS_SW = WS_XQ + 64 * MiB, WS_ROWS = WS_SW + 1 * MiB,
                 WS_WQI = WS_ROWS + 1 * MiB, WQI_LAYER = 104 * MiB, WS_SWI = WS_WQI + DEPTH * WQI_LAYER, WS_END = WS_SWI + 1 * MiB;
static_assert((size_t)NGU * DM <= WQ_LAYER && (size_t)DEPTH * NGU * 4 <= 1 * MiB && (size_t)NIN * DM <= WQI_LAYER && (size_t)DEPTH * NIN * 4 <= 1 * MiB && (size_t)M * DM * 2 <= 64 * MiB, "int8 map");
constexpr int CVT8_HOLD = 8;
constexpr int PN8 = 12;
static_assert((size_t)M * NIN * 2 <= 208 * MiB && (size_t)M * FF * 2 <= 172 * MiB, "activation map");
constexpr int CW_SSQ = 32768;
constexpr int CW_DONE = 28672;
constexpr int CW_BAR = 4096, CW_GBAR = 8192, GBAR_STRIDE = 4096;

constexpr int RING_BYTES = 131072, LDSCTL_OFF = 139264, MISC_OFF = LDSCTL_OFF + 320, LDS_BYTES = 147456;
constexpr int NWAVES = 8;

#define LDS_WAIT() asm volatile("s_waitcnt lgkmcnt(0)" ::: "memory")
#define VM_WAIT() asm volatile("s_waitcnt vmcnt(0)" ::: "memory")
__device__ __forceinline__ unsigned cvt_pk_bf16(float lo, float hi) { unsigned r; asm volatile("v_cvt_pk_bf16_f32 %0, %1, %2" : "=v"(r) : "v"(lo), "v"(hi)); return r; }
__device__ __forceinline__ float bf_lo(unsigned w) { return __uint_as_float(w << 16); }
__device__ __forceinline__ float bf_hi(unsigned w) { return __uint_as_float(w & 0xffff0000u); }
__device__ __forceinline__ int tid_of(int wave) { unsigned m = ~0u; asm volatile("" : "+s"(m)); return wave * 64 + (int)__builtin_amdgcn_mbcnt_hi(m, __builtin_amdgcn_mbcnt_lo(m, 0u)); }
template <int K> __device__ __forceinline__ float xchg(float v) { static_assert(K >= 1 && K <= 16, "xchg"); return __builtin_bit_cast(float, __builtin_amdgcn_ds_swizzle(__builtin_bit_cast(int, v), (K << 10) | 0x1f)); }
__device__ __forceinline__ float sum32(float v) { auto r = __builtin_amdgcn_permlane32_swap(__float_as_uint(v), __float_as_uint(v), false, false); const unsigned a = r[0], b = r[1]; return __uint_as_float(a) + __uint_as_float(b); }
__device__ __forceinline__ float max32(float v) { auto r = __builtin_amdgcn_permlane32_swap(__float_as_uint(v), __float_as_uint(v), false, false); const unsigned a = r[0], b = r[1]; return fmaxf(__uint_as_float(a), __uint_as_float(b)); }
__device__ __forceinline__ float wave_max(float v) { v = fmaxf(v, xchg<1>(v)); v = fmaxf(v, xchg<2>(v)); v = fmaxf(v, xchg<4>(v)); v = fmaxf(v, xchg<8>(v)); v = fmaxf(v, xchg<16>(v)); return max32(v); }
__device__ __forceinline__ float fast_sigmoid(float x) { return __builtin_amdgcn_rcpf(1.0f + __builtin_amdgcn_exp2f(-1.4426950408889634f * x)); }

namespace pg8 {
constexpr int BM = 256, BK = 64, HALF = 128, HTB = HALF * BK * 2, STAGE_BYTES = 8 * HTB, NXCD = 8, WGM = 8;
__host__ __device__ __forceinline__ int lds_byte(int r, int c) { const int st = (r >> 4) * 2 + (c >> 5), rr = r & 15, cc = c & 31, ob = rr * 64 + cc * 2; return st * 1024 + (ob ^ (((ob >> 9) & 1) << 5)); }
__host__ __device__ __forceinline__ void stage_rc(int b, int& R, int& C) { const int st = b / 1024, sb = b % 1024, swz = sb ^ (((sb >> 9) & 1) << 5); R = (st >> 1) * 16 + swz / 64; C = (st & 1) * 32 + (swz % 64) / 2; }
__host__ __device__ __forceinline__ int perm32(int rho) { const int n = rho >> 4, i = rho & 15; return 8 * (i >> 2) + 4 * n + (i & 3); }

struct UnitD { const char* A; const char* B; int pm, pn, nt, kind, slot; };

struct TileOrder {
    int nM, nN, nwg, G, c;
    __device__ __forceinline__ void init(int nM_, int nN_, int G_, int c_) { nM = nM_; nN = nN_; nwg = nM * nN; G = G_; c = c_; }
    __device__ __forceinline__ bool tile(int i, int& pm, int& pn) const {
        const long L = (long)i * G + c; if (L >= nwg) return false;
        int wgid = (int)L; { const int q = nwg / NXCD, r = nwg % NXCD, xcd = wgid % NXCD, off = wgid / NXCD; wgid = (xcd < r ? xcd * (q + 1) : r * (q + 1) + (xcd - r) * q) + off; }
        const int nig = WGM * nN, gid = wgid / nig, fm = gid * WGM, gsz = (nM - fm) < WGM ? (nM - fm) : WGM;
        pm = fm + ((wgid % nig) % gsz); pn = (wgid % nig) / gsz; return true;
    }
};
struct SchedPlain {
    TileOrder T; const char* A; const char* B; size_t tA, tB; int nt;
    __device__ __forceinline__ bool next(int i, UnitD& u) const { int pm, pn; if (!T.tile(i, pm, pn)) return false; u.pm = pm; u.pn = pn; u.A = A + (size_t)pm * tA; u.B = B + (size_t)pn * tB; u.nt = nt; u.kind = 0; return true; }
};
struct SchedPool {
    TileOrder T; const char* A; const char* B; size_t tA, tB; int nt;
    __device__ __forceinline__ bool next(int i, UnitD& u) const { int pm, pn; if (!T.tile(i, pm, pn)) return false; u.pm = pm; u.pn = pn; u.A = A + (size_t)pm * tA + (size_t)(pn >> 1) * 1024; u.B = B + (size_t)pn * tB; u.nt = nt; u.kind = 0; return true; }
};
struct SchedBranch {
    TileOrder T; const char* A1; const char* B1; const char* A2; const char* B2; size_t tA, tB; int nt;
    __device__ __forceinline__ bool next(int i, UnitD& u) const { int pm, pn; if (!T.tile(i >> 1, pm, pn)) return false; const int s = i & 1; u.pm = pm; u.pn = pn;
        u.A = (s ? A2 : A1) + (size_t)pm * tA; u.B = (s ? B2 : B1) + (size_t)pn * tB; u.nt = nt; u.kind = s; return true; }
};

}
struct Args { const float* in[13]; float* out; unsigned char* ws; };
__device__ __forceinline__ int destrow(int s) { return (s & ~31) + pg8::perm32(s & 31); }
__device__ __forceinline__ int srccol(int map, int s) {
    const int d = destrow(s);
    if (map == 1) {
        if (d < C_V) { const int p = d & 127; if (p < 32) { const int e = ((p >> 3) << 2) | (p & 3); return d - p + e + (((p >> 2) & 1) << 4); } }
        return d;
    }
    if (map == 2) {
        const int t = d >> 8, r = d & 255; return r < 128 ? (t << 7) + r : FF + (t << 7) + (r - 128);
    }
    return d;
}
constexpr int NB_IN = PN8 * 256 / 256;
constexpr int I_IN = (DM / 32) * 4 * NB_IN, I_PW = (512 / 32) * (512 / 64), I_BR = (AW / 32) * (DM / 64), I_OUT = (DM / 32) * (DM / 64), I_GU = 0, I_DN = (FF / 32) * (DM / 64);
constexpr int IO_POOL = I_IN, IO_BA = IO_POOL + 4 * I_PW, IO_BP = IO_BA + I_BR, IO_OUT = IO_BP + I_BR, IO_GU = IO_OUT + I_OUT, IO_DN = IO_GU + I_GU, I_LAYER = IO_DN + I_DN;
static_assert(I_LAYER == (PN8 == 20 ? 49152 : 45056), "item map");
struct CvtItem { const float* src; unsigned char* dst; const float* gain; int N, slot0, map, c32; };
template <unsigned KINDS>
__device__ __forceinline__ CvtItem cvt_decode(const Args& args, unsigned char* wsp, int it) {
    const int l = it / I_LAYER; int r = it - l * I_LAYER; unsigned char* wl = wsp + WS_W + (size_t)l * W_LAYER;
    const float* W = nullptr; unsigned char* D = nullptr; const float* gain = nullptr; int N = 512, K = DM, map = 0, k32 = 0, sq = 0;
    if ((KINDS & 1u) && r < IO_POOL) { k32 = r / (4 * NB_IN); sq = r - k32 * (4 * NB_IN); W = args.in[2] + (size_t)l * DM * NIN; N = NIN; D = wl + WO_IN; map = 1; gain = args.in[1] + (size_t)l * DM; }
    else if ((KINDS & 2u) && r < IO_BA) { r -= IO_POOL; const int g = r / I_PW; r -= g * I_PW; k32 = r >> 3; sq = r & 7; W = args.in[4] + ((size_t)l * 4 + g) * 512 * 512; N = 512; K = 512; D = wl + WO_POOL + (size_t)g * 512 * 512 * 2; }
    else if ((KINDS & 4u) && r < IO_BP) { r -= IO_BA; k32 = r >> 6; sq = r & 63; W = args.in[6] + (size_t)l * AW * DM; N = DM; K = AW; D = wl + WO_BA; }
    else if ((KINDS & 8u) && r < IO_OUT) { r -= IO_BP; k32 = r >> 6; sq = r & 63; W = args.in[7] + (size_t)l * PW * DM; N = DM; K = PW; D = wl + WO_BP; }
    else if ((KINDS & 16u) && r < IO_GU) { r -= IO_OUT; k32 = r >> 6; sq = r & 63; W = args.in[8] + (size_t)l * DM * DM; N = DM; D = wl + WO_OUT; }
    else if (KINDS & 64u) { r -= IO_DN; k32 = r >> 6; sq = r & 63; W = args.in[11] + (size_t)l * FF * DM; N = DM; K = FF; D = wl + WO_DN; }
    CvtItem d; d.N = N; d.slot0 = 64 * sq; d.map = map; d.c32 = k32 & 1; d.gain = gain ? gain + 32 * k32 : nullptr;
    d.src = W + (size_t)(32 * k32) * N; d.dst = D + (size_t)(sq >> 2) * ((size_t)K * 512) + (size_t)(k32 >> 1) * 32768;
    return d;
}
__device__ __forceinline__ void cvtk_load(const CvtItem& d, float (&w)[32], int lane) {
    const unsigned loff = (unsigned)srccol(d.map, d.slot0 + lane) * 4u;
#pragma unroll
    for (int j = 0; j < 32; ++j) w[j] = *(const float*)((const char*)(d.src + (size_t)j * d.N) + loff);
}
__device__ __forceinline__ float cvtk_gain_load(const CvtItem& d, int lane) { const float* gp = d.gain ? d.gain : d.src; return gp[lane & 31]; }
__device__ __forceinline__ unsigned img_seg(int r, int c32) { return (unsigned)((r >> 7) * pg8::HTB + ((((r & 127) >> 4) * 2 + c32) * 1024) + (r & 15) * 64); }
__device__ __forceinline__ void cvtk_store(const CvtItem& d, const float (&w)[32], float gl, int lane) {
    const int r = (d.slot0 & 255) + lane; const unsigned seg = img_seg(r, d.c32), x = (r & 8) ? 32u : 0u;
    const bool hg = d.gain != nullptr;
#pragma unroll
    for (int j = 0; j < 4; ++j) { float g[8];
#pragma unroll
        for (int e = 0; e < 8; ++e) { const float t = __builtin_bit_cast(float, __builtin_amdgcn_readlane(__builtin_bit_cast(int, gl), 8 * j + e)); g[e] = hg ? t : 1.f; }
        u32x4 o; o.x = cvt_pk_bf16(w[8 * j] * g[0], w[8 * j + 1] * g[1]); o.y = cvt_pk_bf16(w[8 * j + 2] * g[2], w[8 * j + 3] * g[3]); o.z = cvt_pk_bf16(w[8 * j + 4] * g[4], w[8 * j + 5] * g[5]); o.w = cvt_pk_bf16(w[8 * j + 6] * g[6], w[8 * j + 7] * g[7]);
        *(GAS u32x4*)(d.dst + seg + ((16u * j) ^ x)) = o; }
}

struct BgJob { const Args* args; unsigned char* wsp; int base, n, first, nw; };
template <unsigned KINDS> struct BgOn { static constexpr bool ON = true; static constexpr unsigned K = KINDS; };
struct BgOff { static constexpr bool ON = false; static constexpr unsigned K = 0; };
constexpr int BGN = 1;
template <unsigned KINDS>
__device__ __forceinline__ void bg_drain(const BgJob& job, int& bgk, int lane) {
    asm volatile("" : "+v"(lane));
    for (int j = job.first + bgk * job.nw; j < job.n; j += job.nw) { const CvtItem d = cvt_decode<KINDS>(*job.args, job.wsp, job.base + j); float wv[32];
        const float gl = cvtk_gain_load(d, lane); cvtk_load(d, wv, lane); asm volatile("" ::: "memory"); cvtk_store(d, wv, gl, lane); asm volatile("" ::: "memory"); ++bgk; }
}
namespace pg8 {
template <bool I8> struct AccT { typedef f32x4 type; };
template <> struct AccT<true> { typedef i32x4 type; };
__device__ __forceinline__ void mma16(f32x4& c, bf16x8 b, bf16x8 a) { c = __builtin_amdgcn_mfma_f32_16x16x32_bf16(b, a, c, 0, 0, 0); }
__device__ __forceinline__ void mma16_bf(i32x4& c, bf16x8 b, bf16x8 a) { f32x4 t = __builtin_bit_cast(f32x4, c); t = __builtin_amdgcn_mfma_f32_16x16x32_bf16(b, a, t, 0, 0, 0); c = __builtin_bit_cast(i32x4, t); }
__device__ __forceinline__ void mma16(i32x4& c, bf16x8 b, bf16x8 a) { c = __builtin_amdgcn_mfma_i32_16x16x64_i8(__builtin_bit_cast(i32x4, b), __builtin_bit_cast(i32x4, a), c, 0, 0, 0); }
template <class Epi, class Sched, class Bg = BgOff>
__device__ __forceinline__ void gemm_phase(const int wave_, LAS unsigned char* lds, const int lda, const Sched& S, const Epi& E, const BgJob* job = nullptr, int* bgkp = nullptr) {
    int tid = tid_of(wave_); asm volatile("" : "+v"(tid));
    const int wid = wave_, lane = tid & 63, wr = wid >> 2, wc = wid & 3, fr = lane & 15, fq = lane >> 4;
    unsigned voffA[2], voffB[2];
#pragma unroll
    for (int i = 0; i < 2; ++i) { int R, C; stage_rc(tid * 16 + i * 8192, R, C);
        voffA[i] = (unsigned)(R * lda + C) * 2u; voffB[i] = (unsigned)(tid * 16 + i * 8192); }
    static_assert(Epi::PERM, "the KG-major weight copies are written in PERM slot order");
    const size_t kstep = (size_t)(BK * 2), kstepB = 2 * HTB;
    const size_t hstepA = (size_t)HALF * lda * 2, hstepB = HTB;
    const unsigned ldsw = (unsigned)wid * 1024u;
    const int aoff = lds_byte(wr * 64 + fr, fq * 8), boff = lds_byte(wc * 32 + fr, fq * 8);
#define PG8_SA(b, h) (((b) * 2 + (h)) * HTB)
#define PG8_SB(b, h) ((4 + (b) * 2 + (h)) * HTB)
#define PG8_STAGE(bufoff, gbase, voff) do { _Pragma("unroll") for (int _i = 0; _i < 2; ++_i) \
        __builtin_amdgcn_global_load_lds((const unsigned*)((const char*)(gbase) + (voff)[_i]), (LAS unsigned*)(lds + (bufoff) + ldsw + _i * 8192), 16, 0, 0); } while (0)
#define PG8_LDA(dst, b, h) do { _Pragma("unroll") for (int m = 0; m < 4; ++m) _Pragma("unroll") for (int k = 0; k < 2; ++k) dst[m][k] = *(const LAS bf16x8*)(lds + PG8_SA(b, h) + aoff + m * 2048 + k * 1024); } while (0)
#define PG8_LDB(dst, b, h) do { _Pragma("unroll") for (int n = 0; n < 2; ++n) _Pragma("unroll") for (int k = 0; k < 2; ++k) dst[n][k] = *(const LAS bf16x8*)(lds + PG8_SB(b, h) + boff + n * 2048 + k * 1024); } while (0)
#define PG8_MMA(FN, ai, bj, At, Bt) do { __builtin_amdgcn_s_setprio(1); _Pragma("unroll") for (int m = 0; m < 4; ++m) _Pragma("unroll") for (int n = 0; n < 2; ++n) _Pragma("unroll") for (int k = 0; k < 2; ++k) \
        FN(acc[ai][bj][m][n], Bt[n][k], At[m][k]); __builtin_amdgcn_s_setprio(0); } while (0)
#define PG8_WAIT_V(n) asm volatile("s_waitcnt vmcnt(" #n ")" ::: "memory")
#define PG8_WAIT_L(n) asm volatile("s_waitcnt lgkmcnt(" #n ")" ::: "memory")
#define PG8_BAR __builtin_amdgcn_s_barrier()
#define PG8_SCHED __builtin_amdgcn_sched_barrier(0)
#define PG8_ZERO() do { _Pragma("unroll") for (int a = 0; a < 2; ++a) _Pragma("unroll") for (int b = 0; b < 2; ++b) _Pragma("unroll") for (int m = 0; m < 4; ++m) _Pragma("unroll") for (int n = 0; n < 2; ++n) acc[a][b][m][n] = (acc_t){0, 0, 0, 0}; } while (0)
#define PG8_KLOOP(FN) \
        for (int t = 0; t < nt; t += 2) { \
            const bool last = (t == nt - 2); \
            const char* a1 = cA + (size_t)(t + 1) * kstep; \
            const char* a2 = last ? nA : cA + (size_t)(t + 2) * kstep; const char* b2 = last ? nB : cB + (size_t)(t + 2) * kstepB; \
            const char* a3 = a2 + kstep; const char* b3 = b2 + kstepB; \
 \
            PG8_LDB(B0, 0, 0); PG8_LDB(B1, 0, 1); PG8_SCHED; PG8_LDA(At, 0, 0); PG8_STAGE(PG8_SA(1, 1), a1 + hstepA, voffA); \
            PG8_WAIT_V(8); PG8_WAIT_L(0); PG8_BAR; PG8_MMA(FN, 0, 0, At, B0); PG8_MMA(FN, 0, 1, At, B1); PG8_BAR; PG8_SCHED; \
 \
            PG8_LDA(At, 0, 1); PG8_STAGE(PG8_SB(0, 0), b2, voffB); PG8_STAGE(PG8_SB(0, 1), b2 + hstepB, voffB); PG8_STAGE(PG8_SA(0, 0), a2, voffA); \
            PG8_WAIT_V(8); PG8_WAIT_L(0); PG8_BAR; PG8_MMA(FN, 1, 0, At, B0); PG8_MMA(FN, 1, 1, At, B1); PG8_BAR; PG8_SCHED; \
 \
            PG8_LDB(B0, 1, 0); PG8_LDB(B1, 1, 1); PG8_SCHED; PG8_LDA(At, 1, 0); PG8_STAGE(PG8_SA(0, 1), a2 + hstepA, voffA); \
            PG8_WAIT_V(8); PG8_WAIT_L(0); PG8_BAR; PG8_MMA(FN, 0, 0, At, B0); PG8_MMA(FN, 0, 1, At, B1); PG8_BAR; PG8_SCHED; \
 \
            PG8_LDA(At, 1, 1); PG8_STAGE(PG8_SB(1, 0), b3, voffB); PG8_STAGE(PG8_SB(1, 1), b3 + hstepB, voffB); PG8_STAGE(PG8_SA(1, 0), a3, voffA); \
            PG8_WAIT_V(8); PG8_WAIT_L(0); PG8_BAR; PG8_MMA(FN, 1, 0, At, B0); PG8_MMA(FN, 1, 1, At, B1); PG8_BAR; PG8_SCHED; \
        }
    UnitD cur, nxt; int ui = 0;
    if (!S.next(0, cur)) return;
    typedef typename AccT<Epi::I8 || Epi::MIXED>::type acc_t;
    acc_t acc[2][2][4][2];
    bool k8 = Epi::MIXED && cur.kind != 0;
    PG8_ZERO();
    bf16x8 At[4][2], B0[2][2], B1[2][2];
    const char* cA = cur.A; const char* cB = cur.B;
    cur.slot = 0; if constexpr (Epi::PRE) E.prefetch(cur, wid, lane);
    PG8_STAGE(PG8_SB(0, 0), cB, voffB); PG8_STAGE(PG8_SB(0, 1), cB + hstepB, voffB); PG8_STAGE(PG8_SA(0, 0), cA, voffA); PG8_STAGE(PG8_SA(0, 1), cA + hstepA, voffA);
    if (wr == 1) PG8_BAR;
    PG8_WAIT_V(2); PG8_BAR;
    PG8_STAGE(PG8_SB(1, 0), cB + kstepB, voffB); PG8_STAGE(PG8_SA(1, 0), cA + kstep, voffA); PG8_STAGE(PG8_SB(1, 1), cB + hstepB + kstepB, voffB);
    PG8_WAIT_V(6); PG8_BAR;
    for (;;) {
        const bool has_next = S.next(ui + 1, nxt);
        const char* nA = has_next ? nxt.A : cA; const char* nB = has_next ? nxt.B : cB;
        const int nt = cur.nt;
        if constexpr (Epi::MIXED) { if (k8) { PG8_KLOOP(mma16) } else { PG8_KLOOP(mma16_bf) } } else { PG8_KLOOP(mma16) }
        if (wr == 0) PG8_BAR;
        float bw[BGN][32], bgl[BGN]; int bj[BGN];
        int lx = lane; asm volatile("" : "+v"(lx)); const int frx = lx & 15, fqx = lx >> 4;
        E.pre(acc, cur, wr, wc, frx, fqx);
        if constexpr (Bg::ON) { int ln = lane; asm volatile("" : "+v"(ln));
#pragma unroll
            for (int q = 0; q < BGN; ++q) { bj[q] = job->first + (*bgkp + q) * job->nw;
                if (bj[q] < job->n) { const CvtItem d = cvt_decode<Bg::K>(*job->args, job->wsp, job->base + bj[q]); bgl[q] = cvtk_gain_load(d, ln); cvtk_load(d, bw[q], ln); } }
            *bgkp += BGN; asm volatile("" ::: "memory");
        }
        const bool keep = E(acc, cur, wr, wc, frx, fqx);
        if constexpr (Bg::ON) { asm volatile("" ::: "memory"); int ln = lane; asm volatile("" : "+v"(ln));
#pragma unroll
            for (int q = 0; q < BGN; ++q) if (bj[q] < job->n) { const CvtItem d = cvt_decode<Bg::K>(*job->args, job->wsp, job->base + bj[q]); cvtk_store(d, bw[q], bgl[q], ln); }
            asm volatile("" ::: "memory"); }
        if (!has_next) break;
        if (!keep) PG8_ZERO();
        cur = nxt; cA = nA; cB = nB; ++ui; k8 = Epi::MIXED && cur.kind != 0;
        cur.slot = ui & 1; if constexpr (Epi::PRE) E.prefetch(cur, wid, lane);
        if (wr == 1) PG8_BAR;
    }
    PG8_WAIT_V(0);
    PG8_BAR;
#undef PG8_SA
#undef PG8_SB
#undef PG8_STAGE
#undef PG8_LDA
#undef PG8_LDB
#undef PG8_MMA
#undef PG8_KLOOP
#undef PG8_WAIT_V
#undef PG8_WAIT_L
#undef PG8_BAR
#undef PG8_SCHED
#undef PG8_ZERO
}

struct EpiIn {
    static constexpr bool PERM = true, I8 = false, MIXED = false, PRE = false;
    __device__ __forceinline__ void pre(f32x4 (&)[2][2][4][2], const UnitD&, int, int, int, int) const {}
    bf16_t* P; const float* cosT; const float* sinT; const LAS float* rtab; int tab_pm;
    __device__ __forceinline__ bool operator()(f32x4 (&acc)[2][2][4][2], const UnitD& u, int wr, int wc, int fr, int fq) const {
        const int row0 = u.pm * 256 + wr * 64 + fr, col0 = u.pn * 256 + wc * 32 + 8 * fq;
        const int mode = (u.pn < 10) ? ((wc == 0) ? 1 : 0) : ((u.pn >= 20) ? 2 : 0);
#pragma unroll
        for (int ai = 0; ai < 2; ++ai)
#pragma unroll
            for (int m = 0; m < 4; ++m) {
                const int row = row0 + ai * 128 + m * 16;
                f32x4 v[2][2];
                const float rs = (u.pm == tab_pm) ? rtab[wr * 64 + fr + ai * 128 + m * 16] : __builtin_nanf("");
#pragma unroll
                for (int bj = 0; bj < 2; ++bj) { v[bj][0] = acc[ai][bj][m][0] * rs; v[bj][1] = acc[ai][bj][m][1] * rs; }
                if (mode == 1) {
                    const int pos = row & (SEQ - 1);
                    const f32x4 c = *(const f32x4*)(cosT + pos * 16 + 4 * fq), s = *(const f32x4*)(sinT + pos * 16 + 4 * fq);
#pragma unroll
                    for (int bj = 0; bj < 2; ++bj) { const f32x4 a = v[bj][0], b = v[bj][1]; v[bj][0] = a * c - b * s; v[bj][1] = b * c + a * s; }
                } else if (mode == 2) {
#pragma unroll
                    for (int bj = 0; bj < 2; ++bj)
#pragma unroll
                        for (int n = 0; n < 2; ++n)
#pragma unroll
                            for (int j = 0; j < 4; ++j) v[bj][n][j] = fast_sigmoid(v[bj][n][j]);
                }
                bf16_t* rowp = P + (size_t)row * NIN + col0;
#pragma unroll
                for (int bj = 0; bj < 2; ++bj) { u32x4 w; w.x = cvt_pk_bf16(v[bj][0][0], v[bj][0][1]); w.y = cvt_pk_bf16(v[bj][0][2], v[bj][0][3]); w.z = cvt_pk_bf16(v[bj][1][0], v[bj][1][1]); w.w = cvt_pk_bf16(v[bj][1][2], v[bj][1][3]);
                    *(u32x4*)(rowp + bj * 128) = w; }
            }
        return false;
    }
};
struct EpiInMix {
    static constexpr bool PERM = true, I8 = false, MIXED = true, PRE = true;
    bf16_t* P; const float* cosT; const float* sinT; const LAS float* rtab; int tab_pm; const float* sw; LAS float* scb;
    __device__ __forceinline__ void prefetch(const UnitD& u, int wid, int lane) const { asm volatile("" : "+v"(lane)); if (u.kind != 0 && wid < 4) __builtin_amdgcn_global_load_lds((const unsigned*)(sw + u.pn * 256 + wid * 64 + lane), (LAS unsigned*)(scb + u.slot * 256 + wid * 64), 4, 0, 0); }
    __device__ __forceinline__ void pre(i32x4 (&acc)[2][2][4][2], const UnitD& u, int wr, int wc, int fr, int fq) const {
        const int row0 = u.pm * 256 + wr * 64 + fr;
        const int mode = (u.pn < 10) ? ((wc == 0) ? 1 : 0) : ((u.pn >= 20) ? 2 : 0);
        if (mode == 1) {
            f32x4 c[8], sn[8];
#pragma unroll
            for (int q = 0; q < 8; ++q) { const int pos = (row0 + (q >> 2) * 128 + (q & 3) * 16) & (SEQ - 1); const unsigned to = (unsigned)(pos * 16 + 4 * fq) * 4u; c[q] = *(const f32x4*)((const char*)cosT + to); sn[q] = *(const f32x4*)((const char*)sinT + to); }
#pragma unroll
            for (int q = 0; q < 8; ++q)
#pragma unroll
                for (int bj = 0; bj < 2; ++bj) { const f32x4 a = __builtin_bit_cast(f32x4, acc[q >> 2][bj][q & 3][0]), b = __builtin_bit_cast(f32x4, acc[q >> 2][bj][q & 3][1]);
                    acc[q >> 2][bj][q & 3][0] = __builtin_bit_cast(i32x4, a * c[q] - b * sn[q]); acc[q >> 2][bj][q & 3][1] = __builtin_bit_cast(i32x4, b * c[q] + a * sn[q]); }
        }
    }
    __device__ __forceinline__ bool operator()(i32x4 (&acc)[2][2][4][2], const UnitD& u, int wr, int wc, int fr, int fq) const {
        const int row0 = u.pm * 256 + wr * 64 + fr, col0 = u.pn * 256 + wc * 32 + 8 * fq;
        const bool k8 = u.kind != 0;
        const int mode = (u.pn < 10) ? ((wc == 0) ? 1 : 0) : ((u.pn >= 20) ? 2 : 0);
        f32x4 sc[2][2];
#pragma unroll
        for (int bj = 0; bj < 2; ++bj)
#pragma unroll
            for (int n = 0; n < 2; ++n) sc[bj][n] = k8 ? *(const LAS f32x4*)(scb + u.slot * 256 + wc * 32 + 8 * fq + bj * 128 + 4 * n) : (f32x4){1.f, 1.f, 1.f, 1.f};
#pragma unroll
        for (int ai = 0; ai < 2; ++ai)
#pragma unroll
            for (int m = 0; m < 4; ++m) {
                const int row = row0 + ai * 128 + m * 16;
                f32x4 v[2][2];
                const float rs = (u.pm == tab_pm) ? rtab[(k8 ? 256 : 0) + wr * 64 + fr + ai * 128 + m * 16] : __builtin_nanf("");
#pragma unroll
                for (int bj = 0; bj < 2; ++bj)
#pragma unroll
                    for (int n = 0; n < 2; ++n) { const i32x4 a = acc[ai][bj][m][n];
                        const f32x4 f = k8 ? (f32x4){(float)a[0], (float)a[1], (float)a[2], (float)a[3]} : __builtin_bit_cast(f32x4, a);
                        v[bj][n] = f * (sc[bj][n] * rs); }
                if (mode == 2) {
#pragma unroll
                    for (int bj = 0; bj < 2; ++bj)
#pragma unroll
                        for (int n = 0; n < 2; ++n)
#pragma unroll
                            for (int j = 0; j < 4; ++j) v[bj][n][j] = fast_sigmoid(v[bj][n][j]);
                }
                bf16_t* rowp = P + (size_t)row * NIN + col0;
#pragma unroll
                for (int bj = 0; bj < 2; ++bj) { u32x4 w; w.x = cvt_pk_bf16(v[bj][0][0], v[bj][0][1]); w.y = cvt_pk_bf16(v[bj][0][2], v[bj][0][3]); w.z = cvt_pk_bf16(v[bj][1][0], v[bj][1][1]); w.w = cvt_pk_bf16(v[bj][1][2], v[bj][1][3]);
                    *(u32x4*)(rowp + bj * 128) = w; }
            }
        return false;
    }
};
struct SchedInMix {
    static constexpr int NBA = (PN8 == 20) ? 3 : 2, NBB = (PN8 == 20) ? 2 : 1, NIA = (PN8 == 20) ? 3 : 4, NIB = (PN8 == 20) ? 5 : 6;
    static_assert(4 * NBA + 4 * NBB == PN8 && 4 * NIA + 4 * NIB == NIN / 256 - PN8 && 2 * NBA + NIA == 2 * NBB + NIB, "balanced deal");
    int pm, j; const char* Ab; const char* Aq; const char* Bb; const char* Bq;
    __device__ __forceinline__ void init(int bx) { const int x = bx & 7, w = bx >> 3; pm = 8 * (x >> 1) + (w & 7); j = 4 * (x & 1) + (w >> 3); }
    __device__ __forceinline__ bool next(int i, UnitD& u) const {
        const int nb = j < 4 ? NBA : NBB, ni = j < 4 ? NIA : NIB;
        if (i >= nb + ni) return false;
        const bool k8 = i >= nb;
        const int pn = k8 ? PN8 + (j < 4 ? j * NIA : 4 * NIA + (j - 4) * NIB) + (i - nb) : (j < 4 ? j * NBA : 4 * NBA + (j - 4) * NBB) + i;
        u.pm = pm; u.pn = pn; u.kind = k8 ? 1 : 0; u.nt = k8 ? DM / 128 : DM / 64;
        u.A = (k8 ? Aq : Ab) + (size_t)pm * 256 * DM * 2; u.B = (k8 ? Bq : Bb) + (size_t)pn * (k8 ? 256 * DM : 256 * DM * 2);
        return true;
    }
};
struct EpiPool {
    static constexpr bool PERM = true, I8 = false, MIXED = false, PRE = false;
    __device__ __forceinline__ void pre(f32x4 (&)[2][2][4][2], const UnitD&, int, int, int, int) const {}
    bf16_t* O; const float* scale;
    __device__ __forceinline__ bool operator()(f32x4 (&acc)[2][2][4][2], const UnitD& u, int wr, int wc, int fr, int fq) const {
        const int row0 = u.pm * 256 + wr * 64 + fr, col0 = u.pn * 256 + wc * 32 + 8 * fq;
        f32x4 sc[2][2];
#pragma unroll
        for (int bj = 0; bj < 2; ++bj)
#pragma unroll
            for (int n = 0; n < 2; ++n) sc[bj][n] = *(const f32x4*)(scale + col0 + bj * 128 + 4 * n);
#pragma unroll
        for (int ai = 0; ai < 2; ++ai)
#pragma unroll
            for (int m = 0; m < 4; ++m) { bf16_t* rowp = O + (size_t)(row0 + ai * 128 + m * 16) * PW + col0;
#pragma unroll
                for (int bj = 0; bj < 2; ++bj) { const f32x4 v0 = acc[ai][bj][m][0] * sc[bj][0], v1 = acc[ai][bj][m][1] * sc[bj][1];
                    u32x4 w; w.x = cvt_pk_bf16(v0[0], v0[1]); w.y = cvt_pk_bf16(v0[2], v0[3]); w.z = cvt_pk_bf16(v1[0], v1[1]); w.w = cvt_pk_bf16(v1[2], v1[3]);
                    *(u32x4*)(rowp + bj * 128) = w; } }
        return false;
    }
};
struct EpiBranch {
    static constexpr bool PERM = true, I8 = false, MIXED = false, PRE = false;
    __device__ __forceinline__ void pre(f32x4 (&)[2][2][4][2], const UnitD&, int, int, int, int) const {}
    const bf16_t* P; bf16_t* O;
    __device__ __forceinline__ bool operator()(f32x4 (&acc)[2][2][4][2], const UnitD& u, int wr, int wc, int fr, int fq) const {
        const int row0 = u.pm * 256 + wr * 64 + fr, col0 = u.pn * 256 + wc * 32 + 8 * fq;
        if (u.kind == 0) {
#pragma unroll
            for (int ai = 0; ai < 2; ++ai)
#pragma unroll
                for (int mh = 0; mh < 2; ++mh) {
                    u32x4 ga[2][2], gb[2][2];
#pragma unroll
                    for (int mm = 0; mm < 2; ++mm)
#pragma unroll
                        for (int bj = 0; bj < 2; ++bj) { const bf16_t* rowp = P + (size_t)(row0 + ai * 128 + (2 * mh + mm) * 16) * NIN + col0 + bj * 128; ga[mm][bj] = *(const u32x4*)(rowp + C_GA); gb[mm][bj] = *(const u32x4*)(rowp + C_GB); }
#pragma unroll
                    for (int mm = 0; mm < 2; ++mm)
#pragma unroll
                        for (int bj = 0; bj < 2; ++bj) { const u32x4 a = ga[mm][bj], b = gb[mm][bj]; const int m = 2 * mh + mm;
                            f32x4 r0, r1;
                            r0[0] = bf_lo(a.x) * __builtin_amdgcn_rcpf(fmaxf(bf_lo(b.x), 1e-20f)); r0[1] = bf_hi(a.x) * __builtin_amdgcn_rcpf(fmaxf(bf_hi(b.x), 1e-20f));
                            r0[2] = bf_lo(a.y) * __builtin_amdgcn_rcpf(fmaxf(bf_lo(b.y), 1e-20f)); r0[3] = bf_hi(a.y) * __builtin_amdgcn_rcpf(fmaxf(bf_hi(b.y), 1e-20f));
                            r1[0] = bf_lo(a.z) * __builtin_amdgcn_rcpf(fmaxf(bf_lo(b.z), 1e-20f)); r1[1] = bf_hi(a.z) * __builtin_amdgcn_rcpf(fmaxf(bf_hi(b.z), 1e-20f));
                            r1[2] = bf_lo(a.w) * __builtin_amdgcn_rcpf(fmaxf(bf_lo(b.w), 1e-20f)); r1[3] = bf_hi(a.w) * __builtin_amdgcn_rcpf(fmaxf(bf_hi(b.w), 1e-20f));
                            acc[ai][bj][m][0] = acc[ai][bj][m][0] * r0; acc[ai][bj][m][1] = acc[ai][bj][m][1] * r1; }
                    asm volatile("" ::: "memory");
                }
            return true;
        }
#pragma unroll
        for (int ai = 0; ai < 2; ++ai) {
            u32x4 gb[4][2];
#pragma unroll
            for (int m = 0; m < 4; ++m)
#pragma unroll
                for (int bj = 0; bj < 2; ++bj) gb[m][bj] = *(const u32x4*)(P + (size_t)(row0 + ai * 128 + m * 16) * NIN + col0 + bj * 128 + C_GB);
#pragma unroll
            for (int m = 0; m < 4; ++m) { bf16_t* outp = O + (size_t)(row0 + ai * 128 + m * 16) * DM + col0;
#pragma unroll
                for (int bj = 0; bj < 2; ++bj) { const u32x4 b = gb[m][bj];
                    f32x4 s0, s1;
                    s0[0] = fmaxf(bf_lo(b.x), 1e-20f); s0[1] = fmaxf(bf_hi(b.x), 1e-20f); s0[2] = fmaxf(bf_lo(b.y), 1e-20f); s0[3] = fmaxf(bf_hi(b.y), 1e-20f);
                    s1[0] = fmaxf(bf_lo(b.z), 1e-20f); s1[1] = fmaxf(bf_hi(b.z), 1e-20f); s1[2] = fmaxf(bf_lo(b.w), 1e-20f); s1[3] = fmaxf(bf_hi(b.w), 1e-20f);
                    const f32x4 v0 = acc[ai][bj][m][0] * s0, v1 = acc[ai][bj][m][1] * s1;
                    u32x4 w; w.x = cvt_pk_bf16(v0[0], v0[1]); w.y = cvt_pk_bf16(v0[2], v0[3]); w.z = cvt_pk_bf16(v1[0], v1[1]); w.w = cvt_pk_bf16(v1[2], v1[3]);
                    *(u32x4*)(outp + bj * 128) = w; } }
            asm volatile("" ::: "memory");
        }
        return false;
    }
};
struct EpiRes {
    static constexpr bool PERM = true, I8 = false, MIXED = false, PRE = false;
    __device__ __forceinline__ void pre(f32x4 (&)[2][2][4][2], const UnitD&, int, int, int, int) const {}
    const float* xin32; const bf16_t* xb; bf16_t* xbo; float* xout32; float* part;
    __device__ __forceinline__ void finish(f32x4 (&acc)[2][2][4][2], int ai, int m, const f32x4 (&xi)[2][2], int row, size_t off, int fq, int slot) const {
        float ss = 0.f;
#pragma unroll
        for (int bj = 0; bj < 2; ++bj) { const f32x4 x0 = xi[bj][0] + acc[ai][bj][m][0], x1 = xi[bj][1] + acc[ai][bj][m][1];
            ss += (x0[0] * x0[0] + x0[1] * x0[1]) + (x0[2] * x0[2] + x0[3] * x0[3]) + (x1[0] * x1[0] + x1[1] * x1[1]) + (x1[2] * x1[2] + x1[3] * x1[3]);
            if (xout32) { *(f32x4*)(xout32 + off + bj * 128) = x0; *(f32x4*)(xout32 + off + bj * 128 + 4) = x1; }
            else { u32x4 w; w.x = cvt_pk_bf16(x0[0], x0[1]); w.y = cvt_pk_bf16(x0[2], x0[3]); w.z = cvt_pk_bf16(x1[0], x1[1]); w.w = cvt_pk_bf16(x1[2], x1[3]); *(u32x4*)(xbo + off + bj * 128) = w; } }
        ss += xchg<16>(ss); ss = sum32(ss);
        if (fq == 0) part[(size_t)row * 64 + slot] = ss;
    }
    __device__ __forceinline__ bool operator()(f32x4 (&acc)[2][2][4][2], const UnitD& u, int wr, int wc, int fr, int fq) const {
        const int row0 = u.pm * 256 + wr * 64 + fr, col0 = u.pn * 256 + wc * 32 + 8 * fq;
        if (xin32) {
#pragma unroll
            for (int ai = 0; ai < 2; ++ai)
#pragma unroll
                for (int mh = 0; mh < 2; ++mh) {
                    f32x4 xr[2][2][2];
#pragma unroll
                    for (int mm = 0; mm < 2; ++mm)
#pragma unroll
                        for (int bj = 0; bj < 2; ++bj) { const float* p = xin32 + (size_t)(row0 + ai * 128 + (2 * mh + mm) * 16) * DM + col0 + bj * 128; xr[mm][bj][0] = *(const f32x4*)p; xr[mm][bj][1] = *(const f32x4*)(p + 4); }
#pragma unroll
                    for (int mm = 0; mm < 2; ++mm) { const int m = 2 * mh + mm, row = row0 + ai * 128 + m * 16; finish(acc, ai, m, xr[mm], row, (size_t)row * DM + col0, fq, 4 * u.pn + wc); }
                    asm volatile("" ::: "memory");
                }
        } else {
#pragma unroll
            for (int ai = 0; ai < 2; ++ai) {
                u32x4 xw[4][2];
#pragma unroll
                for (int m = 0; m < 4; ++m)
#pragma unroll
                    for (int bj = 0; bj < 2; ++bj) xw[m][bj] = *(const u32x4*)(xb + (size_t)(row0 + ai * 128 + m * 16) * DM + col0 + bj * 128);
#pragma unroll
                for (int m = 0; m < 4; ++m) { const int row = row0 + ai * 128 + m * 16; f32x4 xi[2][2];
#pragma unroll
                    for (int bj = 0; bj < 2; ++bj) { const u32x4 w = xw[m][bj]; xi[bj][0] = (f32x4){bf_lo(w.x), bf_hi(w.x), bf_lo(w.y), bf_hi(w.y)}; xi[bj][1] = (f32x4){bf_lo(w.z), bf_hi(w.z), bf_lo(w.w), bf_hi(w.w)}; }
                    finish(acc, ai, m, xi, row, (size_t)row * DM + col0, fq, 4 * u.pn + wc); }
                asm volatile("" ::: "memory");
            }
        }
        return false;
    }
};
struct EpiGU {
    static constexpr bool PERM = true, I8 = false, MIXED = false, PRE = false;
    __device__ __forceinline__ void pre(f32x4 (&)[2][2][4][2], const UnitD&, int, int, int, int) const {}
    bf16_t* O; const LAS float* rtab; int tab_pm;
    __device__ __forceinline__ bool operator()(f32x4 (&acc)[2][2][4][2], const UnitD& u, int wr, int wc, int fr, int fq) const {
        const int row0 = u.pm * 256 + wr * 64 + fr, col0 = u.pn * 128 + wc * 32 + 8 * fq;
#pragma unroll
        for (int ai = 0; ai < 2; ++ai)
#pragma unroll
            for (int m = 0; m < 4; ++m) { f32x4 v[2]; const float rs = (u.pm == tab_pm) ? rtab[wr * 64 + fr + ai * 128 + m * 16] : __builtin_nanf("");
#pragma unroll
                for (int n = 0; n < 2; ++n)
#pragma unroll
                    for (int j = 0; j < 4; ++j) { const float g = acc[ai][0][m][n][j] * rs; v[n][j] = g * fast_sigmoid(g) * (acc[ai][1][m][n][j] * rs); }
                u32x4 w; w.x = cvt_pk_bf16(v[0][0], v[0][1]); w.y = cvt_pk_bf16(v[0][2], v[0][3]); w.z = cvt_pk_bf16(v[1][0], v[1][1]); w.w = cvt_pk_bf16(v[1][2], v[1][3]);
                *(u32x4*)(O + (size_t)(row0 + ai * 128 + m * 16) * FF + col0) = w; }
        return false;
    }
};
struct EpiGU8 {
    static constexpr bool PERM = true, I8 = true, MIXED = false, PRE = true;
    __device__ __forceinline__ void pre(i32x4 (&)[2][2][4][2], const UnitD&, int, int, int, int) const {}
    bf16_t* O; const LAS float* rtab; int tab_pm; const float* sw; LAS float* scb;
    __device__ __forceinline__ void prefetch(const UnitD& u, int wid, int lane) const { asm volatile("" : "+v"(lane)); if (wid < 4) __builtin_amdgcn_global_load_lds((const unsigned*)(sw + u.pn * 256 + wid * 64 + lane), (LAS unsigned*)(scb + u.slot * 256 + wid * 64), 4, 0, 0); }
    __device__ __forceinline__ bool operator()(i32x4 (&acc)[2][2][4][2], const UnitD& u, int wr, int wc, int fr, int fq) const {
        const int row0 = tab_pm * 256 + wr * 64 + fr, col0 = u.pn * 128 + wc * 32 + 8 * fq;
        const LAS float* swc = scb + u.slot * 256 + wc * 32 + 8 * fq;
        f32x4 sg[2], su[2];
        sg[0] = *(const LAS f32x4*)swc; sg[1] = *(const LAS f32x4*)(swc + 4); su[0] = *(const LAS f32x4*)(swc + 128); su[1] = *(const LAS f32x4*)(swc + 132);
#pragma unroll
        for (int ai = 0; ai < 2; ++ai)
#pragma unroll
            for (int m = 0; m < 4; ++m) { f32x4 v[2]; const float rs = rtab[wr * 64 + fr + ai * 128 + m * 16];
#pragma unroll
                for (int n = 0; n < 2; ++n)
#pragma unroll
                    for (int j = 0; j < 4; ++j) { const float g = (float)acc[ai][0][m][n][j] * (rs * sg[n][j]); v[n][j] = g * fast_sigmoid(g) * ((float)acc[ai][1][m][n][j] * (rs * su[n][j])); }
                u32x4 w; w.x = cvt_pk_bf16(v[0][0], v[0][1]); w.y = cvt_pk_bf16(v[0][2], v[0][3]); w.z = cvt_pk_bf16(v[1][0], v[1][1]); w.w = cvt_pk_bf16(v[1][2], v[1][3]);
                *(u32x4*)(O + (size_t)(row0 + ai * 128 + m * 16) * FF + col0) = w; }
        return false;
    }
};
}

namespace attn {
constexpr int D = 128, NW = 8, QBLK = 32, KVBLK = 64, QROWS = 64, WIN = 128;
constexpr int SHM_V = KVBLK * D * 2, SHM_K = KVBLK * D * 2;
constexpr int LDS_BYTES = 2 * SHM_V + 2 * SHM_K + NW * 64 * 4;
constexpr int LDQ = NIN, LDKV = NIN, LDO = AW;
constexpr float SCALE = 0.08838834764831845f;
constexpr float THR = 8.f;
#define KSWZ(row, colB) ((row) * 256 + ((colB) ^ (((row) & 7) << 4)))
#define SBAR() __builtin_amdgcn_sched_barrier(0)
__device__ __forceinline__ int v_st(int k, int c) { const int kk = (k & ~0xC) | ((k & 4) << 1) | ((k & 8) >> 1); return ((kk >> 3) * 4 + (c >> 5)) * 512 + ((kk & 7) * 32 + (c & 31)) * 2; }
__device__ __forceinline__ int v_rd_base(int lane) { return ((lane & 3) << 3) | (((lane >> 2) & 3) << 6) | (((lane >> 4) & 1) << 5) | (((lane >> 5) & 1) << 8); }
constexpr int v_rd_off(int d0, int ks, int half) { return d0 * 512 + ks * 4096 + half * 2048; }
__device__ __forceinline__ int crow(int r, int hi) { return (r & 3) + 8 * (r >> 2) + 4 * hi; }
__device__ __forceinline__ unsigned cvtpk(float lo, float hi) { unsigned r; asm volatile("v_cvt_pk_bf16_f32 %0, %1, %2" : "=v"(r) : "v"(lo), "v"(hi)); return r; }
__device__ __forceinline__ bf16x8 load8(const bf16_t* p) { return *reinterpret_cast<const bf16x8*>(p); }
__device__ __forceinline__ void mask_tile(f32x16& p0, f32x16& p1, int dq) {
    const float NEG = -__builtin_inff();
#pragma unroll
    for (int r = 0; r < 16; ++r) {
        const int c = (r & 3) + 8 * (r >> 2);
        if ((unsigned)(dq - c) >= (unsigned)(2 * WIN + 1)) p0[r] = NEG;
        if ((unsigned)(dq - c - 32) >= (unsigned)(2 * WIN + 1)) p1[r] = NEG;
    }
}
__device__ __forceinline__ void partialSM(f32x16& p0, f32x16& p1, float& m_reg, float& mn, float& alpha) {
    float pmax = p0[0]; for (int r = 1; r < 16; ++r) pmax = fmaxf(pmax, p0[r]); for (int r = 0; r < 16; ++r) pmax = fmaxf(pmax, p1[r]);
    { auto rr = __builtin_amdgcn_permlane32_swap(__float_as_uint(pmax), __float_as_uint(pmax), false, false);
      pmax = fmaxf(__uint_as_float(rr[0]), __uint_as_float(rr[1])); }
    constexpr float C2 = 1.4426950408889634f * SCALE;
    if (__builtin_expect(__all((pmax - m_reg) * SCALE <= THR), 1)) { mn = m_reg; alpha = 1.f; }
    else { mn = fmaxf(m_reg, pmax); alpha = __builtin_amdgcn_exp2f((m_reg - mn) * C2); m_reg = mn; }
    const float mnL = -mn * C2;
    for (int r = 0; r < 16; ++r) p0[r] = fmaf(p0[r], C2, mnL); for (int r = 0; r < 16; ++r) p1[r] = fmaf(p1[r], C2, mnL);
    for (int r = 0; r < 16; ++r) p0[r] = __builtin_amdgcn_exp2f(p0[r]);
}
__device__ __forceinline__ void finishSM(f32x16& p0, f32x16& p1, float alpha, float& l_reg, bf16x8& pa0, bf16x8& pa1, bf16x8& pa2, bf16x8& pa3) {
    for (int r = 0; r < 16; ++r) p1[r] = __builtin_amdgcn_exp2f(p1[r]);
    float ps = 0; for (int r = 0; r < 16; ++r) ps += p0[r]; for (int r = 0; r < 16; ++r) ps += p1[r];
    { auto rr = __builtin_amdgcn_permlane32_swap(__float_as_uint(ps), __float_as_uint(ps), false, false);
      ps = __uint_as_float(rr[0]) + __uint_as_float(rr[1]); }
    l_reg = l_reg * alpha + ps;
#define PK4(P, B_, OUT) do { unsigned a0 = cvtpk(P[B_+0], P[B_+1]), a1 = cvtpk(P[B_+2], P[B_+3]);                          \
        unsigned b0 = cvtpk(P[B_+4], P[B_+5]), b1 = cvtpk(P[B_+6], P[B_+7]);                                             \
        auto r0 = __builtin_amdgcn_permlane32_swap(a0, b0, false, false); auto r1 = __builtin_amdgcn_permlane32_swap(a1, b1, false, false); \
        u32x4 w = {r0[0], r1[0], r0[1], r1[1]}; OUT = *reinterpret_cast<bf16x8*>(&w); } while (0)
    PK4(p0, 0, pa0); PK4(p0, 8, pa1); PK4(p1, 0, pa2); PK4(p1, 8, pa3);
#undef PK4
}
template <int KB>
__device__ __forceinline__ void qkt(f32x16& p0, f32x16& p1, const char* K_lds, int r32, int hi, const char* q_lds, bool act) {
    if (!act) { const float NEG = -__builtin_inff();
#pragma unroll
        for (int r = 0; r < 16; ++r) { p0[r] = NEG; p1[r] = NEG; } return; }
    p0 = f32x16{}; p1 = f32x16{};
    const char* kb[4];
#pragma unroll
    for (int dd = 0; dd < 4; ++dd) kb[dd] = K_lds + KB * SHM_K + KSWZ(r32, (dd * 16 + hi * 8) * 2);
#pragma unroll
    for (int d0 = 0; d0 < 8; ++d0) { const char* a = kb[d0 & 3] + (d0 >> 2) * 128;
        bf16x8 b0 = *reinterpret_cast<const bf16x8*>(a);
        bf16x8 b1 = *reinterpret_cast<const bf16x8*>(a + 32 * 256);
        bf16x8 q = *reinterpret_cast<const bf16x8*>(q_lds + d0 * 1024);
        p0 = __builtin_amdgcn_mfma_f32_32x32x16_bf16(b0, q, p0, 0, 0, 0);
        p1 = __builtin_amdgcn_mfma_f32_32x32x16_bf16(b1, q, p1, 0, 0, 0); }
}
template <int VB>
__device__ __forceinline__ void pv_tile(f32x16* o, int vb0, bf16x8 pa0, bf16x8 pa1, bf16x8 pa2, bf16x8 pa3, bool act) {
    if (!act) return;
#define TRRD(dst, off) asm volatile("ds_read_b64_tr_b16 %0, %1 offset:%2" : "=&v"(dst) : "v"(vb0), "i"(off) : "memory")
#define PV_D0(d0) do { s16x4 l0, l1, l2, l3, h0, h1, h2, h3; constexpr int b_ = VB * SHM_V + v_rd_off(d0, 0, 0);   \
        TRRD(l0, b_); TRRD(h0, b_ + 2048); TRRD(l1, b_ + 4096); TRRD(h1, b_ + 6144); TRRD(l2, b_ + 8192); TRRD(h2, b_ + 10240); TRRD(l3, b_ + 12288); TRRD(h3, b_ + 14336); \
        asm volatile("s_waitcnt lgkmcnt(0)" ::: "memory"); SBAR();   \
        o[d0] = __builtin_amdgcn_mfma_f32_32x32x16_bf16(pa0, (bf16x8){l0[0], l0[1], l0[2], l0[3], h0[0], h0[1], h0[2], h0[3]}, o[d0], 0, 0, 0);   \
        o[d0] = __builtin_amdgcn_mfma_f32_32x32x16_bf16(pa1, (bf16x8){l1[0], l1[1], l1[2], l1[3], h1[0], h1[1], h1[2], h1[3]}, o[d0], 0, 0, 0);   \
        o[d0] = __builtin_amdgcn_mfma_f32_32x32x16_bf16(pa2, (bf16x8){l2[0], l2[1], l2[2], l2[3], h2[0], h2[1], h2[2], h2[3]}, o[d0], 0, 0, 0);   \
        o[d0] = __builtin_amdgcn_mfma_f32_32x32x16_bf16(pa3, (bf16x8){l3[0], l3[1], l3[2], l3[3], h3[0], h3[1], h3[2], h3[3]}, o[d0], 0, 0, 0); } while (0)
    PV_D0(0); PV_D0(1); PV_D0(2); PV_D0(3);
#undef PV_D0
#undef TRRD
}
struct BlockRef { const bf16_t* Q; const bf16_t* K; const bf16_t* V; bf16_t* O; int P0; const float* sink4; };
struct Seam { bf16x8 st_v0, st_v1, st_k0, st_k1; };
constexpr int LDS_Q = LDS_BYTES;
constexpr int LDS_TOTAL = LDS_Q + NW * 8192;
__device__ __forceinline__ int jlo_of(int P0) { const int lowk = P0 - WIN; return lowk > 0 ? lowk / KVBLK : 0; }
#define ROW(p, k0, rr) ((p) + (size_t)((k0) + (rr)) * LDKV + sc)
#define VMW() asm volatile("s_waitcnt vmcnt(0)" ::: "memory")
#define SLOAD_H(Kp, Vp, k0) do { S.st_v0 = load8(ROW(Vp, k0, sr)); S.st_v1 = load8(ROW(Vp, k0, 32 + sr));              \
                         S.st_k0 = load8(ROW(Kp, k0, sr)); S.st_k1 = load8(ROW(Kp, k0, 32 + sr)); } while (0)
#define SWRITE_HK(bf) do { *(bf16x8*)(K_lds + (bf) * SHM_K + kws) = S.st_k0; *(bf16x8*)(K_lds + (bf) * SHM_K + kws + 32 * 256) = S.st_k1; } while (0)
#define SWRITE_HV(bf) do { *(bf16x8*)(V_lds + (bf) * SHM_V + vst0) = S.st_v0; *(bf16x8*)(V_lds + (bf) * SHM_V + vst1) = S.st_v1; } while (0)
#define SWRITE_H(bf) do { SWRITE_HV(bf); SWRITE_HK(bf); } while (0)
__device__ __forceinline__ void attn_block(const int wave_, const BlockRef& cur, char* lds) {
    int tid = tid_of(wave_); asm volatile("" : "+v"(tid));
    const int wid = wave_, lane = tid & 63, r32 = lane & 31, hi = lane >> 5;
    const int j_lo = jlo_of(cur.P0);
    int j_hi = (cur.P0 + QROWS - 1 + WIN) / KVBLK + 1; if (j_hi > SEQ / KVBLK) j_hi = SEQ / KVBLK;
    const int NT = j_hi - j_lo;
    const int qlo = cur.P0 + (wid & 1) * QBLK, qm = qlo + r32 - 4 * hi + WIN;
    char* V_lds = lds; char* K_lds = lds + 2 * SHM_V;
    float* ws = (float*)(lds + 2 * SHM_V + 2 * SHM_K) + wid * 64; float* li_l = ws, * al_l = ws + 32;
    char* q_lds = lds + LDS_Q + wid * 8192 + lane * 16;
    float m_reg = cur.sink4[wid >> 1] * 11.313708498984761f, l_reg = 1.f; f32x16 o[4] = {};
    const int sr = tid >> 4, sc = (tid & 15) * 8, vst0 = v_st(sr, sc), vst1 = v_st(32 + sr, sc), kws = KSWZ(sr, sc * 2);
    const int vb0 = (int)(uintptr_t)V_lds + v_rd_base(lane);
    const bf16_t* Kh = cur.K; const bf16_t* Vh = cur.V;
    Seam S;
#define KBASE(t) ((j_lo + (t)) * KVBLK)
    {
        SLOAD_H(Kh, Vh, KBASE(0));
        bf16x8 qv[8];
#pragma unroll
        for (int d0 = 0; d0 < 8; ++d0) qv[d0] = load8(cur.Q + (size_t)((wid & 1) * QBLK + r32) * LDQ + (wid >> 1) * D + d0 * 16 + hi * 8);
        VMW();
#pragma unroll
        for (int d0 = 0; d0 < 8; ++d0) *reinterpret_cast<bf16x8*>(q_lds + d0 * 1024) = qv[d0];
        SWRITE_HK(0);
        __syncthreads();
    }
#define RESC(a) do { if (__any((a) < 1.f)) { if (hi == 0) al_l[r32] = (a); asm volatile("s_waitcnt lgkmcnt(0)" ::: "memory");              \
                     for (int d_ = 0; d_ < 4; ++d_) for (int r = 0; r < 16; ++r) o[d_][r] *= al_l[crow(r, hi)]; } } while (0)
#define ACT(t) (KBASE(t) <= qlo + QBLK - 1 + WIN && KBASE(t) + KVBLK - 1 >= qlo - WIN)
#define MASKT(P0_, P1_, t) do { const int kb_ = KBASE(t); if (ACT(t) && (kb_ + KVBLK - 1 > qlo + WIN || kb_ < qlo + QBLK - 1 - WIN)) mask_tile(P0_, P1_, qm - kb_); } while (0)
    f32x16 pA0, pA1, pB0, pB1; float mnA, mnB, alA, alB; bf16x8 pa0, pa1, pa2, pa3;
    SWRITE_HV(0); SBAR();
    if (NT > 1) { SLOAD_H(Kh, Vh, KBASE(1)); }
    SBAR(); qkt<0>(pA0, pA1, K_lds, r32, hi, q_lds, ACT(0));
    MASKT(pA0, pA1, 0); partialSM(pA0, pA1, m_reg, mnA, alA);
    if (NT > 1) { VMW(); SWRITE_H(1); }
    __syncthreads();
#define HALF_STEP(PX0, PX1, mnX, alX, PY0, PY1, alY, t, KB, VB, SB) do {                                                      \
        SBAR(); qkt<KB>(PX0, PX1, K_lds, r32, hi, q_lds, ACT(t));                                                \
        finishSM(PY0, PY1, alY, l_reg, pa0, pa1, pa2, pa3); SBAR();                                                           \
        if ((t) + 1 < NT) { SLOAD_H(Kh, Vh, KBASE((t) + 1)); SBAR(); }                                                         \
        pv_tile<VB>(o, vb0, pa0, pa1, pa2, pa3, ACT((t) - 1)); MASKT(PX0, PX1, (t)); partialSM(PX0, PX1, m_reg, mnX, alX);    \
        __syncthreads();                                                                                                      \
        if ((t) + 1 < NT) { VMW(); SWRITE_H(SB); }                                                                            \
        RESC(alX); __syncthreads(); } while (0)
    for (int t = 1; t + 1 < NT; t += 2) {
        HALF_STEP(pB0, pB1, mnB, alB, pA0, pA1, alA, t, 1, 0, 0);
        HALF_STEP(pA0, pA1, mnA, alA, pB0, pB1, alB, t + 1, 0, 1, 1);
    }
    const bool even = (NT & 1) == 0;
    if (even) { SBAR(); qkt<1>(pB0, pB1, K_lds, r32, hi, q_lds, ACT(NT - 1)); SBAR(); }
    finishSM(pA0, pA1, alA, l_reg, pa0, pa1, pa2, pa3); SBAR();
    pv_tile<0>(o, vb0, pa0, pa1, pa2, pa3, ACT(even ? NT - 2 : NT - 1));
    if (even) { MASKT(pB0, pB1, NT - 1); partialSM(pB0, pB1, m_reg, mnB, alB); __syncthreads(); RESC(alB);
        finishSM(pB0, pB1, alB, l_reg, pa0, pa1, pa2, pa3); SBAR(); pv_tile<1>(o, vb0, pa0, pa1, pa2, pa3, ACT(NT - 1)); }
    SBAR();
    if (hi == 0) li_l[r32] = l_reg; asm volatile("s_waitcnt lgkmcnt(0)" ::: "memory");
    float rli[16];
#pragma unroll
    for (int r = 0; r < 16; ++r) rli[r] = __builtin_amdgcn_rcpf(li_l[crow(r, hi)]);
    bf16_t* Ow = cur.O + (size_t)((wid & 1) * QBLK) * LDO + (wid >> 1) * D;
#pragma unroll
    for (int r = 0; r < 16; ++r) { const int orow = crow(r, hi);
#pragma unroll
        for (int d0 = 0; d0 < 4; ++d0) { const float v = o[d0][r] * rli[r];
            const float vn = xchg<1>(v);
            if ((r32 & 1) == 0) *(unsigned*)(Ow + (size_t)orow * LDO + d0 * 32 + r32) = cvtpk(v, vn); } }
    __syncthreads();
#undef RESC
#undef KBASE
#undef ACT
#undef MASKT
#undef HALF_STEP
}
#undef ROW
#undef VMW
#undef SLOAD_H
#undef SWRITE_HK
#undef SWRITE_HV
#undef SWRITE_H
#undef KSWZ
#undef SBAR
}
static_assert(attn::LDS_TOTAL <= LDSCTL_OFF && pg8::STAGE_BYTES <= LDSCTL_OFF && MISC_OFF + 128 <= LDS_BYTES, "LDS map");

#define XB_TMO      128
#define XB_XCNT(j)  (256  + 64 * (j))
#define XB_XSUB(j)  (1280 + 64 * (j))
#define XB_XGEN(j)  (2304 + 64 * (j))
#define XB_TOP      3328
#define XB_TOPGEN   3392
#define XCD_BAR_WORDS 3456
#define XB_SPIN_CAP (1u << 18)

__device__ __forceinline__ unsigned xb_ld(unsigned* p)              { return __hip_atomic_load(p, __ATOMIC_RELAXED, __HIP_MEMORY_SCOPE_AGENT); }
__device__ __forceinline__ unsigned xb_add(unsigned* p, unsigned v) { return __hip_atomic_fetch_add(p, v, __ATOMIC_RELAXED, __HIP_MEMORY_SCOPE_AGENT); }
__device__ __forceinline__ unsigned xb_xcc_id() { return (unsigned)__builtin_amdgcn_s_getreg((3 << 11) | 20) & 0xFu; }
#define XB_SPIN(cond, bar) do { unsigned _sp = 0; while (cond) { __builtin_amdgcn_s_sleep(1); \
    if ((++_sp & 255u) == 0u) { if (xb_ld(&(bar)[XB_TMO])) break; if (_sp > XB_SPIN_CAP) { atomicAdd(&(bar)[XB_TMO], 1u); break; } } } } while (0)

struct XcdBarrier {
    unsigned* bar; unsigned x;
    volatile LAS unsigned* st;
    unsigned n;
};
__device__ __forceinline__ XcdBarrier xcd_barrier_post(unsigned* bar, volatile LAS unsigned* st, unsigned n) {
    XcdBarrier b; b.bar = bar; b.x = xb_xcc_id(); b.st = st; b.n = n;
    if (threadIdx.x == 0) (void)xb_add(&bar[XB_XCNT(b.x)], 1u);
    return b;
}
__device__ __forceinline__ void xcd_barrier_complete(unsigned* bar, unsigned x, unsigned& nloc, unsigned& nx, const unsigned G) {
    unsigned sum, cnt, mine, sp = 0u;
    for (;;) {
        sum = 0u; cnt = 0u; mine = 0u;
#pragma unroll
        for (unsigned j = 0; j < 16; ++j) { const unsigned c = xb_ld(&bar[XB_XCNT(j)]); sum += c; cnt += (c > 0u) ? 1u : 0u; mine = (j == x) ? c : mine; }
        if (sum == G) break;
        __builtin_amdgcn_s_sleep(1);
        if ((++sp & 255u) == 0u) { if (xb_ld(&bar[XB_TMO])) break; if (sp > XB_SPIN_CAP) { atomicAdd(&bar[XB_TMO], 1u); break; } }
    }
    nloc = mine > 0u ? mine : 1u; nx = cnt > 0u ? cnt : 1u;
}
__device__ __forceinline__ void xcd_barrier(const XcdBarrier& b, const int wave_) {
    asm volatile("s_waitcnt vmcnt(0)" ::: "memory");
    __syncthreads();
    int tid0 = tid_of(wave_); asm volatile("" : "+v"(tid0));
    if (tid0 == 0) {
        unsigned* bar = b.bar; const unsigned bx_ = xb_xcc_id();
        __builtin_amdgcn_s_waitcnt(0);
        unsigned nloc = b.st[0], nx = b.st[1];
        if (nloc == 0u) { xcd_barrier_complete(bar, bx_, nloc, nx, b.n); b.st[0] = nloc; b.st[1] = nx; }
        const unsigned old = xb_add(&bar[XB_XSUB(bx_)], 1u);
        const unsigned gen = old / nloc;
        if (old + 1u == (gen + 1u) * nloc) {
            __builtin_amdgcn_fence(__ATOMIC_RELEASE, "agent");
            asm volatile("s_waitcnt vmcnt(0)" ::: "memory");
            const unsigned og = xb_add(&bar[XB_TOP], 1u);
            const unsigned tg = og / nx;
            if (og + 1u == (tg + 1u) * nx) xb_add(&bar[XB_TOPGEN], 1u);
            else XB_SPIN(xb_ld(&bar[XB_TOPGEN]) == tg, bar);
            __builtin_amdgcn_fence(__ATOMIC_ACQUIRE, "agent");
            xb_add(&bar[XB_XGEN(bx_)], 1u);
            asm volatile("s_waitcnt vmcnt(0)" ::: "memory");
        } else {
            XB_SPIN(xb_ld(&bar[XB_XGEN(bx_)]) == gen, bar);
            __builtin_amdgcn_fence(__ATOMIC_ACQUIRE, "agent");
            asm volatile("s_waitcnt vmcnt(0)" ::: "memory");
        }
    }
    __syncthreads();
}


__device__ __forceinline__ float wave_sum(float v) {
    v += xchg<1>(v); v += xchg<2>(v); v += xchg<4>(v); v += xchg<8>(v); v += xchg<16>(v);
    return sum32(v);
}
__device__ __forceinline__ void cvt8_block(const float* W, int N, int n0, const float* gain, unsigned char* WT8, int map, float* scales, LAS float* cmx, int wave, int lane) {
    asm volatile("" : "+v"(lane));
    const int c = lane & 31, half = lane >> 5, slot = n0 + c;
    const float* wb = W + (size_t)(wave * 512) * N; const float* gb = gain + wave * 512;
    const unsigned loff = (unsigned)(32 * half * N + srccol(map, slot)) * 4u; const bool hi = half != 0;
    float gv[8];
#pragma unroll
    for (int it = 0; it < 8; ++it) gv[it] = gb[64 * it + lane];
    unsigned pk[8][16]; float mx = 0.f;
#pragma unroll
    for (int it = 0; it < 8; ++it)
#pragma unroll
        for (int h = 0; h < 2; ++h) { float w[16];
#pragma unroll
            for (int i = 0; i < 16; ++i) w[i] = *(const float*)((const char*)(wb + (size_t)(64 * it + 16 * h + i) * N) + loff);
#pragma unroll
            for (int i = 0; i < 16; ++i) { const int gi = __builtin_bit_cast(int, gv[it]); const float g0 = __builtin_bit_cast(float, __builtin_amdgcn_readlane(gi, 16 * h + i)), g1 = __builtin_bit_cast(float, __builtin_amdgcn_readlane(gi, 32 + 16 * h + i)); w[i] *= hi ? g1 : g0; }
#pragma unroll
            for (int i = 0; i < 8; ++i) { const unsigned p = cvt_pk_bf16(w[2 * i], w[2 * i + 1]); pk[it][8 * h + i] = p; mx = fmaxf(mx, fmaxf(fabsf(bf_lo(p)), fabsf(bf_hi(p)))); }
            asm volatile("" ::: "memory"); }
    mx = max32(mx);
    if (lane < 32) cmx[wave * 32 + lane] = mx;
    LDS_WAIT(); __syncthreads();
    float a = 0.f;
#pragma unroll
    for (int q = 0; q < 8; ++q) a = fmaxf(a, cmx[q * 32 + c]);
    const float inv = a > 0.f ? 127.0f / a : 0.f;
    if (wave == 0 && lane < 32) scales[destrow(slot)] = a * (1.0f / 127.0f);
    unsigned char* dp = WT8 + (size_t)(slot >> 8) * ((size_t)DM * 256) + (size_t)(4 * wave) * 32768 + img_seg(slot & 255, 0);
    const unsigned xs = (slot & 8) ? 32u : 0u;
#pragma unroll
    for (int it = 0; it < 8; ++it)
#pragma unroll
        for (int q = 0; q < 2; ++q) { unsigned o[4];
#pragma unroll
            for (int e = 0; e < 4; ++e) { unsigned p0 = pk[it][8 * q + 2 * e], p1 = pk[it][8 * q + 2 * e + 1]; asm volatile("" : "+v"(p0), "+v"(p1));
                o[e] = ((unsigned)(int)__builtin_rintf(bf_lo(p0) * inv) & 0xffu) | (((unsigned)(int)__builtin_rintf(bf_hi(p0) * inv) & 0xffu) << 8) | (((unsigned)(int)__builtin_rintf(bf_lo(p1) * inv) & 0xffu) << 16) | (((unsigned)(int)__builtin_rintf(bf_hi(p1) * inv) & 0xffu) << 24); }
            *(GAS u32x4*)(dp + (it >> 1) * 32768 + (it & 1) * 1024 + ((16u * (2 * half + q)) ^ xs)) = (u32x4){o[0], o[1], o[2], o[3]}; }
    __syncthreads();
}
struct CvtJob { int b0, n0, b1, n1, b2, n2; };
__device__ __forceinline__ int cvt_index(const CvtJob& J, int j) { return j < J.n0 ? J.b0 + j : (j < J.n0 + J.n1 ? J.b1 + (j - J.n0) : J.b2 + (j - J.n0 - J.n1)); }
template <unsigned KINDS>
__device__ __forceinline__ void cvt_run(const Args& args, unsigned char* wsp, const CvtJob& J, int w, int nw, int lane) {
    asm volatile("" : "+v"(lane));
    const int total = J.n0 + J.n1 + J.n2;
    for (int j = w; j < total; j += nw) { const CvtItem d = cvt_decode<KINDS>(args, wsp, cvt_index(J, j)); float wv[32];
        const float gl = cvtk_gain_load(d, lane);
        cvtk_load(d, wv, lane);
        asm volatile("" ::: "memory");
        cvtk_store(d, wv, gl, lane);
        asm volatile("" ::: "memory"); }
}
__device__ __forceinline__ void row_prologue(const float* xrow, bf16_t* xb, unsigned char* xq, float* rstd_out, float* rowf8_out, int lane) {
    asm volatile("" : "+v"(lane));
    const GAS f32x4* sp = (const GAS f32x4*)xrow + 4 * lane;
    f32x4 v[4][4]; float amax = 0.f, ss = 0.f;
#pragma unroll
    for (int j = 0; j < 4; ++j)
#pragma unroll
        for (int q = 0; q < 4; ++q) { v[j][q] = sp[256 * j + q];
#pragma unroll
            for (int e = 0; e < 4; ++e) { amax = fmaxf(amax, fabsf(v[j][q][e])); ss += v[j][q][e] * v[j][q][e]; } }
    amax = wave_max(amax);
    ss = wave_sum(ss);
    const float inv = amax > 0.f ? 127.0f / amax : 0.f;
    GAS u32x4* bp = (GAS u32x4*)xb + 2 * lane; GAS u32x4* qp = (GAS u32x4*)xq + lane;
#pragma unroll
    for (int j = 0; j < 4; ++j) { unsigned w[4];
#pragma unroll
        for (int q = 0; q < 4; ++q) { unsigned x = 0u;
#pragma unroll
            for (int e = 0; e < 4; ++e) { const int iv = (int)__builtin_rintf(v[j][q][e] * inv); x |= ((unsigned)iv & 0xffu) << (8 * e); }
            w[q] = x; }
        qp[64 * j] = (u32x4){w[0], w[1], w[2], w[3]};
        bp[128 * j] = (u32x4){cvt_pk_bf16(v[j][0][0], v[j][0][1]), cvt_pk_bf16(v[j][0][2], v[j][0][3]), cvt_pk_bf16(v[j][1][0], v[j][1][1]), cvt_pk_bf16(v[j][1][2], v[j][1][3])};
        bp[128 * j + 1] = (u32x4){cvt_pk_bf16(v[j][2][0], v[j][2][1]), cvt_pk_bf16(v[j][2][2], v[j][2][3]), cvt_pk_bf16(v[j][3][0], v[j][3][1]), cvt_pk_bf16(v[j][3][2], v[j][3][3])}; }
    if (lane == 0) { const float rstd = 1.0f / sqrtf(ss * (1.f / DM) + RMS_EPS); *rstd_out = rstd; *rowf8_out = rstd * amax * (1.0f / 127.0f); }
}
__device__ __forceinline__ void build_rstd_table(LAS float* tab, const float* part, int np, int pm, int wave, int lane, bool raw = false) {
    asm volatile("" : "+v"(lane));
    if (raw && np == 1) { if (lane < 32) tab[wave * 32 + lane] = part[pm * 256 + wave * 32 + lane]; LDS_WAIT(); __syncthreads(); return; }
    const float* p = part + (size_t)(pm * 256 + wave * 32) * np + lane;
#pragma unroll 8
    for (int r = 0; r < 32; ++r) { float v = (lane < np) ? p[(size_t)r * np] : 0.f; v = wave_sum(v); if (lane == 0) tab[wave * 32 + r] = raw ? v : 1.0f / sqrtf(v * (1.f / DM) + RMS_EPS); }
    LDS_WAIT(); __syncthreads();
}
struct QRow { u32x4 a[4], b[4]; };
__device__ __forceinline__ void quant_row_load(QRow& r, const bf16_t* src, int lane) {
    const GAS u32x4* sp = (const GAS u32x4*)src + 2 * lane;
#pragma unroll
    for (int j = 0; j < 4; ++j) { r.a[j] = sp[128 * j]; r.b[j] = sp[128 * j + 1]; }
}
__device__ __forceinline__ float quant_row_finish(const QRow& r, unsigned char* dst, int lane, float* ssq) {
    float v[4][16]; float amax = 0.f, ss = 0.f;
#pragma unroll
    for (int j = 0; j < 4; ++j) { const u32x4 a = r.a[j], b = r.b[j];
        v[j][0] = bf_lo(a.x); v[j][1] = bf_hi(a.x); v[j][2] = bf_lo(a.y); v[j][3] = bf_hi(a.y); v[j][4] = bf_lo(a.z); v[j][5] = bf_hi(a.z); v[j][6] = bf_lo(a.w); v[j][7] = bf_hi(a.w);
        v[j][8] = bf_lo(b.x); v[j][9] = bf_hi(b.x); v[j][10] = bf_lo(b.y); v[j][11] = bf_hi(b.y); v[j][12] = bf_lo(b.z); v[j][13] = bf_hi(b.z); v[j][14] = bf_lo(b.w); v[j][15] = bf_hi(b.w);
#pragma unroll
        for (int e = 0; e < 16; ++e) { amax = fmaxf(amax, fabsf(v[j][e])); ss += v[j][e] * v[j][e]; } }
    amax = wave_max(amax);
    if (ssq) *ssq = wave_sum(ss);
    const float inv = amax > 0.f ? 127.0f / amax : 0.f;
    GAS u32x4* dp = (GAS u32x4*)dst + lane;
#pragma unroll
    for (int j = 0; j < 4; ++j) { unsigned w[4];
#pragma unroll
        for (int q = 0; q < 4; ++q) { unsigned x = 0u;
#pragma unroll
            for (int e = 0; e < 4; ++e) { const int iv = (int)__builtin_rintf(v[j][4 * q + e] * inv); x |= ((unsigned)iv & 0xffu) << (8 * e); }
            w[q] = x; }
        dp[64 * j] = (u32x4){w[0], w[1], w[2], w[3]}; }
    return amax * (1.0f / 127.0f);
}
__device__ __forceinline__ float quant_row_i8(const bf16_t* src, unsigned char* dst, int lane, float* ssq) {
    asm volatile("" : "+v"(lane));
    QRow r; quant_row_load(r, src, lane); return quant_row_finish(r, dst, lane, ssq);
}
__device__ __forceinline__ void quant_rows_act(const bf16_t* XB, unsigned char* XQ, float* rstd_out  , float* rowf8_out, int m0, int m1, int step, int lane) {
    asm volatile("" : "+v"(lane));
#define QACT_FIN(R, m) do { float ssq; const float sc = quant_row_finish(R, XQ + (size_t)(m) * DM * 2, lane, &ssq); \
        if (lane == 0) { const float rstd = 1.0f / sqrtf(ssq * (1.f / DM) + RMS_EPS); if (rstd_out) rstd_out[m] = rstd; rowf8_out[m] = rstd * sc; } } while (0)
    int m = m0; if (m >= m1) return;
    QRow ra, rb; quant_row_load(ra, XB + (size_t)m * DM, lane);
    for (;;) {
        const int mb = m + step; const bool more_b = mb < m1;
        if (more_b) quant_row_load(rb, XB + (size_t)mb * DM, lane);
        QACT_FIN(ra, m);
        if (!more_b) break;
        const int ma = mb + step; const bool more_a = ma < m1;
        if (more_a) quant_row_load(ra, XB + (size_t)ma * DM, lane);
        QACT_FIN(rb, mb);
        if (!more_a) break;
        m = ma;
    }
#undef QACT_FIN
}
__device__ __forceinline__ void row_final_norm(const bf16_t* xrow, const float* g, float* orow, const float* part64, int lane, bool poison) {
    asm volatile("" : "+v"(lane));
    const GAS u32x4* xr = (const GAS u32x4*)xrow + lane; const GAS f32x4* gr = (const GAS f32x4*)g + 2 * lane;
    float rstd = 1.0f / sqrtf(wave_sum(part64[lane]) * (1.f / DM) + RMS_EPS);
    if (poison) rstd = __builtin_nanf("");
    GAS f32x4* o4 = (GAS f32x4*)orow + 2 * lane;
#pragma unroll
    for (int j = 0; j < 8; ++j) { const u32x4 w = xr[64 * j]; const f32x4 g0 = gr[128 * j], g1 = gr[128 * j + 1];
        o4[128 * j] = (f32x4){bf_lo(w.x), bf_hi(w.x), bf_lo(w.y), bf_hi(w.y)} * rstd * g0; o4[128 * j + 1] = (f32x4){bf_lo(w.z), bf_hi(w.z), bf_lo(w.w), bf_hi(w.w)} * rstd * g1; }
}
__device__ __forceinline__ void sincos_tab(float ang, float& c, float& s) {
    const double a = (double)ang;
    const double k = __builtin_rint(a * 0.63661977236758134308);
    const double r = __builtin_fma(-k, 6.12323399573676603587e-17, __builtin_fma(-k, 1.57079632679489655800, a));
    const double r2 = r * r;
    double sp = -1.0 / 1307674368000.0; sp = sp * r2 + 1.0 / 6227020800.0; sp = sp * r2 - 1.0 / 39916800.0; sp = sp * r2 + 1.0 / 362880.0; sp = sp * r2 - 1.0 / 5040.0; sp = sp * r2 + 1.0 / 120.0; sp = sp * r2 - 1.0 / 6.0; sp = sp * r2 + 1.0;
    const double sn = sp * r;
    double cp = 1.0 / 20922789888000.0; cp = cp * r2 - 1.0 / 87178291200.0; cp = cp * r2 + 1.0 / 479001600.0; cp = cp * r2 - 1.0 / 3628800.0; cp = cp * r2 + 1.0 / 40320.0; cp = cp * r2 - 1.0 / 720.0; cp = cp * r2 + 1.0 / 24.0; cp = cp * r2 - 0.5; cp = cp * r2 + 1.0;
    const int q = ((int)k) & 3;
    const double cs = (q == 0) ? cp : (q == 1) ? -sn : (q == 2) ? -cp : sn;
    const double ss = (q == 0) ? sn : (q == 1) ? cp : (q == 2) ? -sn : -cp;
    c = (float)cs; s = (float)ss;
}
__device__ __forceinline__ float inv_freq_of(int i) {
    switch (i) {
        case 0: return 0x1.000000p+0f; case 1: return 0x1.c2ef78p-2f; case 2: return 0x1.8d2760p-3f; case 3: return 0x1.5dc95ap-4f;
        case 4: return 0x1.341190p-5f; case 5: return 0x1.0f5386p-6f; case 6: return 0x1.ddee9ep-8f; case 7: return 0x1.a4ee40p-9f;
        case 8: return 0x1.72ba42p-10f; case 9: return 0x1.46831ap-11f; case 10: return 0x1.1f91f0p-12f; case 11: return 0x1.fa8b86p-14f;
        case 12: return 0x1.be218cp-15f; case 13: return 0x1.88ec20p-16f; case 14: return 0x1.5a0f4ep-17f; default: return 0x1.30c94ep-18f;
    }
}

template <int W>
__device__ __forceinline__ void pool_rows(const bf16_t* PROJ, bf16_t* POOLED, int row, int ch8) {
    constexpr int H = W / 2;
    {
        const int t = row & (SEQ - 1);
        const bf16_t* base = PROJ + (size_t)(row - t) * NIN + C_U + ch8 * 8;
        u32x4 wv[W];
#pragma unroll
        for (int i = 0; i < W; ++i) { const int j = t - H + i, jc = j < 0 ? 0 : (j > SEQ - 1 ? SEQ - 1 : j); wv[i] = *(const u32x4*)(base + (size_t)jc * NIN); }
        asm volatile("" ::: "memory");
        float a[8] = {0.f, 0.f, 0.f, 0.f, 0.f, 0.f, 0.f, 0.f};
#pragma unroll
        for (int i = 0; i < W; ++i) { const u32x4 w = wv[i]; const float m = ((unsigned)(t - H + i) < (unsigned)SEQ) ? 1.f : 0.f;
            a[0] = fmaf(bf_lo(w.x), m, a[0]); a[1] = fmaf(bf_hi(w.x), m, a[1]); a[2] = fmaf(bf_lo(w.y), m, a[2]); a[3] = fmaf(bf_hi(w.y), m, a[3]);
            a[4] = fmaf(bf_lo(w.z), m, a[4]); a[5] = fmaf(bf_hi(w.z), m, a[5]); a[6] = fmaf(bf_lo(w.w), m, a[6]); a[7] = fmaf(bf_hi(w.w), m, a[7]); }
        const u32x4 own = wv[H];
        const int lo = (t - H) > 0 ? (t - H) : 0, hi = (t + H - 1) < (SEQ - 1) ? (t + H - 1) : (SEQ - 1);
        const float inv = 1.0f / (float)(hi - lo + 1);
        u32x4 o; o.x = cvt_pk_bf16(a[0] * inv - bf_lo(own.x), a[1] * inv - bf_hi(own.x)); o.y = cvt_pk_bf16(a[2] * inv - bf_lo(own.y), a[3] * inv - bf_hi(own.y));
        o.z = cvt_pk_bf16(a[4] * inv - bf_lo(own.z), a[5] * inv - bf_hi(own.z)); o.w = cvt_pk_bf16(a[6] * inv - bf_lo(own.w), a[7] * inv - bf_hi(own.w));
        *(u32x4*)(POOLED + (size_t)row * PW + ch8 * 8) = o;
    }
}

__global__ void __launch_bounds__(NWAVES * 64, 2) fwd_kernel(Args args_k) {
    extern __shared__ __attribute__((aligned(16))) unsigned char lds[];
    LAS unsigned char* const L = (LAS unsigned char*)lds;
    volatile LAS unsigned* const MISC = (volatile LAS unsigned*)(L + MISC_OFF);
    const int wave = __builtin_amdgcn_readfirstlane((int)threadIdx.x >> 6);
#define OPAQUE_TID() int tid = tid_of(wave); asm volatile("" : "+v"(tid)); const int lane = tid & 63; (void)lane
    const int G = gridDim.x; const int bx = blockIdx.x; const int vcu = ((G & 7) == 0) ? (bx & 7) * (G >> 3) + (bx >> 3) : bx;
    unsigned char* const ws = args_k.ws;
#if defined(__HIP_DEVICE_COMPILE__)
#define LOAD_ARGS() const __attribute__((address_space(4))) unsigned long long* ap_ = (const __attribute__((address_space(4))) unsigned long long*)__builtin_amdgcn_kernarg_segment_ptr(); asm volatile("" : "+s"(ap_)); \
    Args args; { static_assert(sizeof(Args) == 15 * 8, "Args"); unsigned long long* ad_ = (unsigned long long*)&args; _Pragma("unroll") for (int i_ = 0; i_ < 15; ++i_) ad_[i_] = ap_[i_]; }
#else
#define LOAD_ARGS() const Args args = args_k
#endif
    gu32* const ctl = (gu32*)(ws + WS_CTL);
    for (int u = threadIdx.x; u < (LDS_BYTES - LDSCTL_OFF) / 4; u += NWAVES * 64) ((LAS unsigned*)(L + LDSCTL_OFF))[u] = 0u;
    __syncthreads();
    const XcdBarrier bar = xcd_barrier_post((unsigned*)(ctl + CW_BAR), MISC + 8, (unsigned)G);
    if (G != 256) return;
    constexpr bool grouped = true;
    static_assert(DEPTH == 2, "the background conversion streams are laid out for two layers");
    const int gsh = grouped ? 2 : 0, grp = grouped ? ((bx & 7) >> 1) : 0, gsz = G >> gsh, rank = grouped ? ((bx & 1) * 32 + (bx >> 3)) : vcu;
    XcdBarrier sbar = bar;
    if (grouped) sbar = xcd_barrier_post((unsigned*)(ctl + CW_GBAR + grp * GBAR_STRIDE), MISC + 10, 64u);
#define GRID_BAR() xcd_barrier(bar, wave)
#define SEAM_BAR() xcd_barrier(sbar, wave)
    int bgk = 0;
#define BG_POST(k) do { int t0_ = tid_of(wave); asm volatile("" : "+v"(t0_)); if (rank == 0 && t0_ == 0) (void)xb_add((unsigned*)(ctl + CW_DONE + 64 * (k)), 1u); } while (0)
#define BG_WAIT(k) do { int t0_ = tid_of(wave); asm volatile("" : "+v"(t0_)); if (t0_ == 0) { unsigned* p_ = (unsigned*)(ctl + CW_DONE + 64 * (k)); XB_SPIN(xb_ld(p_) < 4u, (unsigned*)(ctl + CW_BAR)); \
        __builtin_amdgcn_fence(__ATOMIC_ACQUIRE, "agent"); asm volatile("s_waitcnt vmcnt(0)" ::: "memory"); } __syncthreads(); } while (0)
#define BG_JOB(base_, n_) const BgJob bgj{&args, wsp, (base_), (n_), gw, NGW}
    const int gw = vcu * NWAVES + wave, NGW = G * NWAVES;
    const int NGT = G * NWAVES * 64;
    const int sw = rank * NWAVES + wave, NSW = gsz * NWAVES;
    const int NST = gsz * NWAVES * 64;
    const int nrow_g = M >> gsh, row_g0 = grp * nrow_g;

#define OPAQUE_WS() LOAD_ARGS(); GAS unsigned char* wsg_ = (GAS unsigned char*)args.ws; asm volatile("" : "+s"(wsg_)); unsigned char* wsp = (unsigned char*)wsg_;     int bxo = blockIdx.x; asm volatile("" : "+s"(bxo)); (void)bxo;     \
    float* const cosT = (float*)(wsp + WS_ROT); float* const sinT = cosT + SEQ * 16; bf16_t* const XB = (bf16_t*)(wsp + WS_H); float* const SSQ = (float*)(wsp + WS_CTL) + CW_SSQ; \
    bf16_t* const PROJ = (bf16_t*)(wsp + WS_PROJ); bf16_t* const ATTO = (bf16_t*)(wsp + WS_ATTO); bf16_t* const POOLED = (bf16_t*)(wsp + WS_POOLED); bf16_t* const MIXED = (bf16_t*)(wsp + WS_MIXED); \
    bf16_t* const MERGED = (bf16_t*)(wsp + WS_MERGED); float* const X = (float*)(wsp + WS_X); bf16_t* const ACT = (bf16_t*)(wsp + WS_ACT); float* const PART = (float*)(wsp + WS_PART); unsigned char* const XQ = wsp + WS_XQ; float* const ROWS = (float*)(wsp + WS_ROWS); unsigned char* const wl = wsp + WS_W + (size_t)l * W_LAYER; \
    (void)cosT; (void)sinT; (void)XB; (void)SSQ; (void)PROJ; (void)ATTO; (void)POOLED; (void)MIXED; (void)MERGED; (void)X; (void)ACT; (void)PART; (void)XQ; (void)ROWS; (void)wl

    {
        LOAD_ARGS(); GAS unsigned char* wsg_ = (GAS unsigned char*)args.ws; asm volatile("" : "+s"(wsg_)); unsigned char* wsp = (unsigned char*)wsg_;
        float* const cosT = (float*)(wsp + WS_ROT); float* const sinT = cosT + SEQ * 16; bf16_t* const XB = (bf16_t*)(wsp + WS_H); float* const SSQ = (float*)(wsp + WS_CTL) + CW_SSQ;
        REPEAT(0) { OPAQUE_TID(); const CvtJob J = CvtJob{0, I_IN, IO_DN, I_DN, I_LAYER + IO_DN, I_DN}; cvt_run<65u>(args, wsp, J, gw, NGW, lane); }
        { constexpr int NBG = (NIN - PN8 * 256) / 32, NBU = NGU / 32, NBL = NBG + NBU;
          OPAQUE_TID();
          for (int b = vcu; b < DEPTH * NBL; b += G) { const int l = b / NBL, r = b - l * NBL; const bool gt8 = r < NBG;
            cvt8_block(gt8 ? args.in[2] + (size_t)l * DM * NIN : args.in[10] + (size_t)l * DM * NGU, gt8 ? NIN : NGU, gt8 ? PN8 * 256 + 32 * r : 32 * (r - NBG), (gt8 ? args.in[1] : args.in[9]) + (size_t)l * DM,
                       gt8 ? wsp + WS_WQI + (size_t)l * WQI_LAYER : wsp + WS_WQ + (size_t)l * WQ_LAYER, gt8 ? 0 : 2, gt8 ? (float*)(wsp + WS_SWI) + (size_t)l * NIN : (float*)(wsp + WS_SW) + (size_t)l * NGU,
                       (LAS float*)(L + RING_BYTES), wave, lane); } }
        { OPAQUE_TID();
        for (int e = vcu * (NWAVES * 64) + tid; e < SEQ * 16; e += NGT) { const int pos = e >> 4, i = e & 15; float c, s; sincos_tab((float)pos * inv_freq_of(i), c, s); cosT[e] = c; sinT[e] = s; }
        { unsigned char* const XQ = wsp + WS_XQ; float* const ROWS = (float*)(wsp + WS_ROWS);
          for (int m = gw; m < M; m += NGW) row_prologue(args.in[0] + (size_t)m * DM, XB + (size_t)m * DM, XQ + (size_t)m * DM * 2, ROWS + m, ROWS + M + m, lane); } }
    }
    GRID_BAR();

#ifdef STAGGER_US
    if (grouped && grp > 0) { const unsigned long long t0 = __builtin_amdgcn_s_memrealtime(); while (__builtin_amdgcn_s_memrealtime() - t0 < (unsigned long long)(grp * STAGGER_US * 100)) __builtin_amdgcn_s_sleep(8); }
#endif
    for (int l = 0; l < DEPTH; ++l) {
        REPEAT(1) {
        {
            OPAQUE_WS();
            LAS float* const rtab = (LAS float*)(L + RING_BYTES);
            if (l > 0) { { OPAQUE_TID(); int swo = sw; asm volatile("" : "+s"(swo)); quant_rows_act(XB, XQ, ROWS, ROWS + M, row_g0 + swo, row_g0 + nrow_g, NSW, lane); }
            SEAM_BAR(); }
            if (grouped) {
                pg8::SchedInMix S; S.init(bxo); S.Ab = (const char*)XB; S.Aq = (const char*)XQ; S.Bb = (const char*)(wl + WO_IN); S.Bq = (const char*)(wsp + WS_WQI + (size_t)l * WQI_LAYER);
                { OPAQUE_TID(); build_rstd_table(rtab, ROWS, 1, S.pm, wave, lane, true); build_rstd_table(rtab + 256, ROWS + M, 1, S.pm, wave, lane, true); }
                pg8::EpiInMix E{PROJ, cosT, sinT, rtab, S.pm, (const float*)(wsp + WS_SWI) + (size_t)l * NIN, (LAS float*)(L + RING_BYTES + 2048)};
                if (l == 0) bgk = 0;
                BG_JOB(l == 0 ? IO_POOL : I_LAYER + IO_DN, l == 0 ? IO_DN - IO_POOL : 0);
                pg8::gemm_phase<pg8::EpiInMix, pg8::SchedInMix, BgOn<94u>>(wave, L, DM, S, E, &bgj, &bgk);
                { OPAQUE_TID(); bg_drain<94u>(bgj, bgk, lane); }
            } else {
                pg8::SchedPlain S; S.T.init(M / 256, NIN / 256, G, bxo); S.A = (const char*)XB; S.B = (const char*)(wl + WO_IN); S.tA = (size_t)256 * DM * 2; S.tB = (size_t)256 * DM * 2; S.nt = DM / 64;
                int tab_pm = -1;
                { pg8::UnitD u0; if (S.next(0, u0)) { OPAQUE_TID(); tab_pm = u0.pm; build_rstd_table(rtab, ROWS, 1, tab_pm, wave, lane, true); } }
                pg8::EpiIn E{PROJ, cosT, sinT, rtab, tab_pm};
                pg8::gemm_phase<pg8::EpiIn, pg8::SchedPlain>(wave, L, DM, S, E);
            }
        }
        SEAM_BAR(); BG_POST(l == 0 ? 0 : 3); }
        REPEAT(2) {
        {
            OPAQUE_WS();
            const float* sink = args.in[3] + l * NHEAD;
            constexpr int NITEMS = BATCH * NHEAD * (SEQ / 256);
            for (int Li = grp * (NITEMS >> gsh) + rank; Li < (grp + 1) * (NITEMS >> gsh); Li += gsz) {
                const int qc_ = Li & 31, kh_ = (Li >> 5) & 3, b_ = Li >> 7; const size_t r0_ = (size_t)b_ * SEQ;
                attn::BlockRef cur;
                cur.Q = PROJ + (r0_ + qc_ * 64) * NIN + C_Q + kh_ * 4 * HD; cur.K = PROJ + r0_ * NIN + C_K + kh_ * HD; cur.V = PROJ + r0_ * NIN + C_V + kh_ * HD;
                cur.O = ATTO + (r0_ + qc_ * 64) * AW + kh_ * 4 * HD; cur.P0 = qc_ * 64; cur.sink4 = sink + kh_ * 4;
                attn::attn_block(wave, cur, (char*)lds);
            }
            { OPAQUE_TID(); int swo = sw; asm volatile("" : "+s"(swo));
              for (int p = swo; p < nrow_g * 4; p += NSW) { const int row = row_g0 + (p >> 2), g = p & 3, ch8 = g * 64 + lane;
                if (g == 0) pool_rows<2>(PROJ, POOLED, row, ch8); else if (g == 1) pool_rows<4>(PROJ, POOLED, row, ch8); else if (g == 2) pool_rows<8>(PROJ, POOLED, row, ch8); else pool_rows<16>(PROJ, POOLED, row, ch8); } }
        }
        SEAM_BAR(); if (l == 0) BG_WAIT(0); }
        REPEAT(3) {
        {
            OPAQUE_WS();
            pg8::SchedPool S; S.T.init(M / 256, PW / 256, G, bxo); S.A = (const char*)POOLED; S.B = (const char*)(wl + WO_POOL); S.tA = (size_t)256 * PW * 2; S.tB = (size_t)256 * 512 * 2; S.nt = 512 / 64;
            pg8::EpiPool E{MIXED, args.in[5] + (size_t)l * PW};
            if (l == 0) bgk = 0;
            BG_JOB(IO_DN, 0);
            pg8::gemm_phase<pg8::EpiPool, pg8::SchedPool, BgOn<64u>>(wave, L, PW, S, E, &bgj, &bgk);
        }
        SEAM_BAR(); }
        REPEAT(4) {
        {
            OPAQUE_WS();
            pg8::SchedBranch S; S.T.init(M / 256, DM / 256, G, bxo); S.A1 = (const char*)ATTO; S.B1 = (const char*)(wl + WO_BA); S.A2 = (const char*)MIXED; S.B2 = (const char*)(wl + WO_BP);
            S.tA = (size_t)256 * AW * 2; S.tB = (size_t)256 * AW * 2; S.nt = AW / 64;
            pg8::EpiBranch E{PROJ, MERGED};
            BG_JOB(IO_DN, 0);
            pg8::gemm_phase<pg8::EpiBranch, pg8::SchedBranch, BgOn<64u>>(wave, L, AW, S, E, &bgj, &bgk);
        }
        SEAM_BAR(); }
        REPEAT(5) {
        {
            OPAQUE_WS();
            pg8::SchedPlain S; S.T.init(M / 256, DM / 256, G, bxo); S.A = (const char*)MERGED; S.B = (const char*)(wl + WO_OUT); S.tA = (size_t)256 * DM * 2; S.tB = (size_t)256 * DM * 2; S.nt = DM / 64;
            const bool dry = ((REPMASK >> 5) & 1) && rep_ == 0;
            pg8::EpiRes E{l == 0 ? args.in[0] : nullptr, XB, dry ? (bf16_t*)(wsp + WS_END) : XB, nullptr, PART + (size_t)(dry ? 4 : 2 * l) * M * 64};
            BG_JOB(IO_DN, 0);
            pg8::gemm_phase<pg8::EpiRes, pg8::SchedPlain, BgOn<64u>>(wave, L, DM, S, E, &bgj, &bgk);
            { OPAQUE_TID(); bg_drain<64u>(bgj, bgk, lane); }
        }
        SEAM_BAR(); if (l == 0) BG_POST(1); }
        REPEAT(7) {
        {
            OPAQUE_WS();
            { OPAQUE_TID(); int swo = sw; asm volatile("" : "+s"(swo)); quant_rows_act(XB, XQ, nullptr, ROWS + M, row_g0 + swo, row_g0 + nrow_g, NSW, lane); }
            SEAM_BAR();
            pg8::SchedPlain S; S.T.init(M / 256, NGU / 256, G, bxo); S.A = (const char*)XQ; S.B = (const char*)(wsp + WS_WQ + (size_t)l * WQ_LAYER); S.tA = (size_t)256 * DM * 2; S.tB = (size_t)256 * DM; S.nt = DM / 128;
            LAS float* const rtab = (LAS float*)(L + RING_BYTES);
            int tab_pm = -1;
            { pg8::UnitD u0; if (S.next(0, u0)) { OPAQUE_TID(); tab_pm = u0.pm; build_rstd_table(rtab, ROWS + M, 1, tab_pm, wave, lane, true); } }
            pg8::EpiGU8 E{ACT, rtab, tab_pm, (const float*)(wsp + WS_SW) + (size_t)l * NGU, (LAS float*)(L + RING_BYTES + 2048)};
            if (l == 0) bgk = 0;
            BG_JOB(I_LAYER, l == 0 ? IO_DN : 0);
            pg8::gemm_phase<pg8::EpiGU8, pg8::SchedPlain, BgOn<31u>>(wave, L, DM, S, E, &bgj, &bgk);
            { OPAQUE_TID(); bg_drain<31u>(bgj, bgk, lane); }
        }
        SEAM_BAR(); if (l == 0) { BG_POST(2); BG_WAIT(1); } else BG_WAIT(3); }
        REPEAT(8) {
        {
            OPAQUE_WS();
            pg8::SchedPlain S; S.T.init(M / 256, DM / 256, G, bxo); S.A = (const char*)ACT; S.B = (const char*)(wl + WO_DN); S.tA = (size_t)256 * FF * 2; S.tB = (size_t)256 * FF * 2; S.nt = FF / 64;
            const bool dry = ((REPMASK >> 8) & 1) && rep_ == 0;
            pg8::EpiRes E{nullptr, XB, dry ? (bf16_t*)(wsp + WS_END) : XB, nullptr, PART + (size_t)(dry ? 4 : 2 * l + 1) * M * 64};
            if (l == 0) bgk = 0;
            BG_JOB(I_LAYER + IO_DN, 0);
            pg8::gemm_phase<pg8::EpiRes, pg8::SchedPlain, BgOn<64u>>(wave, L, FF, S, E, &bgj, &bgk);
        }
        SEAM_BAR(); if (l == 0) BG_WAIT(2); }
        if (l + 1 == DEPTH) {
            OPAQUE_WS(); OPAQUE_TID();
            const bool poison = (xb_ld((unsigned*)(ctl + CW_BAR) + XB_TMO) | xb_ld(sbar.bar + XB_TMO)) != 0u;
            const float* pq = PART + (size_t)(2 * DEPTH - 1) * M * 64;
            for (int m = row_g0 + sw; m < row_g0 + nrow_g; m += NSW) row_final_norm(XB + (size_t)m * DM, args.in[12], args.out + (size_t)m * DM, pq + (size_t)m * 64, lane, poison);
        }
    }
#undef GRID_BAR
#undef SEAM_BAR
#undef BG_POST
#undef BG_WAIT
#undef BG_JOB
#undef OPAQUE_WS
#undef OPAQUE_TID
}

extern "C" void kernel_launch(void* const* d_in, const int* in_sizes, int n_in, void* d_out, int out_size, void* d_ws, size_t ws_size, hipStream_t stream) {
    static int grid = 0;
    if (grid == 0) {
        if (n_in != 13 || in_sizes[0] != M * DM || out_size != M * DM || ws_size < WS_END + 64 * MiB) {
            fprintf(stderr, "kernel_launch: unexpected shapes (n_in %d, in0 %d, out %d, ws %zu, need %zu); nothing launched\n", n_in, n_in > 0 ? in_sizes[0] : -1, out_size, ws_size, (size_t)WS_END); grid = -1; return; }
        int dev = 0, cus = 0, per_cu = 0;
        if (hipGetDevice(&dev) != hipSuccess || hipDeviceGetAttribute(&cus, hipDeviceAttributeMultiprocessorCount, dev) != hipSuccess) { fprintf(stderr, "kernel_launch: device query failed\n"); grid = -1; return; }
        if (hipFuncSetAttribute((const void*)fwd_kernel, hipFuncAttributeMaxDynamicSharedMemorySize, LDS_BYTES) != hipSuccess) { fprintf(stderr, "kernel_launch: hipFuncSetAttribute failed\n"); grid = -1; return; }
        if (hipOccupancyMaxActiveBlocksPerMultiprocessor(&per_cu, (const void*)fwd_kernel, NWAVES * 64, LDS_BYTES) != hipSuccess || per_cu < 1)
            fprintf(stderr, "kernel_launch: note: occupancy query reports %d workgroups per CU\n", per_cu);
        (void)hipGetLastError();
        if (cus != 256) { fprintf(stderr, "kernel_launch: this build needs a 256-CU device (found %d CUs); nothing launched\n", cus); grid = -1; return; }
        grid = cus;
    }
    if (grid < 0) return;
    if (hipMemsetAsync((char*)d_ws + WS_CTL, 0, CTL_ZERO_BYTES, stream) != hipSuccess) { fprintf(stderr, "kernel_launch: memset failed\n"); return; }
    Args a{};
    for (int i = 0; i < 13; ++i) a.in[i] = (const float*)d_in[i];
    a.out = (float*)d_out; a.ws = (unsigned char*)d_ws;
    hipLaunchKernelGGL(fwd_kernel, dim3(grid), dim3(NWAVES * 64), LDS_BYTES, stream, a);
    const hipError_t le = hipPeekAtLastError();
    if (le != hipSuccess) fprintf(stderr, "kernel_launch: launch failed: %s\n", hipGetErrorName(le));
}
```

```cpp
#include <hip/hip_runtime.h>
#include <hip/hip_bf16.h>
#include <cstdio>
#include <cstdint>
#ifndef REPMASK
#define REPMASK 0
#endif
#define REPEAT(k) _Pragma("unroll") for (int rep_ = 0; rep_ < 1 + ((REPMASK >> (k)) & 1); ++rep_)

#define GAS __attribute__((address_space(1)))
#define LAS __attribute__((address_space(3)))
typedef unsigned short bf16_t;
typedef short bf16x8 __attribute__((ext_vector_type(8)));
typedef short s16x4 __attribute__((ext_vector_type(4)));
typedef float f32x4 __attribute__((ext_vector_type(4)));
typedef float f32x16 __attribute__((ext_vector_type(16)));
typedef unsigned u32x4 __attribute__((ext_vector_type(4)));
typedef int i32x4 __attribute__((ext_vector_type(4)));
typedef GAS unsigned gu32;

constexpr int BATCH = 4, SEQ = 2048, M = BATCH * SEQ, DM = 4096, NHEAD = 16, NKVH = 4, HD = 128, DEPTH = 2;
constexpr int AW = 2048, KVW = 512, PW = 2048, NIN = 13312, FF = 11008, NGU = 2 * FF;
constexpr int C_Q = 0, C_K = 2048, C_V = 2560, C_U = 3072, C_GA = 5120, C_GB = 9216;
constexpr float RMS_EPS = 1e-6f;

constexpr size_t MiB = 1u << 20;
constexpr size_t WS_CTL = 0, CTL_ZERO_BYTES = 1 * MiB;
constexpr size_t WS_ROT = 1 * MiB;
constexpr size_t WS_W = 2 * MiB;
constexpr size_t WO_IN = 0, WO_POOL = 108 * MiB, WO_BA = 112 * MiB, WO_BP = 130 * MiB, WO_OUT = 148 * MiB, WO_DN = 182 * MiB, W_LAYER = 274 * MiB;
static_assert((size_t)NIN * DM * 2 <= WO_POOL - WO_IN && (size_t)4 * 512 * 512 * 2 <= WO_BA - WO_POOL && (size_t)DM * AW * 2 <= WO_BP - WO_BA && (size_t)DM * DM * 2 <= WO_DN - WO_OUT && (size_t)DM * FF * 2 <= W_LAYER - WO_DN, "weight map");
constexpr size_t WS_ACTS = WS_W + DEPTH * W_LAYER;
constexpr size_t WS_H = WS_ACTS, WS_PROJ = WS_H + 64 * MiB, WS_ATTO = WS_PROJ + 208 * MiB, WS_POOLED = WS_ATTO + 32 * MiB, WS_MIXED = WS_POOLED + 32 * MiB,
                 WS_MERGED = WS_MIXED + 32 * MiB, WS_X = WS_MERGED + 64 * MiB, WS_ACT = WS_X + 128 * MiB, WS_PART = WS_ACT + 172 * MiB, WS_WQ = WS_PART + 10 * MiB, WQ_LAYER = 88 * MiB, WS_XQ = WS_WQ + DEPTH * WQ_LAYER, WS_SW = WS_XQ + 64 * MiB, WS_ROWS = WS_SW + 1 * MiB,
                 WS_WQI = WS_ROWS + 1 * MiB, WQI_LAYER = 104 * MiB, WS_SWI = WS_WQI + DEPTH * WQI_LAYER, WS_END = WS_SWI + 1 * MiB;
static_assert((size_t)NGU * DM <= WQ_LAYER && (size_t)DEPTH * NGU * 4 <= 1 * MiB && (size_t)NIN * DM <= WQI_LAYER && (size_t)DEPTH * NIN * 4 <= 1 * MiB && (size_t)M * DM * 2 <= 64 * MiB, "int8 map");
constexpr int CVT8_HOLD = 8;
constexpr int PN8 = 12;
static_assert((size_t)M * NIN * 2 <= 208 * MiB && (size_t)M * FF * 2 <= 172 * MiB, "activation map");
constexpr int CW_SSQ = 32768;
constexpr int CW_DONE = 28672;
constexpr int CW_BAR = 4096, CW_GBAR = 8192, GBAR_STRIDE = 4096;

constexpr int RING_BYTES = 131072, LDSCTL_OFF = 139264, MISC_OFF = LDSCTL_OFF + 320, LDS_BYTES = 147456;
constexpr int NWAVES = 8;

#define LDS_WAIT() asm volatile("s_waitcnt lgkmcnt(0)" ::: "memory")
#define VM_WAIT() asm volatile("s_waitcnt vmcnt(0)" ::: "memory")
__device__ __forceinline__ unsigned cvt_pk_bf16(float lo, float hi) { unsigned r; asm volatile("v_cvt_pk_bf16_f32 %0, %1, %2" : "=v"(r) : "v"(lo), "v"(hi)); return r; }
__device__ __forceinline__ float bf_lo(unsigned w) { return __uint_as_float(w << 16); }
__device__ __forceinline__ float bf_hi(unsigned w) { return __uint_as_float(w & 0xffff0000u); }
__device__ __forceinline__ int tid_of(int wave) { unsigned m = ~0u; asm volatile("" : "+s"(m)); return wave * 64 + (int)__builtin_amdgcn_mbcnt_hi(m, __builtin_amdgcn_mbcnt_lo(m, 0u)); }
template <int K> __device__ __forceinline__ float xchg(float v) { static_assert(K >= 1 && K <= 16, "xchg"); return __builtin_bit_cast(float, __builtin_amdgcn_ds_swizzle(__builtin_bit_cast(int, v), (K << 10) | 0x1f)); }
__device__ __forceinline__ float sum32(float v) { auto r = __builtin_amdgcn_permlane32_swap(__float_as_uint(v), __float_as_uint(v), false, false); const unsigned a = r[0], b = r[1]; return __uint_as_float(a) + __uint_as_float(b); }
__device__ __forceinline__ float max32(float v) { auto r = __builtin_amdgcn_permlane32_swap(__float_as_uint(v), __float_as_uint(v), false, false); const unsigned a = r[0], b = r[1]; return fmaxf(__uint_as_float(a), __uint_as_float(b)); }
__device__ __forceinline__ float wave_max(float v) { v = fmaxf(v, xchg<1>(v)); v = fmaxf(v, xchg<2>(v)); v = fmaxf(v, xchg<4>(v)); v = fmaxf(v, xchg<8>(v)); v = fmaxf(v, xchg<16>(v)); return max32(v); }
__device__ __forceinline__ float fast_sigmoid(float x) { return __builtin_amdgcn_rcpf(1.0f + __builtin_amdgcn_exp2f(-1.4426950408889634f * x)); }

namespace pg8 {
constexpr int BM = 256, BK = 64, HALF = 128, HTB = HALF * BK * 2, STAGE_BYTES = 8 * HTB, NXCD = 8, WGM = 8;
__host__ __device__ __forceinline__ int lds_byte(int r, int c) { const int st = (r >> 4) * 2 + (c >> 5), rr = r & 15, cc = c & 31, ob = rr * 64 + cc * 2; return st * 1024 + (ob ^ (((ob >> 9) & 1) << 5)); }
__host__ __device__ __forceinline__ void stage_rc(int b, int& R, int& C) { const int st = b / 1024, sb = b % 1024, swz = sb ^ (((sb >> 9) & 1) << 5); R = (st >> 1) * 16 + swz / 64; C = (st & 1) * 32 + (swz % 64) / 2; }
__host__ __device__ __forceinline__ int perm32(int rho) { const int n = rho >> 4, i = rho & 15; return 8 * (i >> 2) + 4 * n + (i & 3); }

struct UnitD { const char* A; const char* B; int pm, pn, nt, kind, slot; };

struct TileOrder {
    int nM, nN, nwg, G, c;
    __device__ __forceinline__ void init(int nM_, int nN_, int G_, int c_) { nM = nM_; nN = nN_; nwg = nM * nN; G = G_; c = c_; }
    __device__ __forceinline__ bool tile(int i, int& pm, int& pn) const {
        const long L = (long)i * G + c; if (L >= nwg) return false;
        int wgid = (int)L; { const int q = nwg / NXCD, r = nwg % NXCD, xcd = wgid % NXCD, off = wgid / NXCD; wgid = (xcd < r ? xcd * (q + 1) : r * (q + 1) + (xcd - r) * q) + off; }
        const int nig = WGM * nN, gid = wgid / nig, fm = gid * WGM, gsz = (nM - fm) < WGM ? (nM - fm) : WGM;
        pm = fm + ((wgid % nig) % gsz); pn = (wgid % nig) / gsz; return true;
    }
};
struct SchedPlain {
    TileOrder T; const char* A; const char* B; size_t tA, tB; int nt;
    __device__ __forceinline__ bool next(int i, UnitD& u) const { int pm, pn; if (!T.tile(i, pm, pn)) return false; u.pm = pm; u.pn = pn; u.A = A + (size_t)pm * tA; u.B = B + (size_t)pn * tB; u.nt = nt; u.kind = 0; return true; }
};
struct SchedPool {
    TileOrder T; const char* A; const char* B; size_t tA, tB; int nt;
    __device__ __forceinline__ bool next(int i, UnitD& u) const { int pm, pn; if (!T.tile(i, pm, pn)) return false; u.pm = pm; u.pn = pn; u.A = A + (size_t)pm * tA + (size_t)(pn >> 1) * 1024; u.B = B + (size_t)pn * tB; u.nt = nt; u.kind = 0; return true; }
};
struct SchedBranch {
    TileOrder T; const char* A1; const char* B1; const char* A2; const char* B2; size_t tA, tB; int nt;
    __device__ __forceinline__ bool next(int i, UnitD& u) const { int pm, pn; if (!T.tile(i >> 1, pm, pn)) return false; const int s = i & 1; u.pm = pm; u.pn = pn;
        u.A = (s ? A2 : A1) + (size_t)pm * tA; u.B = (s ? B2 : B1) + (size_t)pn * tB; u.nt = nt; u.kind = s; return true; }
};

}
struct Args { const float* in[13]; float* out; unsigned char* ws; };
__device__ __forceinline__ int destrow(int s) { return (s & ~31) + pg8::perm32(s & 31); }
__device__ __forceinline__ int srccol(int map, int s) {
    const int d = destrow(s);
    if (map == 1) {
        if (d < C_V) { const int p = d & 127; if (p < 32) { const int e = ((p >> 3) << 2) | (p & 3); return d - p + e + (((p >> 2) & 1) << 4); } }
        return d;
    }
    if (map == 2) {
        const int t = d >> 8, r = d & 255; return r < 128 ? (t << 7) + r : FF + (t << 7) + (r - 128);
    }
    return d;
}
constexpr int NB_IN = PN8 * 256 / 256;
constexpr int I_IN = (DM / 32) * 4 * NB_IN, I_PW = (512 / 32) * (512 / 64), I_BR = (AW / 32) * (DM / 64), I_OUT = (DM / 32) * (DM / 64), I_GU = 0, I_DN = (FF / 32) * (DM / 64);
constexpr int IO_POOL = I_IN, IO_BA = IO_POOL + 4 * I_PW, IO_BP = IO_BA + I_BR, IO_OUT = IO_BP + I_BR, IO_GU = IO_OUT + I_OUT, IO_DN = IO_GU + I_GU, I_LAYER = IO_DN + I_DN;
static_assert(I_LAYER == (PN8 == 20 ? 49152 : 45056), "item map");
struct CvtItem { const float* src; unsigned char* dst; const float* gain; int N, slot0, map, c32; };
template <unsigned KINDS>
__device__ __forceinline__ CvtItem cvt_decode(const Args& args, unsigned char* wsp, int it) {
    const int l = it / I_LAYER; int r = it - l * I_LAYER; unsigned char* wl = wsp + WS_W + (size_t)l * W_LAYER;
    const float* W = nullptr; unsigned char* D = nullptr; const float* gain = nullptr; int N = 512, K = DM, map = 0, k32 = 0, sq = 0;
    if ((KINDS & 1u) && r < IO_POOL) { k32 = r / (4 * NB_IN); sq = r - k32 * (4 * NB_IN); W = args.in[2] + (size_t)l * DM * NIN; N = NIN; D = wl + WO_IN; map = 1; gain = args.in[1] + (size_t)l * DM; }
    else if ((KINDS & 2u) && r < IO_BA) { r -= IO_POOL; const int g = r / I_PW; r -= g * I_PW; k32 = r >> 3; sq = r & 7; W = args.in[4] + ((size_t)l * 4 + g) * 512 * 512; N = 512; K = 512; D = wl + WO_POOL + (size_t)g * 512 * 512 * 2; }
    else if ((KINDS & 4u) && r < IO_BP) { r -= IO_BA; k32 = r >> 6; sq = r & 63; W = args.in[6] + (size_t)l * AW * DM; N = DM; K = AW; D = wl + WO_BA; }
    else if ((KINDS & 8u) && r < IO_OUT) { r -= IO_BP; k32 = r >> 6; sq = r & 63; W = args.in[7] + (size_t)l * PW * DM; N = DM; K = PW; D = wl + WO_BP; }
    else if ((KINDS & 16u) && r < IO_GU) { r -= IO_OUT; k32 = r >> 6; sq = r & 63; W = args.in[8] + (size_t)l * DM * DM; N = DM; D = wl + WO_OUT; }
    else if (KINDS & 64u) { r -= IO_DN; k32 = r >> 6; sq = r & 63; W = args.in[11] + (size_t)l * FF * DM; N = DM; K = FF; D = wl + WO_DN; }
    CvtItem d; d.N = N; d.slot0 = 64 * sq; d.map = map; d.c32 = k32 & 1; d.gain = gain ? gain + 32 * k32 : nullptr;
    d.src = W + (size_t)(32 * k32) * N; d.dst = D + (size_t)(sq >> 2) * ((size_t)K * 512) + (size_t)(k32 >> 1) * 32768;
    return d;
}
__device__ __forceinline__ void cvtk_load(const CvtItem& d, float (&w)[32], int lane) {
    const unsigned loff = (unsigned)srccol(d.map, d.slot0 + lane) * 4u;
#pragma unroll
    for (int j = 0; j < 32; ++j) w[j] = *(const float*)((const char*)(d.src + (size_t)j * d.N) + loff);
}
__device__ __forceinline__ float cvtk_gain_load(const CvtItem& d, int lane) { const float* gp = d.gain ? d.gain : d.src; return gp[lane & 31]; }
__device__ __forceinline__ unsigned img_seg(int r, int c32) { return (unsigned)((r >> 7) * pg8::HTB + ((((r & 127) >> 4) * 2 + c32) * 1024) + (r & 15) * 64); }
__device__ __forceinline__ void cvtk_store(const CvtItem& d, const float (&w)[32], float gl, int lane) {
    const int r = (d.slot0 & 255) + lane; const unsigned seg = img_seg(r, d.c32), x = (r & 8) ? 32u : 0u;
    const bool hg = d.gain != nullptr;
#pragma unroll
    for (int j = 0; j < 4; ++j) { float g[8];
#pragma unroll
        for (int e = 0; e < 8; ++e) { const float t = __builtin_bit_cast(float, __builtin_amdgcn_readlane(__builtin_bit_cast(int, gl), 8 * j + e)); g[e] = hg ? t : 1.f; }
        u32x4 o; o.x = cvt_pk_bf16(w[8 * j] * g[0], w[8 * j + 1] * g[1]); o.y = cvt_pk_bf16(w[8 * j + 2] * g[2], w[8 * j + 3] * g[3]); o.z = cvt_pk_bf16(w[8 * j + 4] * g[4], w[8 * j + 5] * g[5]); o.w = cvt_pk_bf16(w[8 * j + 6] * g[6], w[8 * j + 7] * g[7]);
        *(GAS u32x4*)(d.dst + seg + ((16u * j) ^ x)) = o; }
}

struct BgJob { const Args* args; unsigned char* wsp; int base, n, first, nw; };
template <unsigned KINDS> struct BgOn { static constexpr bool ON = true; static constexpr unsigned K = KINDS; };
struct BgOff { static constexpr bool ON = false; static constexpr unsigned K = 0; };
constexpr int BGN = 1;
template <unsigned KINDS>
__device__ __forceinline__ void bg_drain(const BgJob& job, int& bgk, int lane) {
    asm volatile("" : "+v"(lane));
    for (int j = job.first + bgk * job.nw; j < job.n; j += job.nw) { const CvtItem d = cvt_decode<KINDS>(*job.args, job.wsp, job.base + j); float wv[32];
        const float gl = cvtk_gain_load(d, lane); cvtk_load(d, wv, lane); asm volatile("" ::: "memory"); cvtk_store(d, wv, gl, lane); asm volatile("" ::: "memory"); ++bgk; }
}
namespace pg8 {
template <bool I8> struct AccT { typedef f32x4 type; };
template <> struct AccT<true> { typedef i32x4 type; };
__device__ __forceinline__ void mma16(f32x4& c, bf16x8 b, bf16x8 a) { c = __builtin_amdgcn_mfma_f32_16x16x32_bf16(b, a, c, 0, 0, 0); }
__device__ __forceinline__ void mma16_bf(i32x4& c, bf16x8 b, bf16x8 a) { f32x4 t = __builtin_bit_cast(f32x4, c); t = __builtin_amdgcn_mfma_f32_16x16x32_bf16(b, a, t, 0, 0, 0); c = __builtin_bit_cast(i32x4, t); }
__device__ __forceinline__ void mma16(i32x4& c, bf16x8 b, bf16x8 a) { c = __builtin_amdgcn_mfma_i32_16x16x64_i8(__builtin_bit_cast(i32x4, b), __builtin_bit_cast(i32x4, a), c, 0, 0, 0); }
template <class Epi, class Sched, class Bg = BgOff>
__device__ __forceinline__ void gemm_phase(const int wave_, LAS unsigned char* lds, const int lda, const Sched& S, const Epi& E, const BgJob* job = nullptr, int* bgkp = nullptr) {
    int tid = tid_of(wave_); asm volatile("" : "+v"(tid));
    const int wid = wave_, lane = tid & 63, wr = wid >> 2, wc = wid & 3, fr = lane & 15, fq = lane >> 4;
    unsigned voffA[2], voffB[2];
#pragma unroll
    for (int i = 0; i < 2; ++i) { int R, C; stage_rc(tid * 16 + i * 8192, R, C);
        voffA[i] = (unsigned)(R * lda + C) * 2u; voffB[i] = (unsigned)(tid * 16 + i * 8192); }
    static_assert(Epi::PERM, "the KG-major weight copies are written in PERM slot order");
    const size_t kstep = (size_t)(BK * 2), kstepB = 2 * HTB;
    const size_t hstepA = (size_t)HALF * lda * 2, hstepB = HTB;
    const unsigned ldsw = (unsigned)wid * 1024u;
    const int aoff = lds_byte(wr * 64 + fr, fq * 8), boff = lds_byte(wc * 32 + fr, fq * 8);
#define PG8_SA(b, h) (((b) * 2 + (h)) * HTB)
#define PG8_SB(b, h) ((4 + (b) * 2 + (h)) * HTB)
#define PG8_STAGE(bufoff, gbase, voff) do { _Pragma("unroll") for (int _i = 0; _i < 2; ++_i) \
        __builtin_amdgcn_global_load_lds((const unsigned*)((const char*)(gbase) + (voff)[_i]), (LAS unsigned*)(lds + (bufoff) + ldsw + _i * 8192), 16, 0, 0); } while (0)
#define PG8_LDA(dst, b, h) do { _Pragma("unroll") for (int m = 0; m < 4; ++m) _Pragma("unroll") for (int k = 0; k < 2; ++k) dst[m][k] = *(const LAS bf16x8*)(lds + PG8_SA(b, h) + aoff + m * 2048 + k * 1024); } while (0)
#define PG8_LDB(dst, b, h) do { _Pragma("unroll") for (int n = 0; n < 2; ++n) _Pragma("unroll") for (int k = 0; k < 2; ++k) dst[n][k] = *(const LAS bf16x8*)(lds + PG8_SB(b, h) + boff + n * 2048 + k * 1024); } while (0)
#define PG8_MMA(FN, ai, bj, At, Bt) do { __builtin_amdgcn_s_setprio(1); _Pragma("unroll") for (int m = 0; m < 4; ++m) _Pragma("unroll") for (int n = 0; n < 2; ++n) _Pragma("unroll") for (int k = 0; k < 2; ++k) \
        FN(acc[ai][bj][m][n], Bt[n][k], At[m][k]); __builtin_amdgcn_s_setprio(0); } while (0)
#define PG8_WAIT_V(n) asm volatile("s_waitcnt vmcnt(" #n ")" ::: "memory")
#define PG8_WAIT_L(n) asm volatile("s_waitcnt lgkmcnt(" #n ")" ::: "memory")
#define PG8_BAR __builtin_amdgcn_s_barrier()
#define PG8_SCHED __builtin_amdgcn_sched_barrier(0)
#define PG8_ZERO() do { _Pragma("unroll") for (int a = 0; a < 2; ++a) _Pragma("unroll") for (int b = 0; b < 2; ++b) _Pragma("unroll") for (int m = 0; m < 4; ++m) _Pragma("unroll") for (int n = 0; n < 2; ++n) acc[a][b][m][n] = (acc_t){0, 0, 0, 0}; } while (0)
#define PG8_KLOOP(FN) \
        for (int t = 0; t < nt; t += 2) { \
            const bool last = (t == nt - 2); \
            const char* a1 = cA + (size_t)(t + 1) * kstep; \
            const char* a2 = last ? nA : cA + (size_t)(t + 2) * kstep; const char* b2 = last ? nB : cB + (size_t)(t + 2) * kstepB; \
            const char* a3 = a2 + kstep; const char* b3 = b2 + kstepB; \
 \
            PG8_LDB(B0, 0, 0); PG8_LDB(B1, 0, 1); PG8_SCHED; PG8_LDA(At, 0, 0); PG8_STAGE(PG8_SA(1, 1), a1 + hstepA, voffA); \
            PG8_WAIT_V(8); PG8_WAIT_L(0); PG8_BAR; PG8_MMA(FN, 0, 0, At, B0); PG8_MMA(FN, 0, 1, At, B1); PG8_BAR; PG8_SCHED; \
 \
            PG8_LDA(At, 0, 1); PG8_STAGE(PG8_SB(0, 0), b2, voffB); PG8_STAGE(PG8_SB(0, 1), b2 + hstepB, voffB); PG8_STAGE(PG8_SA(0, 0), a2, voffA); \
            PG8_WAIT_V(8); PG8_WAIT_L(0); PG8_BAR; PG8_MMA(FN, 1, 0, At, B0); PG8_MMA(FN, 1, 1, At, B1); PG8_BAR; PG8_SCHED; \
 \
            PG8_LDB(B0, 1, 0); PG8_LDB(B1, 1, 1); PG8_SCHED; PG8_LDA(At, 1, 0); PG8_STAGE(PG8_SA(0, 1), a2 + hstepA, voffA); \
            PG8_WAIT_V(8); PG8_WAIT_L(0); PG8_BAR; PG8_MMA(FN, 0, 0, At, B0); PG8_MMA(FN, 0, 1, At, B1); PG8_BAR; PG8_SCHED; \
 \
            PG8_LDA(At, 1, 1); PG8_STAGE(PG8_SB(1, 0), b3, voffB); PG8_STAGE(PG8_SB(1, 1), b3 + hstepB, voffB); PG8_STAGE(PG8_SA(1, 0), a3, voffA); \
            PG8_WAIT_V(8); PG8_WAIT_L(0); PG8_BAR; PG8_MMA(FN, 1, 0, At, B0); PG8_MMA(FN, 1, 1, At, B1); PG8_BAR; PG8_SCHED; \
        }
    UnitD cur, nxt; int ui = 0;
    if (!S.next(0, cur)) return;
    typedef typename AccT<Epi::I8 || Epi::MIXED>::type acc_t;
    acc_t acc[2][2][4][2];
    bool k8 = Epi::MIXED && cur.kind != 0;
    PG8_ZERO();
    bf16x8 At[4][2], B0[2][2], B1[2][2];
    const char* cA = cur.A; const char* cB = cur.B;
    cur.slot = 0; if constexpr (Epi::PRE) E.prefetch(cur, wid, lane);
    PG8_STAGE(PG8_SB(0, 0), cB, voffB); PG8_STAGE(PG8_SB(0, 1), cB + hstepB, voffB); PG8_STAGE(PG8_SA(0, 0), cA, voffA); PG8_STAGE(PG8_SA(0, 1), cA + hstepA, voffA);
    if (wr == 1) PG8_BAR;
    PG8_WAIT_V(2); PG8_BAR;
    PG8_STAGE(PG8_SB(1, 0), cB + kstepB, voffB); PG8_STAGE(PG8_SA(1, 0), cA + kstep, voffA); PG8_STAGE(PG8_SB(1, 1), cB + hstepB + kstepB, voffB);
    PG8_WAIT_V(6); PG8_BAR;
    for (;;) {
        const bool has_next = S.next(ui + 1, nxt);
        const char* nA = has_next ? nxt.A : cA; const char* nB = has_next ? nxt.B : cB;
        const int nt = cur.nt;
        if constexpr (Epi::MIXED) { if (k8) { PG8_KLOOP(mma16) } else { PG8_KLOOP(mma16_bf) } } else { PG8_KLOOP(mma16) }
        if (wr == 0) PG8_BAR;
        float bw[BGN][32], bgl[BGN]; int bj[BGN];
        int lx = lane; asm volatile("" : "+v"(lx)); const int frx = lx & 15, fqx = lx >> 4;
        E.pre(acc, cur, wr, wc, frx, fqx);
        if constexpr (Bg::ON) { int ln = lane; asm volatile("" : "+v"(ln));
#pragma unroll
            for (int q = 0; q < BGN; ++q) { bj[q] = job->first + (*bgkp + q) * job->nw;
                if (bj[q] < job->n) { const CvtItem d = cvt_decode<Bg::K>(*job->args, job->wsp, job->base + bj[q]); bgl[q] = cvtk_gain_load(d, ln); cvtk_load(d, bw[q], ln); } }
            *bgkp += BGN; asm volatile("" ::: "memory");
        }
        const bool keep = E(acc, cur, wr, wc, frx, fqx);
        if constexpr (Bg::ON) { asm volatile("" ::: "memory"); int ln = lane; asm volatile("" : "+v"(ln));
#pragma unroll
            for (int q = 0; q < BGN; ++q) if (bj[q] < job->n) { const CvtItem d = cvt_decode<Bg::K>(*job->args, job->wsp, job->base + bj[q]); cvtk_store(d, bw[q], bgl[q], ln); }
            asm volatile("" ::: "memory"); }
        if (!has_next) break;
        if (!keep) PG8_ZERO();
        cur = nxt; cA = nA; cB = nB; ++ui; k8 = Epi::MIXED && cur.kind != 0;
        cur.slot = ui & 1; if constexpr (Epi::PRE) E.prefetch(cur, wid, lane);
        if (wr == 1) PG8_BAR;
    }
    PG8_WAIT_V(0);
    PG8_BAR;
#undef PG8_SA
#undef PG8_SB
#undef PG8_STAGE
#undef PG8_LDA
#undef PG8_LDB
#undef PG8_MMA
#undef PG8_KLOOP
#undef PG8_WAIT_V
#undef PG8_WAIT_L
#undef PG8_BAR
#undef PG8_SCHED
#undef PG8_ZERO
}

struct EpiIn {
    static constexpr bool PERM = true, I8 = false, MIXED = false, PRE = false;
    __device__ __forceinline__ void pre(f32x4 (&)[2][2][4][2], const UnitD&, int, int, int, int) const {}
    bf16_t* P; const float* cosT; const float* sinT; const LAS float* rtab; int tab_pm;
    __device__ __forceinline__ bool operator()(f32x4 (&acc)[2][2][4][2], const UnitD& u, int wr, int wc, int fr, int fq) const {
        const int row0 = u.pm * 256 + wr * 64 + fr, col0 = u.pn * 256 + wc * 32 + 8 * fq;
        const int mode = (u.pn < 10) ? ((wc == 0) ? 1 : 0) : ((u.pn >= 20) ? 2 : 0);
#pragma unroll
        for (int ai = 0; ai < 2; ++ai)
#pragma unroll
            for (int m = 0; m < 4; ++m) {
                const int row = row0 + ai * 128 + m * 16;
                f32x4 v[2][2];
                const float rs = (u.pm == tab_pm) ? rtab[wr * 64 + fr + ai * 128 + m * 16] : __builtin_nanf("");
#pragma unroll
                for (int bj = 0; bj < 2; ++bj) { v[bj][0] = acc[ai][bj][m][0] * rs; v[bj][1] = acc[ai][bj][m][1] * rs; }
                if (mode == 1) {
                    const int pos = row & (SEQ - 1);
                    const f32x4 c = *(const f32x4*)(cosT + pos * 16 + 4 * fq), s = *(const f32x4*)(sinT + pos * 16 + 4 * fq);
#pragma unroll
                    for (int bj = 0; bj < 2; ++bj) { const f32x4 a = v[bj][0], b = v[bj][1]; v[bj][0] = a * c - b * s; v[bj][1] = b * c + a * s; }
                } else if (mode == 2) {
#pragma unroll
                    for (int bj = 0; bj < 2; ++bj)
#pragma unroll
                        for (int n = 0; n < 2; ++n)
#pragma unroll
                            for (int j = 0; j < 4; ++j) v[bj][n][j] = fast_sigmoid(v[bj][n][j]);
                }
                bf16_t* rowp = P + (size_t)row * NIN + col0;
#pragma unroll
                for (int bj = 0; bj < 2; ++bj) { u32x4 w; w.x = cvt_pk_bf16(v[bj][0][0], v[bj][0][1]); w.y = cvt_pk_bf16(v[bj][0][2], v[bj][0][3]); w.z = cvt_pk_bf16(v[bj][1][0], v[bj][1][1]); w.w = cvt_pk_bf16(v[bj][1][2], v[bj][1][3]);
                    *(u32x4*)(rowp + bj * 128) = w; }
            }
        return false;
    }
};
struct EpiInMix {
    static constexpr bool PERM = true, I8 = false, MIXED = true, PRE = true;
    bf16_t* P; const float* cosT; const float* sinT; const LAS float* rtab; int tab_pm; const float* sw; LAS float* scb;
    __device__ __forceinline__ void prefetch(const UnitD& u, int wid, int lane) const { asm volatile("" : "+v"(lane)); if (u.kind != 0 && wid < 4) __builtin_amdgcn_global_load_lds((const unsigned*)(sw + u.pn * 256 + wid * 64 + lane), (LAS unsigned*)(scb + u.slot * 256 + wid * 64), 4, 0, 0); }
    __device__ __forceinline__ void pre(i32x4 (&acc)[2][2][4][2], const UnitD& u, int wr, int wc, int fr, int fq) const {
        const int row0 = u.pm * 256 + wr * 64 + fr;
        const int mode = (u.pn < 10) ? ((wc == 0) ? 1 : 0) : ((u.pn >= 20) ? 2 : 0);
        if (mode == 1) {
            f32x4 c[8], sn[8];
#pragma unroll
            for (int q = 0; q < 8; ++q) { const int pos = (row0 + (q >> 2) * 128 + (q & 3) * 16) & (SEQ - 1); const unsigned to = (unsigned)(pos * 16 + 4 * fq) * 4u; c[q] = *(const f32x4*)((const char*)cosT + to); sn[q] = *(const f32x4*)((const char*)sinT + to); }
#pragma unroll
            for (int q = 0; q < 8; ++q)
#pragma unroll
                for (int bj = 0; bj < 2; ++bj) { const f32x4 a = __builtin_bit_cast(f32x4, acc[q >> 2][bj][q & 3][0]), b = __builtin_bit_cast(f32x4, acc[q >> 2][bj][q & 3][1]);
                    acc[q >> 2][bj][q & 3][0] = __builtin_bit_cast(i32x4, a * c[q] - b * sn[q]); acc[q >> 2][bj][q & 3][1] = __builtin_bit_cast(i32x4, b * c[q] + a * sn[q]); }
        }
    }
    __device__ __forceinline__ bool operator()(i32x4 (&acc)[2][2][4][2], const UnitD& u, int wr, int wc, int fr, int fq) const {
        const int row0 = u.pm * 256 + wr * 64 + fr, col0 = u.pn * 256 + wc * 32 + 8 * fq;
        const bool k8 = u.kind != 0;
        const int mode = (u.pn < 10) ? ((wc == 0) ? 1 : 0) : ((u.pn >= 20) ? 2 : 0);
        f32x4 sc[2][2];
#pragma unroll
        for (int bj = 0; bj < 2; ++bj)
#pragma unroll
            for (int n = 0; n < 2; ++n) sc[bj][n] = k8 ? *(const LAS f32x4*)(scb + u.slot * 256 + wc * 32 + 8 * fq + bj * 128 + 4 * n) : (f32x4){1.f, 1.f, 1.f, 1.f};
#pragma unroll
        for (int ai = 0; ai < 2; ++ai)
#pragma unroll
            for (int m = 0; m < 4; ++m) {
                const int row = row0 + ai * 128 + m * 16;
                f32x4 v[2][2];
                const float rs = (u.pm == tab_pm) ? rtab[(k8 ? 256 : 0) + wr * 64 + fr + ai * 128 + m * 16] : __builtin_nanf("");
#pragma unroll
                for (int bj = 0; bj < 2; ++bj)
#pragma unroll
                    for (int n = 0; n < 2; ++n) { const i32x4 a = acc[ai][bj][m][n];
                        const f32x4 f = k8 ? (f32x4){(float)a[0], (float)a[1], (float)a[2], (float)a[3]} : __builtin_bit_cast(f32x4, a);
                        v[bj][n] = f * (sc[bj][n] * rs); }
                if (mode == 2) {
#pragma unroll
                    for (int bj = 0; bj < 2; ++bj)
#pragma unroll
                        for (int n = 0; n < 2; ++n)
#pragma unroll
                            for (int j = 0; j < 4; ++j) v[bj][n][j] = fast_sigmoid(v[bj][n][j]);
                }
                bf16_t* rowp = P + (size_t)row * NIN + col0;
#pragma unroll
                for (int bj = 0; bj < 2; ++bj) { u32x4 w; w.x = cvt_pk_bf16(v[bj][0][0], v[bj][0][1]); w.y = cvt_pk_bf16(v[bj][0][2], v[bj][0][3]); w.z = cvt_pk_bf16(v[bj][1][0], v[bj][1][1]); w.w = cvt_pk_bf16(v[bj][1][2], v[bj][1][3]);
                    *(u32x4*)(rowp + bj * 128) = w; }
            }
        return false;
    }
};
struct SchedInMix {
    static constexpr int NBA = (PN8 == 20) ? 3 : 2, NBB = (PN8 == 20) ? 2 : 1, NIA = (PN8 == 20) ? 3 : 4, NIB = (PN8 == 20) ? 5 : 6;
    static_assert(4 * NBA + 4 * NBB == PN8 && 4 * NIA + 4 * NIB == NIN / 256 - PN8 && 2 * NBA + NIA == 2 * NBB + NIB, "balanced deal");
    int pm, j; const char* Ab; const char* Aq; const char* Bb; const char* Bq;
    __device__ __forceinline__ void init(int bx) { const int x = bx & 7, w = bx >> 3; pm = 8 * (x >> 1) + (w & 7); j = 4 * (x & 1) + (w >> 3); }
    __device__ __forceinline__ bool next(int i, UnitD& u) const {
        const int nb = j < 4 ? NBA : NBB, ni = j < 4 ? NIA : NIB;
        if (i >= nb + ni) return false;
        const bool k8 = i >= nb;
        const int pn = k8 ? PN8 + (j < 4 ? j * NIA : 4 * NIA + (j - 4) * NIB) + (i - nb) : (j < 4 ? j * NBA : 4 * NBA + (j - 4) * NBB) + i;
        u.pm = pm; u.pn = pn; u.kind = k8 ? 1 : 0; u.nt = k8 ? DM / 128 : DM / 64;
        u.A = (k8 ? Aq : Ab) + (size_t)pm * 256 * DM * 2; u.B = (k8 ? Bq : Bb) + (size_t)pn * (k8 ? 256 * DM : 256 * DM * 2);
        return true;
    }
};
struct EpiPool {
    static constexpr bool PERM = true, I8 = false, MIXED = false, PRE = false;
    __device__ __forceinline__ void pre(f32x4 (&)[2][2][4][2], const UnitD&, int, int, int, int) const {}
    bf16_t* O; const float* scale;
    __device__ __forceinline__ bool operator()(f32x4 (&acc)[2][2][4][2], const UnitD& u, int wr, int wc, int fr, int fq) const {
        const int row0 = u.pm * 256 + wr * 64 + fr, col0 = u.pn * 256 + wc * 32 + 8 * fq;
        f32x4 sc[2][2];
#pragma unroll
        for (int bj = 0; bj < 2; ++bj)
#pragma unroll
            for (int n = 0; n < 2; ++n) sc[bj][n] = *(const f32x4*)(scale + col0 + bj * 128 + 4 * n);
#pragma unroll
        for (int ai = 0; ai < 2; ++ai)
#pragma unroll
            for (int m = 0; m < 4; ++m) { bf16_t* rowp = O + (size_t)(row0 + ai * 128 + m * 16) * PW + col0;
#pragma unroll
                for (int bj = 0; bj < 2; ++bj) { const f32x4 v0 = acc[ai][bj][m][0] * sc[bj][0], v1 = acc[ai][bj][m][1] * sc[bj][1];
                    u32x4 w; w.x = cvt_pk_bf16(v0[0], v0[1]); w.y = cvt_pk_bf16(v0[2], v0[3]); w.z = cvt_pk_bf16(v1[0], v1[1]); w.w = cvt_pk_bf16(v1[2], v1[3]);
                    *(u32x4*)(rowp + bj * 128) = w; } }
        return false;
    }
};
struct EpiBranch {
    static constexpr bool PERM = true, I8 = false, MIXED = false, PRE = false;
    __device__ __forceinline__ void pre(f32x4 (&)[2][2][4][2], const UnitD&, int, int, int, int) const {}
    const bf16_t* P; bf16_t* O;
    __device__ __forceinline__ bool operator()(f32x4 (&acc)[2][2][4][2], const UnitD& u, int wr, int wc, int fr, int fq) const {
        const int row0 = u.pm * 256 + wr * 64 + fr, col0 = u.pn * 256 + wc * 32 + 8 * fq;
        if (u.kind == 0) {
#pragma unroll
            for (int ai = 0; ai < 2; ++ai)
#pragma unroll
                for (int mh = 0; mh < 2; ++mh) {
                    u32x4 ga[2][2], gb[2][2];
#pragma unroll
                    for (int mm = 0; mm < 2; ++mm)
#pragma unroll
                        for (int bj = 0; bj < 2; ++bj) { const bf16_t* rowp = P + (size_t)(row0 + ai * 128 + (2 * mh + mm) * 16) * NIN + col0 + bj * 128; ga[mm][bj] = *(const u32x4*)(rowp + C_GA); gb[mm][bj] = *(const u32x4*)(rowp + C_GB); }
#pragma unroll
                    for (int mm = 0; mm < 2; ++mm)
#pragma unroll
                        for (int bj = 0; bj < 2; ++bj) { const u32x4 a = ga[mm][bj], b = gb[mm][bj]; const int m = 2 * mh + mm;
                            f32x4 r0, r1;
                            r0[0] = bf_lo(a.x) * __builtin_amdgcn_rcpf(fmaxf(bf_lo(b.x), 1e-20f)); r0[1] = bf_hi(a.x) * __builtin_amdgcn_rcpf(fmaxf(bf_hi(b.x), 1e-20f));
                            r0[2] = bf_lo(a.y) * __builtin_amdgcn_rcpf(fmaxf(bf_lo(b.y), 1e-20f)); r0[3] = bf_hi(a.y) * __builtin_amdgcn_rcpf(fmaxf(bf_hi(b.y), 1e-20f));
                            r1[0] = bf_lo(a.z) * __builtin_amdgcn_rcpf(fmaxf(bf_lo(b.z), 1e-20f)); r1[1] = bf_hi(a.z) * __builtin_amdgcn_rcpf(fmaxf(bf_hi(b.z), 1e-20f));
                            r1[2] = bf_lo(a.w) * __builtin_amdgcn_rcpf(fmaxf(bf_lo(b.w), 1e-20f)); r1[3] = bf_hi(a.w) * __builtin_amdgcn_rcpf(fmaxf(bf_hi(b.w), 1e-20f));
                            acc[ai][bj][m][0] = acc[ai][bj][m][0] * r0; acc[ai][bj][m][1] = acc[ai][bj][m][1] * r1; }
                    asm volatile("" ::: "memory");
                }
            return true;
        }
#pragma unroll
        for (int ai = 0; ai < 2; ++ai) {
            u32x4 gb[4][2];
#pragma unroll
            for (int m = 0; m < 4; ++m)
#pragma unroll
                for (int bj = 0; bj < 2; ++bj) gb[m][bj] = *(const u32x4*)(P + (size_t)(row0 + ai * 128 + m * 16) * NIN + col0 + bj * 128 + C_GB);
#pragma unroll
            for (int m = 0; m < 4; ++m) { bf16_t* outp = O + (size_t)(row0 + ai * 128 + m * 16) * DM + col0;
#pragma unroll
                for (int bj = 0; bj < 2; ++bj) { const u32x4 b = gb[m][bj];
                    f32x4 s0, s1;
                    s0[0] = fmaxf(bf_lo(b.x), 1e-20f); s0[1] = fmaxf(bf_hi(b.x), 1e-20f); s0[2] = fmaxf(bf_lo(b.y), 1e-20f); s0[3] = fmaxf(bf_hi(b.y), 1e-20f);
                    s1[0] = fmaxf(bf_lo(b.z), 1e-20f); s1[1] = fmaxf(bf_hi(b.z), 1e-20f); s1[2] = fmaxf(bf_lo(b.w), 1e-20f); s1[3] = fmaxf(bf_hi(b.w), 1e-20f);
                    const f32x4 v0 = acc[ai][bj][m][0] * s0, v1 = acc[ai][bj][m][1] * s1;
                    u32x4 w; w.x = cvt_pk_bf16(v0[0], v0[1]); w.y = cvt_pk_bf16(v0[2], v0[3]); w.z = cvt_pk_bf16(v1[0], v1[1]); w.w = cvt_pk_bf16(v1[2], v1[3]);
                    *(u32x4*)(outp + bj * 128) = w; } }
            asm volatile("" ::: "memory");
        }
        return false;
    }
};
struct EpiRes {
    static constexpr bool PERM = true, I8 = false, MIXED = false, PRE = false;
    __device__ __forceinline__ void pre(f32x4 (&)[2][2][4][2], const UnitD&, int, int, int, int) const {}
    const float* xin32; const bf16_t* xb; bf16_t* xbo; float* xout32; float* part;
    __device__ __forceinline__ void finish(f32x4 (&acc)[2][2][4][2], int ai, int m, const f32x4 (&xi)[2][2], int row, size_t off, int fq, int slot) const {
        float ss = 0.f;
#pragma unroll
        for (int bj = 0; bj < 2; ++bj) { const f32x4 x0 = xi[bj][0] + acc[ai][bj][m][0], x1 = xi[bj][1] + acc[ai][bj][m][1];
            ss += (x0[0] * x0[0] + x0[1] * x0[1]) + (x0[2] * x0[2] + x0[3] * x0[3]) + (x1[0] * x1[0] + x1[1] * x1[1]) + (x1[2] * x1[2] + x1[3] * x1[3]);
            if (xout32) { *(f32x4*)(xout32 + off + bj * 128) = x0; *(f32x4*)(xout32 + off + bj * 128 + 4) = x1; }
            else { u32x4 w; w.x = cvt_pk_bf16(x0[0], x0[1]); w.y = cvt_pk_bf16(x0[2], x0[3]); w.z = cvt_pk_bf16(x1[0], x1[1]); w.w = cvt_pk_bf16(x1[2], x1[3]); *(u32x4*)(xbo + off + bj * 128) = w; } }
        ss += xchg<16>(ss); ss = sum32(ss);
        if (fq == 0) part[(size_t)row * 64 + slot] = ss;
    }
    __device__ __forceinline__ bool operator()(f32x4 (&acc)[2][2][4][2], const UnitD& u, int wr, int wc, int fr, int fq) const {
        const int row0 = u.pm * 256 + wr * 64 + fr, col0 = u.pn * 256 + wc * 32 + 8 * fq;
        if (xin32) {
#pragma unroll
            for (int ai = 0; ai < 2; ++ai)
#pragma unroll
                for (int mh = 0; mh < 2; ++mh) {
                    f32x4 xr[2][2][2];
#pragma unroll
                    for (int mm = 0; mm < 2; ++mm)
#pragma unroll
                        for (int bj = 0; bj < 2; ++bj) { const float* p = xin32 + (size_t)(row0 + ai * 128 + (2 * mh + mm) * 16) * DM + col0 + bj * 128; xr[mm][bj][0] = *(const f32x4*)p; xr[mm][bj][1] = *(const f32x4*)(p + 4); }
#pragma unroll
                    for (int mm = 0; mm < 2; ++mm) { const int m = 2 * mh + mm, row = row0 + ai * 128 + m * 16; finish(acc, ai, m, xr[mm], row, (size_t)row * DM + col0, fq, 4 * u.pn + wc); }
                    asm volatile("" ::: "memory");
                }
        } else {
#pragma unroll
            for (int ai = 0; ai < 2; ++ai) {
                u32x4 xw[4][2];
#pragma unroll
                for (int m = 0; m < 4; ++m)
#pragma unroll
                    for (int bj = 0; bj < 2; ++bj) xw[m][bj] = *(const u32x4*)(xb + (size_t)(row0 + ai * 128 + m * 16) * DM + col0 + bj * 128);
#pragma unroll
                for (int m = 0; m < 4; ++m) { const int row = row0 + ai * 128 + m * 16; f32x4 xi[2][2];
#pragma unroll
                    for (int bj = 0; bj < 2; ++bj) { const u32x4 w = xw[m][bj]; xi[bj][0] = (f32x4){bf_lo(w.x), bf_hi(w.x), bf_lo(w.y), bf_hi(w.y)}; xi[bj][1] = (f32x4){bf_lo(w.z), bf_hi(w.z), bf_lo(w.w), bf_hi(w.w)}; }
                    finish(acc, ai, m, xi, row, (size_t)row * DM + col0, fq, 4 * u.pn + wc); }
                asm volatile("" ::: "memory");
            }
        }
        return false;
    }
};
struct EpiGU {
    static constexpr bool PERM = true, I8 = false, MIXED = false, PRE = false;
    __device__ __forceinline__ void pre(f32x4 (&)[2][2][4][2], const UnitD&, int, int, int, int) const {}
    bf16_t* O; const LAS float* rtab; int tab_pm;
    __device__ __forceinline__ bool operator()(f32x4 (&acc)[2][2][4][2], const UnitD& u, int wr, int wc, int fr, int fq) const {
        const int row0 = u.pm * 256 + wr * 64 + fr, col0 = u.pn * 128 + wc * 32 + 8 * fq;
#pragma unroll
        for (int ai = 0; ai < 2; ++ai)
#pragma unroll
            for (int m = 0; m < 4; ++m) { f32x4 v[2]; const float rs = (u.pm == tab_pm) ? rtab[wr * 64 + fr + ai * 128 + m * 16] : __builtin_nanf("");
#pragma unroll
                for (int n = 0; n < 2; ++n)
#pragma unroll
                    for (int j = 0; j < 4; ++j) { const float g = acc[ai][0][m][n][j] * rs; v[n][j] = g * fast_sigmoid(g) * (acc[ai][1][m][n][j] * rs); }
                u32x4 w; w.x = cvt_pk_bf16(v[0][0], v[0][1]); w.y = cvt_pk_bf16(v[0][2], v[0][3]); w.z = cvt_pk_bf16(v[1][0], v[1][1]); w.w = cvt_pk_bf16(v[1][2], v[1][3]);
                *(u32x4*)(O + (size_t)(row0 + ai * 128 + m * 16) * FF + col0) = w; }
        return false;
    }
};
struct EpiGU8 {
    static constexpr bool PERM = true, I8 = true, MIXED = false, PRE = true;
    __device__ __forceinline__ void pre(i32x4 (&)[2][2][4][2], const UnitD&, int, int, int, int) const {}
    bf16_t* O; const LAS float* rtab; int tab_pm; const float* sw; LAS float* scb;
    __device__ __forceinline__ void prefetch(const UnitD& u, int wid, int lane) const { asm volatile("" : "+v"(lane)); if (wid < 4) __builtin_amdgcn_global_load_lds((const unsigned*)(sw + u.pn * 256 + wid * 64 + lane), (LAS unsigned*)(scb + u.slot * 256 + wid * 64), 4, 0, 0); }
    __device__ __forceinline__ bool operator()(i32x4 (&acc)[2][2][4][2], const UnitD& u, int wr, int wc, int fr, int fq) const {
        const int row0 = tab_pm * 256 + wr * 64 + fr, col0 = u.pn * 128 + wc * 32 + 8 * fq;
        const LAS float* swc = scb + u.slot * 256 + wc * 32 + 8 * fq;
        f32x4 sg[2], su[2];
        sg[0] = *(const LAS f32x4*)swc; sg[1] = *(const LAS f32x4*)(swc + 4); su[0] = *(const LAS f32x4*)(swc + 128); su[1] = *(const LAS f32x4*)(swc + 132);
#pragma unroll
        for (int ai = 0; ai < 2; ++ai)
#pragma unroll
            for (int m = 0; m < 4; ++m) { f32x4 v[2]; const float rs = rtab[wr * 64 + fr + ai * 128 + m * 16];
#pragma unroll
                for (int n = 0; n < 2; ++n)
#pragma unroll
                    for (int j = 0; j < 4; ++j) { const float g = (float)acc[ai][0][m][n][j] * (rs * sg[n][j]); v[n][j] = g * fast_sigmoid(g) * ((float)acc[ai][1][m][n][j] * (rs * su[n][j])); }
                u32x4 w; w.x = cvt_pk_bf16(v[0][0], v[0][1]); w.y = cvt_pk_bf16(v[0][2], v[0][3]); w.z = cvt_pk_bf16(v[1][0], v[1][1]); w.w = cvt_pk_bf16(v[1][2], v[1][3]);
                *(u32x4*)(O + (size_t)(row0 + ai * 128 + m * 16) * FF + col0) = w; }
        return false;
    }
};
}

namespace attn {
constexpr int D = 128, NW = 8, QBLK = 32, KVBLK = 64, QROWS = 64, WIN = 128;
constexpr int SHM_V = KVBLK * D * 2, SHM_K = KVBLK * D * 2;
constexpr int LDS_BYTES = 2 * SHM_V + 2 * SHM_K + NW * 64 * 4;
constexpr int LDQ = NIN, LDKV = NIN, LDO = AW;
constexpr float SCALE = 0.08838834764831845f;
constexpr float THR = 8.f;
#define KSWZ(row, colB) ((row) * 256 + ((colB) ^ (((row) & 7) << 4)))
#define SBAR() __builtin_amdgcn_sched_barrier(0)
__device__ __forceinline__ int v_st(int k, int c) { const int kk = (k & ~0xC) | ((k & 4) << 1) | ((k & 8) >> 1); return ((kk >> 3) * 4 + (c >> 5)) * 512 + ((kk & 7) * 32 + (c & 31)) * 2; }
__device__ __forceinline__ int v_rd_base(int lane) { return ((lane & 3) << 3) | (((lane >> 2) & 3) << 6) | (((lane >> 4) & 1) << 5) | (((lane >> 5) & 1) << 8); }
constexpr int v_rd_off(int d0, int ks, int half) { return d0 * 512 + ks * 4096 + half * 2048; }
__device__ __forceinline__ int crow(int r, int hi) { return (r & 3) + 8 * (r >> 2) + 4 * hi; }
__device__ __forceinline__ unsigned cvtpk(float lo, float hi) { unsigned r; asm volatile("v_cvt_pk_bf16_f32 %0, %1, %2" : "=v"(r) : "v"(lo), "v"(hi)); return r; }
__device__ __forceinline__ bf16x8 load8(const bf16_t* p) { return *reinterpret_cast<const bf16x8*>(p); }
__device__ __forceinline__ void mask_tile(f32x16& p0, f32x16& p1, int dq) {
    const float NEG = -__builtin_inff();
#pragma unroll
    for (int r = 0; r < 16; ++r) {
        const int c = (r & 3) + 8 * (r >> 2);
        if ((unsigned)(dq - c) >= (unsigned)(2 * WIN + 1)) p0[r] = NEG;
        if ((unsigned)(dq - c - 32) >= (unsigned)(2 * WIN + 1)) p1[r] = NEG;
    }
}
__device__ __forceinline__ void partialSM(f32x16& p0, f32x16& p1, float& m_reg, float& mn, float& alpha) {
    float pmax = p0[0]; for (int r = 1; r < 16; ++r) pmax = fmaxf(pmax, p0[r]); for (int r = 0; r < 16; ++r) pmax = fmaxf(pmax, p1[r]);
    { auto rr = __builtin_amdgcn_permlane32_swap(__float_as_uint(pmax), __float_as_uint(pmax), false, false);
      pmax = fmaxf(__uint_as_float(rr[0]), __uint_as_float(rr[1])); }
    constexpr float C2 = 1.4426950408889634f * SCALE;
    if (__builtin_expect(__all((pmax - m_reg) * SCALE <= THR), 1)) { mn = m_reg; alpha = 1.f; }
    else { mn = fmaxf(m_reg, pmax); alpha = __builtin_amdgcn_exp2f((m_reg - mn) * C2); m_reg = mn; }
    const float mnL = -mn * C2;
    for (int r = 0; r < 16; ++r) p0[r] = fmaf(p0[r], C2, mnL); for (int r = 0; r < 16; ++r) p1[r] = fmaf(p1[r], C2, mnL);
    for (int r = 0; r < 16; ++r) p0[r] = __builtin_amdgcn_exp2f(p0[r]);
}
__device__ __forceinline__ void finishSM(f32x16& p0, f32x16& p1, float alpha, float& l_reg, bf16x8& pa0, bf16x8& pa1, bf16x8& pa2, bf16x8& pa3) {
    for (int r = 0; r < 16; ++r) p1[r] = __builtin_amdgcn_exp2f(p1[r]);
    float ps = 0; for (int r = 0; r < 16; ++r) ps += p0[r]; for (int r = 0; r < 16; ++r) ps += p1[r];
    { auto rr = __builtin_amdgcn_permlane32_swap(__float_as_uint(ps), __float_as_uint(ps), false, false);
      ps = __uint_as_float(rr[0]) + __uint_as_float(rr[1]); }
    l_reg = l_reg * alpha + ps;
#define PK4(P, B_, OUT) do { unsigned a0 = cvtpk(P[B_+0], P[B_+1]), a1 = cvtpk(P[B_+2], P[B_+3]);                          \
        unsigned b0 = cvtpk(P[B_+4], P[B_+5]), b1 = cvtpk(P[B_+6], P[B_+7]);                                             \
        auto r0 = __builtin_amdgcn_permlane32_swap(a0, b0, false, false); auto r1 = __builtin_amdgcn_permlane32_swap(a1, b1, false, false); \
        u32x4 w = {r0[0], r1[0], r0[1], r1[1]}; OUT = *reinterpret_cast<bf16x8*>(&w); } while (0)
    PK4(p0, 0, pa0); PK4(p0, 8, pa1); PK4(p1, 0, pa2); PK4(p1, 8, pa3);
#undef PK4
}
template <int KB>
__device__ __forceinline__ void qkt(f32x16& p0, f32x16& p1, const char* K_lds, int r32, int hi, const char* q_lds, bool act) {
    if (!act) { const float NEG = -__builtin_inff();
#pragma unroll
        for (int r = 0; r < 16; ++r) { p0[r] = NEG; p1[r] = NEG; } return; }
    p0 = f32x16{}; p1 = f32x16{};
    const char* kb[4];
#pragma unroll
    for (int dd = 0; dd < 4; ++dd) kb[dd] = K_lds + KB * SHM_K + KSWZ(r32, (dd * 16 + hi * 8) * 2);
#pragma unroll
    for (int d0 = 0; d0 < 8; ++d0) { const char* a = kb[d0 & 3] + (d0 >> 2) * 128;
        bf16x8 b0 = *reinterpret_cast<const bf16x8*>(a);
        bf16x8 b1 = *reinterpret_cast<const bf16x8*>(a + 32 * 256);
        bf16x8 q = *reinterpret_cast<const bf16x8*>(q_lds + d0 * 1024);
        p0 = __builtin_amdgcn_mfma_f32_32x32x16_bf16(b0, q, p0, 0, 0, 0);
        p1 = __builtin_amdgcn_mfma_f32_32x32x16_bf16(b1, q, p1, 0, 0, 0); }
}
template <int VB>
__device__ __forceinline__ void pv_tile(f32x16* o, int vb0, bf16x8 pa0, bf16x8 pa1, bf16x8 pa2, bf16x8 pa3, bool act) {
    if (!act) return;
#define TRRD(dst, off) asm volatile("ds_read_b64_tr_b16 %0, %1 offset:%2" : "=&v"(dst) : "v"(vb0), "i"(off) : "memory")
#define PV_D0(d0) do { s16x4 l0, l1, l2, l3, h0, h1, h2, h3; constexpr int b_ = VB * SHM_V + v_rd_off(d0, 0, 0);   \
        TRRD(l0, b_); TRRD(h0, b_ + 2048); TRRD(l1, b_ + 4096); TRRD(h1, b_ + 6144); TRRD(l2, b_ + 8192); TRRD(h2, b_ + 10240); TRRD(l3, b_ + 12288); TRRD(h3, b_ + 14336); \
        asm volatile("s_waitcnt lgkmcnt(0)" ::: "memory"); SBAR();   \
        o[d0] = __builtin_amdgcn_mfma_f32_32x32x16_bf16(pa0, (bf16x8){l0[0], l0[1], l0[2], l0[3], h0[0], h0[1], h0[2], h0[3]}, o[d0], 0, 0, 0);   \
        o[d0] = __builtin_amdgcn_mfma_f32_32x32x16_bf16(pa1, (bf16x8){l1[0], l1[1], l1[2], l1[3], h1[0], h1[1], h1[2], h1[3]}, o[d0], 0, 0, 0);   \
        o[d0] = __builtin_amdgcn_mfma_f32_32x32x16_bf16(pa2, (bf16x8){l2[0], l2[1], l2[2], l2[3], h2[0], h2[1], h2[2], h2[3]}, o[d0], 0, 0, 0);   \
        o[d0] = __builtin_amdgcn_mfma_f32_32x32x16_bf16(pa3, (bf16x8){l3[0], l3[1], l3[2], l3[3], h3[0], h3[1], h3[2], h3[3]}, o[d0], 0, 0, 0); } while (0)
    PV_D0(0); PV_D0(1); PV_D0(2); PV_D0(3);
#undef PV_D0
#undef TRRD
}
struct BlockRef { const bf16_t* Q; const bf16_t* K; const bf16_t* V; bf16_t* O; int P0; const float* sink4; };
struct Seam { bf16x8 st_v0, st_v1, st_k0, st_k1; };
constexpr int LDS_Q = LDS_BYTES;
constexpr int LDS_TOTAL = LDS_Q + NW * 8192;
__device__ __forceinline__ int jlo_of(int P0) { const int lowk = P0 - WIN; return lowk > 0 ? lowk / KVBLK : 0; }
#define ROW(p, k0, rr) ((p) + (size_t)((k0) + (rr)) * LDKV + sc)
#define VMW() asm volatile("s_waitcnt vmcnt(0)" ::: "memory")
#define SLOAD_H(Kp, Vp, k0) do { S.st_v0 = load8(ROW(Vp, k0, sr)); S.st_v1 = load8(ROW(Vp, k0, 32 + sr));              \
                         S.st_k0 = load8(ROW(Kp, k0, sr)); S.st_k1 = load8(ROW(Kp, k0, 32 + sr)); } while (0)
#define SWRITE_HK(bf) do { *(bf16x8*)(K_lds + (bf) * SHM_K + kws) = S.st_k0; *(bf16x8*)(K_lds + (bf) * SHM_K + kws + 32 * 256) = S.st_k1; } while (0)
#define SWRITE_HV(bf) do { *(bf16x8*)(V_lds + (bf) * SHM_V + vst0) = S.st_v0; *(bf16x8*)(V_lds + (bf) * SHM_V + vst1) = S.st_v1; } while (0)
#define SWRITE_H(bf) do { SWRITE_HV(bf); SWRITE_HK(bf); } while (0)
__device__ __forceinline__ void attn_block(const int wave_, const BlockRef& cur, char* lds) {
    int tid = tid_of(wave_); asm volatile("" : "+v"(tid));
    const int wid = wave_, lane = tid & 63, r32 = lane & 31, hi = lane >> 5;
    const int j_lo = jlo_of(cur.P0);
    int j_hi = (cur.P0 + QROWS - 1 + WIN) / KVBLK + 1; if (j_hi > SEQ / KVBLK) j_hi = SEQ / KVBLK;
    const int NT = j_hi - j_lo;
    const int qlo = cur.P0 + (wid & 1) * QBLK, qm = qlo + r32 - 4 * hi + WIN;
    char* V_lds = lds; char* K_lds = lds + 2 * SHM_V;
    float* ws = (float*)(lds + 2 * SHM_V + 2 * SHM_K) + wid * 64; float* li_l = ws, * al_l = ws + 32;
    char* q_lds = lds + LDS_Q + wid * 8192 + lane * 16;
    float m_reg = cur.sink4[wid >> 1] * 11.313708498984761f, l_reg = 1.f; f32x16 o[4] = {};
    const int sr = tid >> 4, sc = (tid & 15) * 8, vst0 = v_st(sr, sc), vst1 = v_st(32 + sr, sc), kws = KSWZ(sr, sc * 2);
    const int vb0 = (int)(uintptr_t)V_lds + v_rd_base(lane);
    const bf16_t* Kh = cur.K; const bf16_t* Vh = cur.V;
    Seam S;
#define KBASE(t) ((j_lo + (t)) * KVBLK)
    {
        SLOAD_H(Kh, Vh, KBASE(0));
        bf16x8 qv[8];
#pragma unroll
        for (int d0 = 0; d0 < 8; ++d0) qv[d0] = load8(cur.Q + (size_t)((wid & 1) * QBLK + r32) * LDQ + (wid >> 1) * D + d0 * 16 + hi * 8);
        VMW();
#pragma unroll
        for (int d0 = 0; d0 < 8; ++d0) *reinterpret_cast<bf16x8*>(q_lds + d0 * 1024) = qv[d0];
        SWRITE_HK(0);
        __syncthreads();
    }
#define RESC(a) do { if (__any((a) < 1.f)) { if (hi == 0) al_l[r32] = (a); asm volatile("s_waitcnt lgkmcnt(0)" ::: "memory");              \
                     for (int d_ = 0; d_ < 4; ++d_) for (int r = 0; r < 16; ++r) o[d_][r] *= al_l[crow(r, hi)]; } } while (0)
#define ACT(t) (KBASE(t) <= qlo + QBLK - 1 + WIN && KBASE(t) + KVBLK - 1 >= qlo - WIN)
#define MASKT(P0_, P1_, t) do { const int kb_ = KBASE(t); if (ACT(t) && (kb_ + KVBLK - 1 > qlo + WIN || kb_ < qlo + QBLK - 1 - WIN)) mask_tile(P0_, P1_, qm - kb_); } while (0)
    f32x16 pA0, pA1, pB0, pB1; float mnA, mnB, alA, alB; bf16x8 pa0, pa1, pa2, pa3;
    SWRITE_HV(0); SBAR();
    if (NT > 1) { SLOAD_H(Kh, Vh, KBASE(1)); }
    SBAR(); qkt<0>(pA0, pA1, K_lds, r32, hi, q_lds, ACT(0));
    MASKT(pA0, pA1, 0); partialSM(pA0, pA1, m_reg, mnA, alA);
    if (NT > 1) { VMW(); SWRITE_H(1); }
    __syncthreads();
#define HALF_STEP(PX0, PX1, mnX, alX, PY0, PY1, alY, t, KB, VB, SB) do {                                                      \
        SBAR(); qkt<KB>(PX0, PX1, K_lds, r32, hi, q_lds, ACT(t));                                                \
        finishSM(PY0, PY1, alY, l_reg, pa0, pa1, pa2, pa3); SBAR();                                                           \
        if ((t) + 1 < NT) { SLOAD_H(Kh, Vh, KBASE((t) + 1)); SBAR(); }                                                         \
        pv_tile<VB>(o, vb0, pa0, pa1, pa2, pa3, ACT((t) - 1)); MASKT(PX0, PX1, (t)); partialSM(PX0, PX1, m_reg, mnX, alX);    \
        __syncthreads();                                                                                                      \
        if ((t) + 1 < NT) { VMW(); SWRITE_H(SB); }                                                                            \
        RESC(alX); __syncthreads(); } while (0)
    for (int t = 1; t + 1 < NT; t += 2) {
        HALF_STEP(pB0, pB1, mnB, alB, pA0, pA1, alA, t, 1, 0, 0);
        HALF_STEP(pA0, pA1, mnA, alA, pB0, pB1, alB, t + 1, 0, 1, 1);
    }
    const bool even = (NT & 1) == 0;
    if (even) { SBAR(); qkt<1>(pB0, pB1, K_lds, r32, hi, q_lds, ACT(NT - 1)); SBAR(); }
    finishSM(pA0, pA1, alA, l_reg, pa0, pa1, pa2, pa3); SBAR();
    pv_tile<0>(o, vb0, pa0, pa1, pa2, pa3, ACT(even ? NT - 2 : NT - 1));
    if (even) { MASKT(pB0, pB1, NT - 1); partialSM(pB0, pB1, m_reg, mnB, alB); __syncthreads(); RESC(alB);
        finishSM(pB0, pB1, alB, l_reg, pa0, pa1, pa2, pa3); SBAR(); pv_tile<1>(o, vb0, pa0, pa1, pa2, pa3, ACT(NT - 1)); }
    SBAR();
    if (hi == 0) li_l[r32] = l_reg; asm volatile("s_waitcnt lgkmcnt(0)" ::: "memory");
    float rli[16];
#pragma unroll
    for (int r = 0; r < 16; ++r) rli[r] = __builtin_amdgcn_rcpf(li_l[crow(r, hi)]);
    bf16_t* Ow = cur.O + (size_t)((wid & 1) * QBLK) * LDO + (wid >> 1) * D;
#pragma unroll
    for (int r = 0; r < 16; ++r) { const int orow = crow(r, hi);
#pragma unroll
        for (int d0 = 0; d0 < 4; ++d0) { const float v = o[d0][r] * rli[r];
            *(unsigned short*)(Ow + (size_t)orow * LDO + d0 * 32 + r32) = (unsigned short)cvtpk(v, v); } }
    __syncthreads();
#undef RESC
#undef KBASE
#undef ACT
#undef MASKT
#undef HALF_STEP
}
#undef ROW
#undef VMW
#undef SLOAD_H
#undef SWRITE_HK
#undef SWRITE_HV
#undef SWRITE_H
#undef KSWZ
#undef SBAR
}
static_assert(attn::LDS_TOTAL <= LDSCTL_OFF && pg8::STAGE_BYTES <= LDSCTL_OFF && MISC_OFF + 128 <= LDS_BYTES, "LDS map");

#define XB_TMO      128
#define XB_XCNT(j)  (256  + 64 * (j))
#define XB_XSUB(j)  (1280 + 64 * (j))
#define XB_XGEN(j)  (2304 + 64 * (j))
#define XB_TOP      3328
#define XB_TOPGEN   3392
#define XCD_BAR_WORDS 3456
#define XB_SPIN_CAP (1u << 18)

__device__ __forceinline__ unsigned xb_ld(unsigned* p)              { return __hip_atomic_load(p, __ATOMIC_RELAXED, __HIP_MEMORY_SCOPE_AGENT); }
__device__ __forceinline__ unsigned xb_add(unsigned* p, unsigned v) { return __hip_atomic_fetch_add(p, v, __ATOMIC_RELAXED, __HIP_MEMORY_SCOPE_AGENT); }
__device__ __forceinline__ unsigned xb_xcc_id() { return (unsigned)__builtin_amdgcn_s_getreg((3 << 11) | 20) & 0xFu; }
#define XB_SPIN(cond, bar) do { unsigned _sp = 0; while (cond) { __builtin_amdgcn_s_sleep(1); \
    if ((++_sp & 255u) == 0u) { if (xb_ld(&(bar)[XB_TMO])) break; if (_sp > XB_SPIN_CAP) { atomicAdd(&(bar)[XB_TMO], 1u); break; } } } } while (0)

struct XcdBarrier {
    unsigned* bar; unsigned x;
    volatile LAS unsigned* st;
    unsigned n;
};
__device__ __forceinline__ XcdBarrier xcd_barrier_post(unsigned* bar, volatile LAS unsigned* st, unsigned n) {
    XcdBarrier b; b.bar = bar; b.x = xb_xcc_id(); b.st = st; b.n = n;
    if (threadIdx.x == 0) (void)xb_add(&bar[XB_XCNT(b.x)], 1u);
    return b;
}
__device__ __forceinline__ void xcd_barrier_complete(unsigned* bar, unsigned x, unsigned& nloc, unsigned& nx, const unsigned G) {
    unsigned sum, cnt, mine, sp = 0u;
    for (;;) {
        sum = 0u; cnt = 0u; mine = 0u;
#pragma unroll
        for (unsigned j = 0; j < 16; ++j) { const unsigned c = xb_ld(&bar[XB_XCNT(j)]); sum += c; cnt += (c > 0u) ? 1u : 0u; mine = (j == x) ? c : mine; }
        if (sum == G) break;
        __builtin_amdgcn_s_sleep(1);
        if ((++sp & 255u) == 0u) { if (xb_ld(&bar[XB_TMO])) break; if (sp > XB_SPIN_CAP) { atomicAdd(&bar[XB_TMO], 1u); break; } }
    }
    nloc = mine > 0u ? mine : 1u; nx = cnt > 0u ? cnt : 1u;
}
__device__ __forceinline__ void xcd_barrier(const XcdBarrier& b, const int wave_) {
    asm volatile("s_waitcnt vmcnt(0)" ::: "memory");
    __syncthreads();
    int tid0 = tid_of(wave_); asm volatile("" : "+v"(tid0));
    if (tid0 == 0) {
        unsigned* bar = b.bar; const unsigned bx_ = xb_xcc_id();
        __builtin_amdgcn_s_waitcnt(0);
        unsigned nloc = b.st[0], nx = b.st[1];
        if (nloc == 0u) { xcd_barrier_complete(bar, bx_, nloc, nx, b.n); b.st[0] = nloc; b.st[1] = nx; }
        const unsigned old = xb_add(&bar[XB_XSUB(bx_)], 1u);
        const unsigned gen = old / nloc;
        if (old + 1u == (gen + 1u) * nloc) {
            __builtin_amdgcn_fence(__ATOMIC_RELEASE, "agent");
            asm volatile("s_waitcnt vmcnt(0)" ::: "memory");
            const unsigned og = xb_add(&bar[XB_TOP], 1u);
            const unsigned tg = og / nx;
            if (og + 1u == (tg + 1u) * nx) xb_add(&bar[XB_TOPGEN], 1u);
            else XB_SPIN(xb_ld(&bar[XB_TOPGEN]) == tg, bar);
            __builtin_amdgcn_fence(__ATOMIC_ACQUIRE, "agent");
            xb_add(&bar[XB_XGEN(bx_)], 1u);
            asm volatile("s_waitcnt vmcnt(0)" ::: "memory");
        } else {
            XB_SPIN(xb_ld(&bar[XB_XGEN(bx_)]) == gen, bar);
            __builtin_amdgcn_fence(__ATOMIC_ACQUIRE, "agent");
            asm volatile("s_waitcnt vmcnt(0)" ::: "memory");
        }
    }
    __syncthreads();
}


__device__ __forceinline__ float wave_sum(float v) {
    v += xchg<1>(v); v += xchg<2>(v); v += xchg<4>(v); v += xchg<8>(v); v += xchg<16>(v);
    return sum32(v);
}
__device__ __forceinline__ void cvt8_block(const float* W, int N, int n0, const float* gain, unsigned char* WT8, int map, float* scales, LAS float* cmx, int wave, int lane) {
    asm volatile("" : "+v"(lane));
    const int c = lane & 31, half = lane >> 5, slot = n0 + c;
    const float* wb = W + (size_t)(wave * 512) * N; const float* gb = gain + wave * 512;
    const unsigned loff = (unsigned)(32 * half * N + srccol(map, slot)) * 4u; const bool hi = half != 0;
    float gv[8];
#pragma unroll
    for (int it = 0; it < 8; ++it) gv[it] = gb[64 * it + lane];
    unsigned pk[8][16]; float mx = 0.f;
#pragma unroll
    for (int it = 0; it < 8; ++it)
#pragma unroll
        for (int h = 0; h < 2; ++h) { float w[16];
#pragma unroll
            for (int i = 0; i < 16; ++i) w[i] = *(const float*)((const char*)(wb + (size_t)(64 * it + 16 * h + i) * N) + loff);
#pragma unroll
            for (int i = 0; i < 16; ++i) { const int gi = __builtin_bit_cast(int, gv[it]); const float g0 = __builtin_bit_cast(float, __builtin_amdgcn_readlane(gi, 16 * h + i)), g1 = __builtin_bit_cast(float, __builtin_amdgcn_readlane(gi, 32 + 16 * h + i)); w[i] *= hi ? g1 : g0; }
#pragma unroll
            for (int i = 0; i < 8; ++i) { const unsigned p = cvt_pk_bf16(w[2 * i], w[2 * i + 1]); pk[it][8 * h + i] = p; mx = fmaxf(mx, fmaxf(fabsf(bf_lo(p)), fabsf(bf_hi(p)))); }
            asm volatile("" ::: "memory"); }
    mx = max32(mx);
    if (lane < 32) cmx[wave * 32 + lane] = mx;
    LDS_WAIT(); __syncthreads();
    float a = 0.f;
#pragma unroll
    for (int q = 0; q < 8; ++q) a = fmaxf(a, cmx[q * 32 + c]);
    const float inv = a > 0.f ? 127.0f / a : 0.f;
    if (wave == 0 && lane < 32) scales[destrow(slot)] = a * (1.0f / 127.0f);
    unsigned char* dp = WT8 + (size_t)(slot >> 8) * ((size_t)DM * 256) + (size_t)(4 * wave) * 32768 + img_seg(slot & 255, 0);
    const unsigned xs = (slot & 8) ? 32u : 0u;
#pragma unroll
    for (int it = 0; it < 8; ++it)
#pragma unroll
        for (int q = 0; q < 2; ++q) { unsigned o[4];
#pragma unroll
            for (int e = 0; e < 4; ++e) { unsigned p0 = pk[it][8 * q + 2 * e], p1 = pk[it][8 * q + 2 * e + 1]; asm volatile("" : "+v"(p0), "+v"(p1));
                o[e] = ((unsigned)(int)__builtin_rintf(bf_lo(p0) * inv) & 0xffu) | (((unsigned)(int)__builtin_rintf(bf_hi(p0) * inv) & 0xffu) << 8) | (((unsigned)(int)__builtin_rintf(bf_lo(p1) * inv) & 0xffu) << 16) | (((unsigned)(int)__builtin_rintf(bf_hi(p1) * inv) & 0xffu) << 24); }
            *(GAS u32x4*)(dp + (it >> 1) * 32768 + (it & 1) * 1024 + ((16u * (2 * half + q)) ^ xs)) = (u32x4){o[0], o[1], o[2], o[3]}; }
    __syncthreads();
}
struct CvtJob { int b0, n0, b1, n1, b2, n2; };
__device__ __forceinline__ int cvt_index(const CvtJob& J, int j) { return j < J.n0 ? J.b0 + j : (j < J.n0 + J.n1 ? J.b1 + (j - J.n0) : J.b2 + (j - J.n0 - J.n1)); }
template <unsigned KINDS>
__device__ __forceinline__ void cvt_run(const Args& args, unsigned char* wsp, const CvtJob& J, int w, int nw, int lane) {
    asm volatile("" : "+v"(lane));
    const int total = J.n0 + J.n1 + J.n2;
    for (int j = w; j < total; j += nw) { const CvtItem d = cvt_decode<KINDS>(args, wsp, cvt_index(J, j)); float wv[32];
        const float gl = cvtk_gain_load(d, lane);
        cvtk_load(d, wv, lane);
        asm volatile("" ::: "memory");
        cvtk_store(d, wv, gl, lane);
        asm volatile("" ::: "memory"); }
}
__device__ __forceinline__ void row_prologue(const float* xrow, bf16_t* xb, unsigned char* xq, float* rstd_out, float* rowf8_out, int lane) {
    asm volatile("" : "+v"(lane));
    const GAS f32x4* sp = (const GAS f32x4*)xrow + 4 * lane;
    f32x4 v[4][4]; float amax = 0.f, ss = 0.f;
#pragma unroll
    for (int j = 0; j < 4; ++j)
#pragma unroll
        for (int q = 0; q < 4; ++q) { v[j][q] = sp[256 * j + q];
#pragma unroll
            for (int e = 0; e < 4; ++e) { amax = fmaxf(amax, fabsf(v[j][q][e])); ss += v[j][q][e] * v[j][q][e]; } }
    amax = wave_max(amax);
    ss = wave_sum(ss);
    const float inv = amax > 0.f ? 127.0f / amax : 0.f;
    GAS u32x4* bp = (GAS u32x4*)xb + 2 * lane; GAS u32x4* qp = (GAS u32x4*)xq + lane;
#pragma unroll
    for (int j = 0; j < 4; ++j) { unsigned w[4];
#pragma unroll
        for (int q = 0; q < 4; ++q) { unsigned x = 0u;
#pragma unroll
            for (int e = 0; e < 4; ++e) { const int iv = (int)__builtin_rintf(v[j][q][e] * inv); x |= ((unsigned)iv & 0xffu) << (8 * e); }
            w[q] = x; }
        qp[64 * j] = (u32x4){w[0], w[1], w[2], w[3]};
        bp[128 * j] = (u32x4){cvt_pk_bf16(v[j][0][0], v[j][0][1]), cvt_pk_bf16(v[j][0][2], v[j][0][3]), cvt_pk_bf16(v[j][1][0], v[j][1][1]), cvt_pk_bf16(v[j][1][2], v[j][1][3])};
        bp[128 * j + 1] = (u32x4){cvt_pk_bf16(v[j][2][0], v[j][2][1]), cvt_pk_bf16(v[j][2][2], v[j][2][3]), cvt_pk_bf16(v[j][3][0], v[j][3][1]), cvt_pk_bf16(v[j][3][2], v[j][3][3])}; }
    if (lane == 0) { const float rstd = 1.0f / sqrtf(ss * (1.f / DM) + RMS_EPS); *rstd_out = rstd; *rowf8_out = rstd * amax * (1.0f / 127.0f); }
}
__device__ __forceinline__ void build_rstd_table(LAS float* tab, const float* part, int np, int pm, int wave, int lane, bool raw = false) {
    asm volatile("" : "+v"(lane));
    if (raw && np == 1) { if (lane < 32) tab[wave * 32 + lane] = part[pm * 256 + wave * 32 + lane]; LDS_WAIT(); __syncthreads(); return; }
    const float* p = part + (size_t)(pm * 256 + wave * 32) * np + lane;
#pragma unroll 8
    for (int r = 0; r < 32; ++r) { float v = (lane < np) ? p[(size_t)r * np] : 0.f; v = wave_sum(v); if (lane == 0) tab[wave * 32 + r] = raw ? v : 1.0f / sqrtf(v * (1.f / DM) + RMS_EPS); }
    LDS_WAIT(); __syncthreads();
}
struct QRow { u32x4 a[4], b[4]; };
__device__ __forceinline__ void quant_row_load(QRow& r, const bf16_t* src, int lane) {
    const GAS u32x4* sp = (const GAS u32x4*)src + 2 * lane;
#pragma unroll
    for (int j = 0; j < 4; ++j) { r.a[j] = sp[128 * j]; r.b[j] = sp[128 * j + 1]; }
}
__device__ __forceinline__ float quant_row_finish(const QRow& r, unsigned char* dst, int lane, float* ssq) {
    float v[4][16]; float amax = 0.f, ss = 0.f;
#pragma unroll
    for (int j = 0; j < 4; ++j) { const u32x4 a = r.a[j], b = r.b[j];
        v[j][0] = bf_lo(a.x); v[j][1] = bf_hi(a.x); v[j][2] = bf_lo(a.y); v[j][3] = bf_hi(a.y); v[j][4] = bf_lo(a.z); v[j][5] = bf_hi(a.z); v[j][6] = bf_lo(a.w); v[j][7] = bf_hi(a.w);
        v[j][8] = bf_lo(b.x); v[j][9] = bf_hi(b.x); v[j][10] = bf_lo(b.y); v[j][11] = bf_hi(b.y); v[j][12] = bf_lo(b.z); v[j][13] = bf_hi(b.z); v[j][14] = bf_lo(b.w); v[j][15] = bf_hi(b.w);
#pragma unroll
        for (int e = 0; e < 16; ++e) { amax = fmaxf(amax, fabsf(v[j][e])); ss += v[j][e] * v[j][e]; } }
    amax = wave_max(amax);
    if (ssq) *ssq = wave_sum(ss);
    const float inv = amax > 0.f ? 127.0f / amax : 0.f;
    GAS u32x4* dp = (GAS u32x4*)dst + lane;
#pragma unroll
    for (int j = 0; j < 4; ++j) { unsigned w[4];
#pragma unroll
        for (int q = 0; q < 4; ++q) { unsigned x = 0u;
#pragma unroll
            for (int e = 0; e < 4; ++e) { const int iv = (int)__builtin_rintf(v[j][4 * q + e] * inv); x |= ((unsigned)iv & 0xffu) << (8 * e); }
            w[q] = x; }
        dp[64 * j] = (u32x4){w[0], w[1], w[2], w[3]}; }
    return amax * (1.0f / 127.0f);
}
__device__ __forceinline__ float quant_row_i8(const bf16_t* src, unsigned char* dst, int lane, float* ssq) {
    asm volatile("" : "+v"(lane));
    QRow r; quant_row_load(r, src, lane); return quant_row_finish(r, dst, lane, ssq);
}
__device__ __forceinline__ void quant_rows_act(const bf16_t* XB, unsigned char* XQ, float* rstd_out  , float* rowf8_out, int m0, int m1, int step, int lane) {
    asm volatile("" : "+v"(lane));
#define QACT_FIN(R, m) do { float ssq; const float sc = quant_row_finish(R, XQ + (size_t)(m) * DM * 2, lane, &ssq); \
        if (lane == 0) { const float rstd = 1.0f / sqrtf(ssq * (1.f / DM) + RMS_EPS); if (rstd_out) rstd_out[m] = rstd; rowf8_out[m] = rstd * sc; } } while (0)
    int m = m0; if (m >= m1) return;
    QRow ra, rb; quant_row_load(ra, XB + (size_t)m * DM, lane);
    for (;;) {
        const int mb = m + step; const bool more_b = mb < m1;
        if (more_b) quant_row_load(rb, XB + (size_t)mb * DM, lane);
        QACT_FIN(ra, m);
        if (!more_b) break;
        const int ma = mb + step; const bool more_a = ma < m1;
        if (more_a) quant_row_load(ra, XB + (size_t)ma * DM, lane);
        QACT_FIN(rb, mb);
        if (!more_a) break;
        m = ma;
    }
#undef QACT_FIN
}
__device__ __forceinline__ void row_final_norm(const bf16_t* xrow, const float* g, float* orow, const float* part64, int lane, bool poison) {
    asm volatile("" : "+v"(lane));
    const GAS u32x4* xr = (const GAS u32x4*)xrow + lane; const GAS f32x4* gr = (const GAS f32x4*)g + 2 * lane;
    float rstd = 1.0f / sqrtf(wave_sum(part64[lane]) * (1.f / DM) + RMS_EPS);
    if (poison) rstd = __builtin_nanf("");
    GAS f32x4* o4 = (GAS f32x4*)orow + 2 * lane;
#pragma unroll
    for (int j = 0; j < 8; ++j) { const u32x4 w = xr[64 * j]; const f32x4 g0 = gr[128 * j], g1 = gr[128 * j + 1];
        o4[128 * j] = (f32x4){bf_lo(w.x), bf_hi(w.x), bf_lo(w.y), bf_hi(w.y)} * rstd * g0; o4[128 * j + 1] = (f32x4){bf_lo(w.z), bf_hi(w.z), bf_lo(w.w), bf_hi(w.w)} * rstd * g1; }
}
__device__ __forceinline__ void sincos_tab(float ang, float& c, float& s) {
    const double a = (double)ang;
    const double k = __builtin_rint(a * 0.63661977236758134308);
    const double r = __builtin_fma(-k, 6.12323399573676603587e-17, __builtin_fma(-k, 1.57079632679489655800, a));
    const double r2 = r * r;
    double sp = -1.0 / 1307674368000.0; sp = sp * r2 + 1.0 / 6227020800.0; sp = sp * r2 - 1.0 / 39916800.0; sp = sp * r2 + 1.0 / 362880.0; sp = sp * r2 - 1.0 / 5040.0; sp = sp * r2 + 1.0 / 120.0; sp = sp * r2 - 1.0 / 6.0; sp = sp * r2 + 1.0;
    const double sn = sp * r;
    double cp = 1.0 / 20922789888000.0; cp = cp * r2 - 1.0 / 87178291200.0; cp = cp * r2 + 1.0 / 479001600.0; cp = cp * r2 - 1.0 / 3628800.0; cp = cp * r2 + 1.0 / 40320.0; cp = cp * r2 - 1.0 / 720.0; cp = cp * r2 + 1.0 / 24.0; cp = cp * r2 - 0.5; cp = cp * r2 + 1.0;
    const int q = ((int)k) & 3;
    const double cs = (q == 0) ? cp : (q == 1) ? -sn : (q == 2) ? -cp : sn;
    const double ss = (q == 0) ? sn : (q == 1) ? cp : (q == 2) ? -sn : -cp;
    c = (float)cs; s = (float)ss;
}
__device__ __forceinline__ float inv_freq_of(int i) {
    switch (i) {
        case 0: return 0x1.000000p+0f; case 1: return 0x1.c2ef78p-2f; case 2: return 0x1.8d2760p-3f; case 3: return 0x1.5dc95ap-4f;
        case 4: return 0x1.341190p-5f; case 5: return 0x1.0f5386p-6f; case 6: return 0x1.ddee9ep-8f; case 7: return 0x1.a4ee40p-9f;
        case 8: return 0x1.72ba42p-10f; case 9: return 0x1.46831ap-11f; case 10: return 0x1.1f91f0p-12f; case 11: return 0x1.fa8b86p-14f;
        case 12: return 0x1.be218cp-15f; case 13: return 0x1.88ec20p-16f; case 14: return 0x1.5a0f4ep-17f; default: return 0x1.30c94ep-18f;
    }
}

template <int W>
__device__ __forceinline__ void pool_rows(const bf16_t* PROJ, bf16_t* POOLED, int row, int ch8) {
    constexpr int H = W / 2;
    {
        const int t = row & (SEQ - 1);
        const bf16_t* base = PROJ + (size_t)(row - t) * NIN + C_U + ch8 * 8;
        u32x4 wv[W];
#pragma unroll
        for (int i = 0; i < W; ++i) { const int j = t - H + i, jc = j < 0 ? 0 : (j > SEQ - 1 ? SEQ - 1 : j); wv[i] = *(const u32x4*)(base + (size_t)jc * NIN); }
        asm volatile("" ::: "memory");
        float a[8] = {0.f, 0.f, 0.f, 0.f, 0.f, 0.f, 0.f, 0.f};
#pragma unroll
        for (int i = 0; i < W; ++i) { const u32x4 w = wv[i]; const float m = ((unsigned)(t - H + i) < (unsigned)SEQ) ? 1.f : 0.f;
            a[0] = fmaf(bf_lo(w.x), m, a[0]); a[1] = fmaf(bf_hi(w.x), m, a[1]); a[2] = fmaf(bf_lo(w.y), m, a[2]); a[3] = fmaf(bf_hi(w.y), m, a[3]);
            a[4] = fmaf(bf_lo(w.z), m, a[4]); a[5] = fmaf(bf_hi(w.z), m, a[5]); a[6] = fmaf(bf_lo(w.w), m, a[6]); a[7] = fmaf(bf_hi(w.w), m, a[7]); }
        const u32x4 own = wv[H];
        const int lo = (t - H) > 0 ? (t - H) : 0, hi = (t + H - 1) < (SEQ - 1) ? (t + H - 1) : (SEQ - 1);
        const float inv = 1.0f / (float)(hi - lo + 1);
        u32x4 o; o.x = cvt_pk_bf16(a[0] * inv - bf_lo(own.x), a[1] * inv - bf_hi(own.x)); o.y = cvt_pk_bf16(a[2] * inv - bf_lo(own.y), a[3] * inv - bf_hi(own.y));
        o.z = cvt_pk_bf16(a[4] * inv - bf_lo(own.z), a[5] * inv - bf_hi(own.z)); o.w = cvt_pk_bf16(a[6] * inv - bf_lo(own.w), a[7] * inv - bf_hi(own.w));
        *(u32x4*)(POOLED + (size_t)row * PW + ch8 * 8) = o;
    }
}

__global__ void __launch_bounds__(NWAVES * 64, 2) fwd_kernel(Args args_k) {
    extern __shared__ __attribute__((aligned(16))) unsigned char lds[];
    LAS unsigned char* const L = (LAS unsigned char*)lds;
    volatile LAS unsigned* const MISC = (volatile LAS unsigned*)(L + MISC_OFF);
    const int wave = __builtin_amdgcn_readfirstlane((int)threadIdx.x >> 6);
#define OPAQUE_TID() int tid = tid_of(wave); asm volatile("" : "+v"(tid)); const int lane = tid & 63; (void)lane
    const int G = gridDim.x; const int bx = blockIdx.x; const int vcu = ((G & 7) == 0) ? (bx & 7) * (G >> 3) + (bx >> 3) : bx;
    unsigned char* const ws = args_k.ws;
#if defined(__HIP_DEVICE_COMPILE__)
#define LOAD_ARGS() const __attribute__((address_space(4))) unsigned long long* ap_ = (const __attribute__((address_space(4))) unsigned long long*)__builtin_amdgcn_kernarg_segment_ptr(); asm volatile("" : "+s"(ap_)); \
    Args args; { static_assert(sizeof(Args) == 15 * 8, "Args"); unsigned long long* ad_ = (unsigned long long*)&args; _Pragma("unroll") for (int i_ = 0; i_ < 15; ++i_) ad_[i_] = ap_[i_]; }
#else
#define LOAD_ARGS() const Args args = args_k
#endif
    gu32* const ctl = (gu32*)(ws + WS_CTL);
    for (int u = threadIdx.x; u < (LDS_BYTES - LDSCTL_OFF) / 4; u += NWAVES * 64) ((LAS unsigned*)(L + LDSCTL_OFF))[u] = 0u;
    __syncthreads();
    const XcdBarrier bar = xcd_barrier_post((unsigned*)(ctl + CW_BAR), MISC + 8, (unsigned)G);
    if (G != 256) return;
    constexpr bool grouped = true;
    static_assert(DEPTH == 2, "the background conversion streams are laid out for two layers");
    const int gsh = grouped ? 2 : 0, grp = grouped ? ((bx & 7) >> 1) : 0, gsz = G >> gsh, rank = grouped ? ((bx & 1) * 32 + (bx >> 3)) : vcu;
    XcdBarrier sbar = bar;
    if (grouped) sbar = xcd_barrier_post((unsigned*)(ctl + CW_GBAR + grp * GBAR_STRIDE), MISC + 10, 64u);
#define GRID_BAR() xcd_barrier(bar, wave)
#define SEAM_BAR() xcd_barrier(sbar, wave)
    int bgk = 0;
#define BG_POST(k) do { int t0_ = tid_of(wave); asm volatile("" : "+v"(t0_)); if (rank == 0 && t0_ == 0) (void)xb_add((unsigned*)(ctl + CW_DONE + 64 * (k)), 1u); } while (0)
#define BG_WAIT(k) do { int t0_ = tid_of(wave); asm volatile("" : "+v"(t0_)); if (t0_ == 0) { unsigned* p_ = (unsigned*)(ctl + CW_DONE + 64 * (k)); XB_SPIN(xb_ld(p_) < 4u, (unsigned*)(ctl + CW_BAR)); \
        __builtin_amdgcn_fence(__ATOMIC_ACQUIRE, "agent"); asm volatile("s_waitcnt vmcnt(0)" ::: "memory"); } __syncthreads(); } while (0)
#define BG_JOB(base_, n_) const BgJob bgj{&args, wsp, (base_), (n_), gw, NGW}
    const int gw = vcu * NWAVES + wave, NGW = G * NWAVES;
    const int NGT = G * NWAVES * 64;
    const int sw = rank * NWAVES + wave, NSW = gsz * NWAVES;
    const int NST = gsz * NWAVES * 64;
    const int nrow_g = M >> gsh, row_g0 = grp * nrow_g;

#define OPAQUE_WS() LOAD_ARGS(); GAS unsigned char* wsg_ = (GAS unsigned char*)args.ws; asm volatile("" : "+s"(wsg_)); unsigned char* wsp = (unsigned char*)wsg_;     int bxo = blockIdx.x; asm volatile("" : "+s"(bxo)); (void)bxo;     \
    float* const cosT = (float*)(wsp + WS_ROT); float* const sinT = cosT + SEQ * 16; bf16_t* const XB = (bf16_t*)(wsp + WS_H); float* const SSQ = (float*)(wsp + WS_CTL) + CW_SSQ; \
    bf16_t* const PROJ = (bf16_t*)(wsp + WS_PROJ); bf16_t* const ATTO = (bf16_t*)(wsp + WS_ATTO); bf16_t* const POOLED = (bf16_t*)(wsp + WS_POOLED); bf16_t* const MIXED = (bf16_t*)(wsp + WS_MIXED); \
    bf16_t* const MERGED = (bf16_t*)(wsp + WS_MERGED); float* const X = (float*)(wsp + WS_X); bf16_t* const ACT = (bf16_t*)(wsp + WS_ACT); float* const PART = (float*)(wsp + WS_PART); unsigned char* const XQ = wsp + WS_XQ; float* const ROWS = (float*)(wsp + WS_ROWS); unsigned char* const wl = wsp + WS_W + (size_t)l * W_LAYER; \
    (void)cosT; (void)sinT; (void)XB; (void)SSQ; (void)PROJ; (void)ATTO; (void)POOLED; (void)MIXED; (void)MERGED; (void)X; (void)ACT; (void)PART; (void)XQ; (void)ROWS; (void)wl

    {
        LOAD_ARGS(); GAS unsigned char* wsg_ = (GAS unsigned char*)args.ws; asm volatile("" : "+s"(wsg_)); unsigned char* wsp = (unsigned char*)wsg_;
        float* const cosT = (float*)(wsp + WS_ROT); float* const sinT = cosT + SEQ * 16; bf16_t* const XB = (bf16_t*)(wsp + WS_H); float* const SSQ = (float*)(wsp + WS_CTL) + CW_SSQ;
        REPEAT(0) { OPAQUE_TID(); const CvtJob J = CvtJob{0, I_IN, IO_DN, I_DN, I_LAYER + IO_DN, I_DN}; cvt_run<65u>(args, wsp, J, gw, NGW, lane); }
        { constexpr int NBG = (NIN - PN8 * 256) / 32, NBU = NGU / 32, NBL = NBG + NBU;
          OPAQUE_TID();
          for (int b = vcu; b < DEPTH * NBL; b += G) { const int l = b / NBL, r = b - l * NBL; const bool gt8 = r < NBG;
            cvt8_block(gt8 ? args.in[2] + (size_t)l * DM * NIN : args.in[10] + (size_t)l * DM * NGU, gt8 ? NIN : NGU, gt8 ? PN8 * 256 + 32 * r : 32 * (r - NBG), (gt8 ? args.in[1] : args.in[9]) + (size_t)l * DM,
                       gt8 ? wsp + WS_WQI + (size_t)l * WQI_LAYER : wsp + WS_WQ + (size_t)l * WQ_LAYER, gt8 ? 0 : 2, gt8 ? (float*)(wsp + WS_SWI) + (size_t)l * NIN : (float*)(wsp + WS_SW) + (size_t)l * NGU,
                       (LAS float*)(L + RING_BYTES), wave, lane); } }
        { OPAQUE_TID();
        for (int e = vcu * (NWAVES * 64) + tid; e < SEQ * 16; e += NGT) { const int pos = e >> 4, i = e & 15; float c, s; sincos_tab((float)pos * inv_freq_of(i), c, s); cosT[e] = c; sinT[e] = s; }
        { unsigned char* const XQ = wsp + WS_XQ; float* const ROWS = (float*)(wsp + WS_ROWS);
          for (int m = gw; m < M; m += NGW) row_prologue(args.in[0] + (size_t)m * DM, XB + (size_t)m * DM, XQ + (size_t)m * DM * 2, ROWS + m, ROWS + M + m, lane); } }
    }
    GRID_BAR();

#ifdef STAGGER_US
    if (grouped && grp > 0) { const unsigned long long t0 = __builtin_amdgcn_s_memrealtime(); while (__builtin_amdgcn_s_memrealtime() - t0 < (unsigned long long)(grp * STAGGER_US * 100)) __builtin_amdgcn_s_sleep(8); }
#endif
    for (int l = 0; l < DEPTH; ++l) {
        REPEAT(1) {
        {
            OPAQUE_WS();
            LAS float* const rtab = (LAS float*)(L + RING_BYTES);
            if (l > 0) { { OPAQUE_TID(); int swo = sw; asm volatile("" : "+s"(swo)); quant_rows_act(XB, XQ, ROWS, ROWS + M, row_g0 + swo, row_g0 + nrow_g, NSW, lane); }
            SEAM_BAR(); }
            if (grouped) {
                pg8::SchedInMix S; S.init(bxo); S.Ab = (const char*)XB; S.Aq = (const char*)XQ; S.Bb = (const char*)(wl + WO_IN); S.Bq = (const char*)(wsp + WS_WQI + (size_t)l * WQI_LAYER);
                { OPAQUE_TID(); build_rstd_table(rtab, ROWS, 1, S.pm, wave, lane, true); build_rstd_table(rtab + 256, ROWS + M, 1, S.pm, wave, lane, true); }
                pg8::EpiInMix E{PROJ, cosT, sinT, rtab, S.pm, (const float*)(wsp + WS_SWI) + (size_t)l * NIN, (LAS float*)(L + RING_BYTES + 2048)};
                if (l == 0) bgk = 0;
                BG_JOB(l == 0 ? IO_POOL : I_LAYER + IO_DN, l == 0 ? IO_DN - IO_POOL : 0);
                pg8::gemm_phase<pg8::EpiInMix, pg8::SchedInMix, BgOn<94u>>(wave, L, DM, S, E, &bgj, &bgk);
                { OPAQUE_TID(); bg_drain<94u>(bgj, bgk, lane); }
            } else {
                pg8::SchedPlain S; S.T.init(M / 256, NIN / 256, G, bxo); S.A = (const char*)XB; S.B = (const char*)(wl + WO_IN); S.tA = (size_t)256 * DM * 2; S.tB = (size_t)256 * DM * 2; S.nt = DM / 64;
                int tab_pm = -1;
                { pg8::UnitD u0; if (S.next(0, u0)) { OPAQUE_TID(); tab_pm = u0.pm; build_rstd_table(rtab, ROWS, 1, tab_pm, wave, lane, true); } }
                pg8::EpiIn E{PROJ, cosT, sinT, rtab, tab_pm};
                pg8::gemm_phase<pg8::EpiIn, pg8::SchedPlain>(wave, L, DM, S, E);
            }
        }
        SEAM_BAR(); BG_POST(l == 0 ? 0 : 3); }
        REPEAT(2) {
        {
            OPAQUE_WS();
            const float* sink = args.in[3] + l * NHEAD;
            constexpr int NITEMS = BATCH * NHEAD * (SEQ / 256);
            for (int Li = grp * (NITEMS >> gsh) + rank; Li < (grp + 1) * (NITEMS >> gsh); Li += gsz) {
                const int qc_ = Li & 31, kh_ = (Li >> 5) & 3, b_ = Li >> 7; const size_t r0_ = (size_t)b_ * SEQ;
                attn::BlockRef cur;
                cur.Q = PROJ + (r0_ + qc_ * 64) * NIN + C_Q + kh_ * 4 * HD; cur.K = PROJ + r0_ * NIN + C_K + kh_ * HD; cur.V = PROJ + r0_ * NIN + C_V + kh_ * HD;
                cur.O = ATTO + (r0_ + qc_ * 64) * AW + kh_ * 4 * HD; cur.P0 = qc_ * 64; cur.sink4 = sink + kh_ * 4;
                attn::attn_block(wave, cur, (char*)lds);
            }
            { OPAQUE_TID(); int swo = sw; asm volatile("" : "+s"(swo));
              for (int p = swo; p < nrow_g * 4; p += NSW) { const int row = row_g0 + (p >> 2), g = p & 3, ch8 = g * 64 + lane;
                if (g == 0) pool_rows<2>(PROJ, POOLED, row, ch8); else if (g == 1) pool_rows<4>(PROJ, POOLED, row, ch8); else if (g == 2) pool_rows<8>(PROJ, POOLED, row, ch8); else pool_rows<16>(PROJ, POOLED, row, ch8); } }
        }
        SEAM_BAR(); if (l == 0) BG_WAIT(0); }
        REPEAT(3) {
        {
            OPAQUE_WS();
            pg8::SchedPool S; S.T.init(M / 256, PW / 256, G, bxo); S.A = (const char*)POOLED; S.B = (const char*)(wl + WO_POOL); S.tA = (size_t)256 * PW * 2; S.tB = (size_t)256 * 512 * 2; S.nt = 512 / 64;
            pg8::EpiPool E{MIXED, args.in[5] + (size_t)l * PW};
            if (l == 0) bgk = 0;
            BG_JOB(IO_DN, 0);
            pg8::gemm_phase<pg8::EpiPool, pg8::SchedPool, BgOn<64u>>(wave, L, PW, S, E, &bgj, &bgk);
        }
        SEAM_BAR(); }
        REPEAT(4) {
        {
            OPAQUE_WS();
            pg8::SchedBranch S; S.T.init(M / 256, DM / 256, G, bxo); S.A1 = (const char*)ATTO; S.B1 = (const char*)(wl + WO_BA); S.A2 = (const char*)MIXED; S.B2 = (const char*)(wl + WO_BP);
            S.tA = (size_t)256 * AW * 2; S.tB = (size_t)256 * AW * 2; S.nt = AW / 64;
            pg8::EpiBranch E{PROJ, MERGED};
            BG_JOB(IO_DN, 0);
            pg8::gemm_phase<pg8::EpiBranch, pg8::SchedBranch, BgOn<64u>>(wave, L, AW, S, E, &bgj, &bgk);
        }
        SEAM_BAR(); }
        REPEAT(5) {
        {
            OPAQUE_WS();
            pg8::SchedPlain S; S.T.init(M / 256, DM / 256, G, bxo); S.A = (const char*)MERGED; S.B = (const char*)(wl + WO_OUT); S.tA = (size_t)256 * DM * 2; S.tB = (size_t)256 * DM * 2; S.nt = DM / 64;
            const bool dry = ((REPMASK >> 5) & 1) && rep_ == 0;
            pg8::EpiRes E{l == 0 ? args.in[0] : nullptr, XB, dry ? (bf16_t*)(wsp + WS_END) : XB, nullptr, PART + (size_t)(dry ? 4 : 2 * l) * M * 64};
            BG_JOB(IO_DN, 0);
            pg8::gemm_phase<pg8::EpiRes, pg8::SchedPlain, BgOn<64u>>(wave, L, DM, S, E, &bgj, &bgk);
            { OPAQUE_TID(); bg_drain<64u>(bgj, bgk, lane); }
        }
        SEAM_BAR(); if (l == 0) BG_POST(1); }
        REPEAT(7) {
        {
            OPAQUE_WS();
            { OPAQUE_TID(); int swo = sw; asm volatile("" : "+s"(swo)); quant_rows_act(XB, XQ, nullptr, ROWS + M, row_g0 + swo, row_g0 + nrow_g, NSW, lane); }
            SEAM_BAR();
            pg8::SchedPlain S; S.T.init(M / 256, NGU / 256, G, bxo); S.A = (const char*)XQ; S.B = (const char*)(wsp + WS_WQ + (size_t)l * WQ_LAYER); S.tA = (size_t)256 * DM * 2; S.tB = (size_t)256 * DM; S.nt = DM / 128;
            LAS float* const rtab = (LAS float*)(L + RING_BYTES);
            int tab_pm = -1;
            { pg8::UnitD u0; if (S.next(0, u0)) { OPAQUE_TID(); tab_pm = u0.pm; build_rstd_table(rtab, ROWS + M, 1, tab_pm, wave, lane, true); } }
            pg8::EpiGU8 E{ACT, rtab, tab_pm, (const float*)(wsp + WS_SW) + (size_t)l * NGU, (LAS float*)(L + RING_BYTES + 2048)};
            if (l == 0) bgk = 0;
            BG_JOB(I_LAYER, l == 0 ? IO_DN : 0);
            pg8::gemm_phase<pg8::EpiGU8, pg8::SchedPlain, BgOn<31u>>(wave, L, DM, S, E, &bgj, &bgk);
            { OPAQUE_TID(); bg_drain<31u>(bgj, bgk, lane); }
        }
        SEAM_BAR(); if (l == 0) { BG_POST(2); BG_WAIT(1); } else BG_WAIT(3); }
        REPEAT(8) {
        {
            OPAQUE_WS();
            pg8::SchedPlain S; S.T.init(M / 256, DM / 256, G, bxo); S.A = (const char*)ACT; S.B = (const char*)(wl + WO_DN); S.tA = (size_t)256 * FF * 2; S.tB = (size_t)256 * FF * 2; S.nt = FF / 64;
            const bool dry = ((REPMASK >> 8) & 1) && rep_ == 0;
            pg8::EpiRes E{nullptr, XB, dry ? (bf16_t*)(wsp + WS_END) : XB, nullptr, PART + (size_t)(dry ? 4 : 2 * l + 1) * M * 64};
            if (l == 0) bgk = 0;
            BG_JOB(I_LAYER + IO_DN, 0);
            pg8::gemm_phase<pg8::EpiRes, pg8::SchedPlain, BgOn<64u>>(wave, L, FF, S, E, &bgj, &bgk);
        }
        SEAM_BAR(); if (l == 0) BG_WAIT(2); }
        if (l + 1 == DEPTH) {
            OPAQUE_WS(); OPAQUE_TID();
            const bool poison = (xb_ld((unsigned*)(ctl + CW_BAR) + XB_TMO) | xb_ld(sbar.bar + XB_TMO)) != 0u;
            const float* pq = PART + (size_t)(2 * DEPTH - 1) * M * 64;
            for (int m = row_g0 + sw; m < row_g0 + nrow_g; m += NSW) row_final_norm(XB + (size_t)m * DM, args.in[12], args.out + (size_t)m * DM, pq + (size_t)m * 64, lane, poison);
        }
    }
#undef GRID_BAR
#undef SEAM_BAR
#undef BG_POST
#undef BG_WAIT
#undef BG_JOB
#undef OPAQUE_WS
#undef OPAQUE_TID
}

extern "C" void kernel_launch(void* const* d_in, const int* in_sizes, int n_in, void* d_out, int out_size, void* d_ws, size_t ws_size, hipStream_t stream) {
    static int grid = 0;
    if (grid == 0) {
        if (n_in != 13 || in_sizes[0] != M * DM || out_size != M * DM || ws_size < WS_END + 64 * MiB) {
            fprintf(stderr, "kernel_launch: unexpected shapes (n_in %d, in0 %d, out %d, ws %zu, need %zu); nothing launched\n", n_in, n_in > 0 ? in_sizes[0] : -1, out_size, ws_size, (size_t)WS_END); grid = -1; return; }
        int dev = 0, cus = 0, per_cu = 0;
        if (hipGetDevice(&dev) != hipSuccess || hipDeviceGetAttribute(&cus, hipDeviceAttributeMultiprocessorCount, dev) != hipSuccess) { fprintf(stderr, "kernel_launch: device query failed\n"); grid = -1; return; }
        if (hipFuncSetAttribute((const void*)fwd_kernel, hipFuncAttributeMaxDynamicSharedMemorySize, LDS_BYTES) != hipSuccess) { fprintf(stderr, "kernel_launch: hipFuncSetAttribute failed\n"); grid = -1; return; }
        if (hipOccupancyMaxActiveBlocksPerMultiprocessor(&per_cu, (const void*)fwd_kernel, NWAVES * 64, LDS_BYTES) != hipSuccess || per_cu < 1)
            fprintf(stderr, "kernel_launch: note: occupancy query reports %d workgroups per CU\n", per_cu);
        (void)hipGetLastError();
        if (cus != 256) { fprintf(stderr, "kernel_launch: this build needs a 256-CU device (found %d CUs); nothing launched\n", cus); grid = -1; return; }
        grid = cus;
    }
    if (grid < 0) return;
    if (hipMemsetAsync((char*)d_ws + WS_CTL, 0, CTL_ZERO_BYTES, stream) != hipSuccess) { fprintf(stderr, "kernel_launch: memset failed\n"); return; }
    Args a{};
    for (int i = 0; i < 13; ++i) a.in[i] = (const float*)d_in[i];
    a.out = (float*)d_out; a.ws = (unsigned char*)d_ws;
    hipLaunchKernelGGL(fwd_kernel, dim3(grid), dim3(NWAVES * 64), LDS_BYTES, stream, a);
    const hipError_t le = hipPeekAtLastError();
    if (le != hipSuccess) fprintf(stderr, "kernel_launch: launch failed: %s\n", hipGetErrorName(le));
}
```
